# Optimizing an MI355X kernel written in HIP

```python
import jax, jax.numpy as jnp
from jax import lax
import numpy as np

D_MODEL = 2048
BATCH = 1
SEQ = 8192
DEPTH = 1
DEC_BATCH = 128
DEC_SEQ = 4
PAST_LEN = 2048
PAGE_SIZE = 128

HG_HEADS = 8
HG_DK = 128
HG_DV = 128
HG_WIDTH = HG_HEADS * HG_DK
HG_VWIDTH = HG_HEADS * HG_DV
HG_CHUNK = 64
NSA_HEADS = 16
NSA_KV_HEADS = 2
NSA_GROUP = NSA_HEADS // NSA_KV_HEADS
HEAD_DIM = 64
NSA_WIDTH = NSA_HEADS * HEAD_DIM
KV_WIDTH = NSA_KV_HEADS * HEAD_DIM
CMP_BLOCK = 32
CMP_STRIDE = 16
CMP_HIDDEN = 256
SLC_BLOCK = 64
SLC_TOP = 16
WINDOW = 512
Q_BLOCK = 128
FORCE_SCORE = 1.0e4
D_FF = 5504
EPS = 1e-6
IN_WIDTHS = (HG_WIDTH, HG_WIDTH, HG_VWIDTH, HG_VWIDTH, NSA_WIDTH,
             KV_WIDTH, KV_WIDTH, KV_WIDTH, KV_WIDTH, KV_WIDTH, KV_WIDTH,
             3 * NSA_HEADS, D_MODEL, D_MODEL)
D_IN = sum(IN_WIDTHS)

kernel_name = 'hybrid_hgrn2_nsa_macaron_step'


def rmsnorm(x, g):
    xf = x.astype(jnp.float32)
    y = xf * lax.rsqrt(jnp.mean(xf * xf, axis=-1, keepdims=True) + EPS)
    return (y * g.astype(jnp.float32)).astype(x.dtype)


def half_ffn(x, n_pre, n_post, w_gate, w_up, w_down):
    h = rmsnorm(x, n_pre)
    y = (jax.nn.silu(h @ w_gate) * (h @ w_up)) @ w_down
    return x + 0.5 * rmsnorm(y, n_post)


def alibi_slopes():
    return jnp.asarray(np.power(2.0, -8.0 * np.arange(1, NSA_HEADS + 1) / NSA_HEADS), dtype=jnp.float32)


def in_project(h, w_in):
    points = np.cumsum(IN_WIDTHS)[:-1].tolist()
    parts = jnp.split(h @ w_in, points, axis=-1)
    hg_in = (parts[0], parts[1], parts[2], parts[3])
    nsa_in = (parts[4], (parts[5], parts[6], parts[7], parts[8], parts[9], parts[10]), parts[11])
    return hg_in, nsa_in, parts[12], parts[13]


def hgrn2_scan(q, logf, k, v, s0):
    B, T, H, _ = q.shape
    C = min(HG_CHUNK, T)
    n_chunks = -(-T // C)
    pad = n_chunks * C - T

    def prep(a):
        a = jnp.pad(a.astype(jnp.float32), ((0, 0), (0, pad), (0, 0), (0, 0)))
        return a.reshape(B, n_chunks, C, H, a.shape[-1]).transpose(1, 0, 2, 3, 4)

    qc, fc, kc, vc = prep(q), prep(logf), prep(k), prep(v)
    causal = jnp.tril(jnp.ones((C, C), dtype=bool))[None, :, :, None, None]

    def step(S, inp):
        qi, fi, ki, vi = inp
        b = jnp.cumsum(fi, axis=1)
        o_inter = jnp.einsum('bchk,bhkv->bchv', qi * jnp.exp(b), S)
        diff = b[:, :, None] - b[:, None, :]
        decay = jnp.exp(jnp.where(causal, diff, -jnp.inf))
        A = jnp.einsum('bthk,bshk,btshk->bhts', qi, ki, decay)
        o_intra = jnp.einsum('bhts,bshv->bthv', A, vi)
        b_last = b[:, -1]
        k_dec = ki * jnp.exp(b_last[:, None] - b)
        S_new = jnp.exp(b_last)[..., None] * S + jnp.einsum('bshk,bshv->bhkv', k_dec, vi)
        return S_new, o_inter + o_intra

    S_fin, o = lax.scan(step, s0.astype(jnp.float32), (qc, fc, kc, vc))
    o = o.transpose(1, 0, 2, 3, 4).reshape(B, n_chunks * C, H, HG_DV)[:, :T]
    return o, S_fin


def hgrn2_branch(q_raw, f_raw, i_raw, g_raw, lb, g_norm, s0):
    B, T, _ = q_raw.shape
    f = lb + (1.0 - lb) * jax.nn.sigmoid(f_raw.astype(jnp.float32))
    logf = jnp.log(f)
    k = 1.0 - f
    q = jax.nn.silu(q_raw.astype(jnp.float32))
    heads = lambda a: a.reshape(B, T, HG_HEADS, -1)
    o, S = hgrn2_scan(heads(q), heads(logf), heads(k), heads(i_raw), s0)
    o = rmsnorm(o, g_norm) * jax.nn.silu(heads(g_raw).astype(jnp.float32))
    return o.reshape(B, T, HG_VWIDTH).astype(q_raw.dtype), S


def nsa_heads(q_raw, kv_raws, g_raw):
    B, T, _ = q_raw.shape
    q = q_raw.reshape(B, T, NSA_HEADS, HEAD_DIM) * (HEAD_DIM ** -0.5)
    kvs = tuple(a.reshape(B, T, NSA_KV_HEADS, HEAD_DIM) for a in kv_raws)
    gates = jax.nn.sigmoid(g_raw.astype(jnp.float32)).reshape(B, T, NSA_HEADS, 3)
    return q, gates, kvs


def compress(k, pos_emb, w1, w2):
    B, L, N, D = k.shape
    nc = (L - CMP_BLOCK) // CMP_STRIDE + 1
    idx = jnp.arange(nc)[:, None] * CMP_STRIDE + jnp.arange(CMP_BLOCK)[None, :]
    blocks = k[:, idx] + pos_emb[None, None, :, None, :]
    flat = blocks.transpose(0, 1, 3, 2, 4).reshape(B, nc, N, CMP_BLOCK * D)
    return jax.nn.gelu(flat @ w1) @ w2


def to_blocks(k):
    B, L, N, D = k.shape
    ns = -(-L // SLC_BLOCK)
    k = jnp.pad(k, ((0, 0), (0, ns * SLC_BLOCK - L), (0, 0), (0, 0)))
    return k.reshape(B, ns, SLC_BLOCK, N, D).transpose(0, 3, 1, 2, 4)


def overlap_matrix(nc, ns):
    cs = jnp.arange(nc)[:, None] * CMP_STRIDE
    ss = jnp.arange(ns)[None, :] * SLC_BLOCK
    return ((cs <= ss + SLC_BLOCK - 1) & (cs + CMP_BLOCK - 1 >= ss)).astype(jnp.float32)


def masked_attend(s, mask, v, eq):
    s = jnp.where(mask, s, -jnp.inf)
    m = jnp.max(s, axis=-1, keepdims=True)
    m = jnp.where(jnp.isfinite(m), m, 0.0)
    p = jnp.where(mask, jnp.exp(s - m), 0.0)
    p = p / jnp.maximum(jnp.sum(p, axis=-1, keepdims=True), 1e-30)
    return p, jnp.einsum(eq, p, v.astype(jnp.float32))


def nsa_block(q, qpos, gates, kc, vc, cpos, ks_blocks, vs_blocks, kw, vw, wpos):
    B, Tq, H, D = q.shape
    nc = kc.shape[1]
    ns = ks_blocks.shape[2]
    slopes = alibi_slopes().reshape(NSA_KV_HEADS, NSA_GROUP, 1, 1)
    qg = q.astype(jnp.float32).reshape(B, Tq, NSA_KV_HEADS, NSA_GROUP, D)
    dist_c = (qpos[:, None] - cpos[None, :]).astype(jnp.float32)
    s_c = jnp.einsum('btngd,bcnd->bngtc', qg, kc.astype(jnp.float32)) - slopes * dist_c
    p_c, o_c = masked_attend(s_c, dist_c >= 0, vc, 'bngtc,bcnd->btngd')
    score = jnp.einsum('bngtc,cs->bnts', p_c, overlap_matrix(nc, ns))
    blk = jnp.arange(ns)[None, :]
    qblk = (qpos // SLC_BLOCK)[:, None]
    forced = (blk == 0) | (blk == qblk) | (blk == qblk - 1)
    valid = blk * SLC_BLOCK <= qpos[:, None]
    score = jnp.where(valid, jnp.where(forced, FORCE_SCORE, score), -jnp.inf)
    n_top = min(SLC_TOP, ns)
    _, idx = lax.top_k(score, n_top)
    idx_flat = idx.reshape(B, NSA_KV_HEADS, Tq * n_top)
    b_ix = jnp.arange(B)[:, None, None]
    n_ix = jnp.arange(NSA_KV_HEADS)[None, :, None]
    ks = ks_blocks[b_ix, n_ix, idx_flat].reshape(B, NSA_KV_HEADS, Tq, n_top * SLC_BLOCK, D)
    vs = vs_blocks[b_ix, n_ix, idx_flat].reshape(B, NSA_KV_HEADS, Tq, n_top * SLC_BLOCK, D)
    spos = (idx[..., None] * SLC_BLOCK + jnp.arange(SLC_BLOCK)).reshape(B, NSA_KV_HEADS, Tq, n_top * SLC_BLOCK)
    dist_s = (qpos[:, None] - spos).astype(jnp.float32)[:, :, None]
    s_s = jnp.einsum('btngd,bntsd->bngts', qg, ks.astype(jnp.float32)) - slopes * dist_s
    _, o_s = masked_attend(s_s, dist_s >= 0, vs, 'bngts,bntsd->btngd')
    dist_w = qpos[:, None] - wpos[None, :]
    mask_w = (dist_w >= 0) & (dist_w < WINDOW) & (wpos[None, :] >= 0)
    s_w = jnp.einsum('btngd,bwnd->bngtw', qg, kw.astype(jnp.float32)) - slopes * dist_w.astype(jnp.float32)
    _, o_w = masked_attend(s_w, mask_w, vw, 'bngtw,bwnd->btngd')
    o = jnp.stack([o_c, o_s, o_w], axis=-2).reshape(B, Tq, H, 3, D)
    return jnp.einsum('bthr,bthrd->bthd', gates, o)


def nsa_prompt(q, gates, kvs, cmp_k, cmp_v):
    B, T, H, D = q.shape
    k_c, v_c, k_s, v_s, k_w, v_w = kvs
    kc = compress(k_c, *cmp_k)
    vc = compress(v_c, *cmp_v)
    cpos = jnp.arange(kc.shape[1]) * CMP_STRIDE + CMP_BLOCK - 1
    ks_blocks, vs_blocks = to_blocks(k_s), to_blocks(v_s)
    kw_pad = jnp.pad(k_w, ((0, 0), (WINDOW, 0), (0, 0), (0, 0)))
    vw_pad = jnp.pad(v_w, ((0, 0), (WINDOW, 0), (0, 0), (0, 0)))
    nq = T // Q_BLOCK
    qb = q.reshape(B, nq, Q_BLOCK, H, D).swapaxes(0, 1)
    gb = gates.reshape(B, nq, Q_BLOCK, H, 3).swapaxes(0, 1)

    def step(args):
        i, q_i, g_i = args
        start = i * Q_BLOCK
        qpos = start + jnp.arange(Q_BLOCK)
        kw = lax.dynamic_slice_in_dim(kw_pad, start, WINDOW + Q_BLOCK, axis=1)
        vw = lax.dynamic_slice_in_dim(vw_pad, start, WINDOW + Q_BLOCK, axis=1)
        wpos = start - WINDOW + jnp.arange(WINDOW + Q_BLOCK)
        return nsa_block(q_i, qpos, g_i, kc, vc, cpos, ks_blocks, vs_blocks, kw, vw, wpos)

    o = lax.map(step, (jnp.arange(nq), qb, gb))
    o = o.swapaxes(0, 1).reshape(B, T, NSA_WIDTH)
    kv_rows = jnp.stack([k_c, v_c, k_s, v_s], axis=2)
    wl = min(WINDOW, T)
    win_rows = jnp.stack([k_w, v_w], axis=2)[:, T - wl:]
    return o, kv_rows, win_rows


def nsa_sample(q, gates, kvs, cache_kv_l, cache_win_l, page_table, cmp_k, cmp_v):
    B, Tn, H, D = q.shape
    k_c, v_c, k_s, v_s, k_w, v_w = kvs
    past_len = page_table.shape[1] * cache_kv_l.shape[1]
    past = cache_kv_l[page_table].reshape(B, past_len, 4, NSA_KV_HEADS, HEAD_DIM)
    new_rows = jnp.stack([k_c, v_c, k_s, v_s], axis=2)
    full = jnp.concatenate([past, new_rows.astype(past.dtype)], axis=1)
    kc = compress(full[:, :, 0], *cmp_k)
    vc = compress(full[:, :, 1], *cmp_v)
    cpos = jnp.arange(kc.shape[1]) * CMP_STRIDE + CMP_BLOCK - 1
    ks_blocks, vs_blocks = to_blocks(full[:, :, 2]), to_blocks(full[:, :, 3])
    wl = cache_win_l.shape[1]
    wfull = jnp.concatenate([cache_win_l, jnp.stack([k_w, v_w], axis=2).astype(cache_win_l.dtype)], axis=1)
    wpos = past_len - wl + jnp.arange(wl + Tn)
    qpos = past_len + jnp.arange(Tn)
    o = nsa_block(q, qpos, gates, kc, vc, cpos, ks_blocks, vs_blocks, wfull[:, :, 0], wfull[:, :, 1], wpos)
    return o.reshape(B, Tn, NSA_WIDTH), new_rows, wfull[:, Tn:]


def merge_out(o_hg, o_nsa, gate_a, gate_b, w_proj_hg, w_proj_nsa, w_out):
    y = jax.nn.sigmoid(gate_a) * (o_hg @ w_proj_hg) + jax.nn.sigmoid(gate_b) * (o_nsa @ w_proj_nsa)
    return y @ w_out


def setup_inputs(seed: int = 0) -> dict:
    key = jax.random.key(seed)
    keys = list(jax.random.split(key, 48))
    cnt = [0]

    def nk():
        cnt[0] += 1
        return keys[cnt[0] - 1]

    def nrm(shape, scale):
        return jax.random.normal(nk(), shape, jnp.float32) * scale

    def gain(shape):
        return 1.0 + nrm(shape, 0.1)

    n_pages = PAST_LEN // PAGE_SIZE
    n_pool = (DEC_BATCH * n_pages * 5) // 4
    win_len = min(WINDOW, PAST_LEN)
    inp = {}
    inp['x_prompt'] = nrm((BATCH, SEQ, D_MODEL), 1.0)
    inp['x_sample'] = nrm((DEC_BATCH, DEC_SEQ, D_MODEL), 1.0)
    inp['cache_kv'] = nrm((DEPTH, n_pool, PAGE_SIZE, 4, NSA_KV_HEADS, HEAD_DIM), 1.0)
    inp['cache_win'] = nrm((DEPTH, DEC_BATCH, win_len, 2, NSA_KV_HEADS, HEAD_DIM), 1.0)
    inp['state_hgrn'] = nrm((DEPTH, DEC_BATCH, HG_HEADS, HG_DK, HG_DV), 0.3)
    inp['page_table'] = jax.random.permutation(nk(), n_pool)[: DEC_BATCH * n_pages].reshape(DEC_BATCH, n_pages).astype(jnp.int32)
    inp['norm_pre1'] = gain((DEPTH, D_MODEL))
    inp['norm_post1'] = gain((DEPTH, D_MODEL))
    inp['ff1_gate'] = nrm((DEPTH, D_MODEL, D_FF), D_MODEL ** -0.5)
    inp['ff1_up'] = nrm((DEPTH, D_MODEL, D_FF), D_MODEL ** -0.5)
    inp['ff1_down'] = nrm((DEPTH, D_FF, D_MODEL), D_FF ** -0.5)
    inp['norm_pre2'] = gain((DEPTH, D_MODEL))
    inp['norm_post2'] = gain((DEPTH, D_MODEL))
    inp['w_in'] = nrm((DEPTH, D_MODEL, D_IN), D_MODEL ** -0.5)
    inp['hg_lb'] = nrm((DEPTH + 1, HG_WIDTH), 0.5)
    inp['hg_gnorm'] = gain((DEPTH, HG_DV))
    inp['cmp_pos_k'] = nrm((DEPTH, CMP_BLOCK, HEAD_DIM), 0.5)
    inp['cmp_w1_k'] = nrm((DEPTH, CMP_BLOCK * HEAD_DIM, CMP_HIDDEN), (CMP_BLOCK * HEAD_DIM) ** -0.5)
    inp['cmp_w2_k'] = nrm((DEPTH, CMP_HIDDEN, HEAD_DIM), CMP_HIDDEN ** -0.5)
    inp['cmp_pos_v'] = nrm((DEPTH, CMP_BLOCK, HEAD_DIM), 0.5)
    inp['cmp_w1_v'] = nrm((DEPTH, CMP_BLOCK * HEAD_DIM, CMP_HIDDEN), (CMP_BLOCK * HEAD_DIM) ** -0.5)
    inp['cmp_w2_v'] = nrm((DEPTH, CMP_HIDDEN, HEAD_DIM), CMP_HIDDEN ** -0.5)
    inp['w_proj_hg'] = nrm((DEPTH, HG_VWIDTH, D_MODEL), HG_VWIDTH ** -0.5)
    inp['w_proj_nsa'] = nrm((DEPTH, NSA_WIDTH, D_MODEL), NSA_WIDTH ** -0.5)
    inp['w_out'] = nrm((DEPTH, D_MODEL, D_MODEL), D_MODEL ** -0.5)
    inp['norm_pre3'] = gain((DEPTH, D_MODEL))
    inp['norm_post3'] = gain((DEPTH, D_MODEL))
    inp['ff2_gate'] = nrm((DEPTH, D_MODEL, D_FF), D_MODEL ** -0.5)
    inp['ff2_up'] = nrm((DEPTH, D_MODEL, D_FF), D_MODEL ** -0.5)
    inp['ff2_down'] = nrm((DEPTH, D_FF, D_MODEL), D_FF ** -0.5)
    return inp


def reference(x_prompt, x_sample, cache_kv, cache_win, state_hgrn, page_table,
              norm_pre1, norm_post1, ff1_gate, ff1_up, ff1_down,
              norm_pre2, norm_post2, w_in, hg_lb, hg_gnorm,
              cmp_pos_k, cmp_w1_k, cmp_w2_k, cmp_pos_v, cmp_w1_v, cmp_w2_v,
              w_proj_hg, w_proj_nsa, w_out,
              norm_pre3, norm_post3, ff2_gate, ff2_up, ff2_down):
    lb_all = jnp.cumsum(jax.nn.softmax(hg_lb.astype(jnp.float32), axis=0), axis=0)[:DEPTH]
    xp, xs = x_prompt, x_sample
    kv_p, kv_s, win_p, win_s, st_p, st_s = [], [], [], [], [], []
    for l in range(DEPTH):
        xp = half_ffn(xp, norm_pre1[l], norm_post1[l], ff1_gate[l], ff1_up[l], ff1_down[l])
        xs = half_ffn(xs, norm_pre1[l], norm_post1[l], ff1_gate[l], ff1_up[l], ff1_down[l])
        cmp_k = (cmp_pos_k[l], cmp_w1_k[l], cmp_w2_k[l])
        cmp_v = (cmp_pos_v[l], cmp_w1_v[l], cmp_w2_v[l])
        h = rmsnorm(xp, norm_pre2[l])
        hg_in, nsa_in, gate_a, gate_b = in_project(h, w_in[l])
        s0 = jnp.zeros((xp.shape[0], HG_HEADS, HG_DK, HG_DV), jnp.float32)
        o_hg, s_new = hgrn2_branch(*hg_in, lb_all[l], hg_gnorm[l], s0)
        q, gates, kvs = nsa_heads(*nsa_in)
        o_nsa, kv_rows, win_rows = nsa_prompt(q, gates, kvs, cmp_k, cmp_v)
        mix = merge_out(o_hg, o_nsa.astype(h.dtype), gate_a, gate_b, w_proj_hg[l], w_proj_nsa[l], w_out[l])
        xp = xp + rmsnorm(mix, norm_post2[l])
        kv_p.append(kv_rows)
        win_p.append(win_rows)
        st_p.append(s_new)
        h = rmsnorm(xs, norm_pre2[l])
        hg_in, nsa_in, gate_a, gate_b = in_project(h, w_in[l])
        o_hg, s_new = hgrn2_branch(*hg_in, lb_all[l], hg_gnorm[l], state_hgrn[l])
        q, gates, kvs = nsa_heads(*nsa_in)
        o_nsa, kv_rows, win_buf = nsa_sample(q, gates, kvs, cache_kv[l], cache_win[l], page_table, cmp_k, cmp_v)
        mix = merge_out(o_hg, o_nsa.astype(h.dtype), gate_a, gate_b, w_proj_hg[l], w_proj_nsa[l], w_out[l])
        xs = xs + rmsnorm(mix, norm_post2[l])
        kv_s.append(kv_rows)
        win_s.append(win_buf)
        st_s.append(s_new)
        xp = half_ffn(xp, norm_pre3[l], norm_post3[l], ff2_gate[l], ff2_up[l], ff2_down[l])
        xs = half_ffn(xs, norm_pre3[l], norm_post3[l], ff2_gate[l], ff2_up[l], ff2_down[l])
    kv_prompt = jnp.stack(kv_p, axis=0)
    kv_sample = jnp.stack(kv_s, axis=0)
    win_prompt = jnp.stack(win_p, axis=0)
    win_sample = jnp.stack(win_s, axis=0)
    hgrn_prompt = jnp.stack(st_p, axis=0)
    hgrn_sample = jnp.stack(st_s, axis=0)
    return (xp, xs, kv_prompt, kv_sample, win_prompt, win_sample, hgrn_prompt, hgrn_sample)
```

```cpp
#include <hip/hip_runtime.h>
#include <cstdio>
#include <cstdint>
namespace pg8 {
#define PG8_LAS __attribute__((address_space(3)))
typedef unsigned short bf16_t;
typedef short bf16x8 __attribute__((ext_vector_type(8)));
typedef float f32x4 __attribute__((ext_vector_type(4)));
typedef unsigned u32x4 __attribute__((ext_vector_type(4)));
constexpr int BM = 256, BK = 64, HALF = 128, HTB = HALF * BK * 2  , STAGE_BYTES = 8 * HTB, NXCD = 8, WGM = 8;

__host__ __device__ __forceinline__ int lds_byte(int r, int c) { const int st = (r >> 4) * 2 + (c >> 5), rr = r & 15, cc = c & 31, ob = rr * 64 + cc * 2; return st * 1024 + (ob ^ (((ob >> 9) & 1) << 5)); }
__host__ __device__ __forceinline__ void stage_rc(int b, int& R, int& C) { const int st = b / 1024, sb = b % 1024, swz = sb ^ (((sb >> 9) & 1) << 5); R = (st >> 1) * 16 + swz / 64; C = (st & 1) * 32 + (swz % 64) / 2; }
__host__ __device__ __forceinline__ int perm32(int rho) { const int n = rho >> 4, i = rho & 15; return 8 * (i >> 2) + 4 * n + (i & 3); }

struct Unit { int pm, pn; };
struct Gemm { const bf16_t* A; const bf16_t* Bt; int M, N, K, lda, ldb; };

struct StaticOrder {
    int nM, nN, nwg, G, c;
    __host__ __device__ void init(int M, int N, int G_, int c_) { nM = M / BM; nN = N / BM; nwg = nM * nN; G = G_; c = c_; }
    __host__ __device__ bool next(int i, Unit& u) const {
        const long L = (long)i * G + c; if (L >= nwg) return false;
        int wgid = (int)L; { const int q = nwg / NXCD, r = nwg % NXCD, xcd = wgid % NXCD, off = wgid / NXCD; wgid = (xcd < r ? xcd * (q + 1) : r * (q + 1) + (xcd - r) * q) + off; }
        const int nig = WGM * nN, gid = wgid / nig, fm = gid * WGM, gsz = (nM - fm) < WGM ? (nM - fm) : WGM;
        u.pm = fm + ((wgid % nig) % gsz); u.pn = (wgid % nig) / gsz; return true;
    }
    __device__ __forceinline__ void a_ready(const Unit&) const {}
    __device__ __forceinline__ void done(const Unit&) const {}
};

__device__ __forceinline__ unsigned cvt_pk_bf16(float lo, float hi) { unsigned r; asm volatile("v_cvt_pk_bf16_f32 %0, %1, %2" : "=v"(r) : "v"(lo), "v"(hi)); return r; }
typedef float f32x2 __attribute__((ext_vector_type(2)));
template <class Epi, class Sched, bool ALIGN_EPI = false>
__device__ __forceinline__ void gemm_phase(PG8_LAS unsigned char* lds, const Gemm g, const Sched& S, const Epi& E) {
    const int tid = threadIdx.x, wid = __builtin_amdgcn_readfirstlane(tid >> 6), lane = tid & 63, wr = wid >> 2, wc = wid & 3, fr = lane & 15, fq = lane >> 4;
    const int K = g.K, nt = K / BK;
    unsigned voffA[2], voffB[2];
#pragma unroll
    for (int i = 0; i < 2; ++i) { int R, C; stage_rc(tid * 16 + i * 8192, R, C); const int Rb = Epi::PERM ? ((R & ~31) + perm32(R & 31)) : R;
        voffA[i] = (unsigned)(R * g.lda + C) * 2u; voffB[i] = (unsigned)(Rb * g.ldb + C) * 2u; }
    const size_t kstep = (size_t)(BK * 2);
    const size_t hstepA = (size_t)HALF * g.lda * 2, hstepB = (size_t)HALF * g.ldb * 2;
    const size_t tstepA = 2 * hstepA, tstepB = 2 * hstepB;
    const unsigned ldsw = (unsigned)wid * 1024u;
    const int aoff = lds_byte(wr * 64 + fr, fq * 8), boff = lds_byte(wc * 32 + fr, fq * 8);
#define PG8_SA(b, h) (((b) * 2 + (h)) * HTB)
#define PG8_SB(b, h) ((4 + (b) * 2 + (h)) * HTB)
#define PG8_STAGE(bufoff, gbase, voff) do { _Pragma("unroll") for (int _i = 0; _i < 2; ++_i) \
        __builtin_amdgcn_global_load_lds((const unsigned*)((const char*)(gbase) + (voff)[_i]), (PG8_LAS unsigned*)(lds + (bufoff) + ldsw + _i * 8192), 16, 0, 0); } while (0)
#define PG8_LDA(dst, b, h) do { _Pragma("unroll") for (int m = 0; m < 4; ++m) _Pragma("unroll") for (int k = 0; k < 2; ++k) dst[m][k] = *(const PG8_LAS bf16x8*)(lds + PG8_SA(b, h) + aoff + m * 2048 + k * 1024); } while (0)
#define PG8_LDB(dst, b, h) do { _Pragma("unroll") for (int n = 0; n < 2; ++n) _Pragma("unroll") for (int k = 0; k < 2; ++k) dst[n][k] = *(const PG8_LAS bf16x8*)(lds + PG8_SB(b, h) + boff + n * 2048 + k * 1024); } while (0)
#define PG8_MMA(ai, bj, At, Bt) do { __builtin_amdgcn_s_setprio(1); _Pragma("unroll") for (int m = 0; m < 4; ++m) _Pragma("unroll") for (int n = 0; n < 2; ++n) _Pragma("unroll") for (int k = 0; k < 2; ++k) \
        acc[ai][bj][m][n] = __builtin_amdgcn_mfma_f32_16x16x32_bf16(Bt[n][k], At[m][k], acc[ai][bj][m][n], 0, 0, 0); __builtin_amdgcn_s_setprio(0); } while (0)
#define PG8_WAIT_V(n) asm volatile("s_waitcnt vmcnt(" #n ")" ::: "memory")
#define PG8_WAIT_L(n) asm volatile("s_waitcnt lgkmcnt(" #n ")" ::: "memory")
#define PG8_BAR __builtin_amdgcn_s_barrier()
#define PG8_SCHED __builtin_amdgcn_sched_barrier(0)
    Unit cur, nxt; int ui = 0;
    if (!S.next(0, cur)) return;
    f32x4 acc[2][2][4][2];
#pragma unroll
    for (int a = 0; a < 2; ++a)
#pragma unroll
        for (int b = 0; b < 2; ++b)
#pragma unroll
            for (int m = 0; m < 4; ++m)
#pragma unroll
                for (int n = 0; n < 2; ++n) acc[a][b][m][n] = (f32x4){0.f, 0.f, 0.f, 0.f};
    bf16x8 At[4][2], B0[2][2], B1[2][2];
    const char* cA = (const char*)g.A + (size_t)cur.pm * tstepA; const char* cB = (const char*)g.Bt + (size_t)cur.pn * tstepB;
    S.a_ready(cur);
    PG8_STAGE(PG8_SB(0, 0), cB, voffB); PG8_STAGE(PG8_SB(0, 1), cB + hstepB, voffB); PG8_STAGE(PG8_SA(0, 0), cA, voffA); PG8_STAGE(PG8_SA(0, 1), cA + hstepA, voffA);
    if (wr == 1) PG8_BAR;
    PG8_WAIT_V(2); PG8_BAR;
    PG8_STAGE(PG8_SB(1, 0), cB + kstep, voffB); PG8_STAGE(PG8_SA(1, 0), cA + kstep, voffA); PG8_STAGE(PG8_SB(1, 1), cB + hstepB + kstep, voffB);
    PG8_WAIT_V(6); PG8_BAR;
    for (;;) {
        const bool has_next = S.next(ui + 1, nxt);
        const char* nA = has_next ? (const char*)g.A + (size_t)nxt.pm * tstepA : cA; const char* nB = has_next ? (const char*)g.Bt + (size_t)nxt.pn * tstepB : cB;
        for (int t = 0; t < nt; t += 2) {
            const bool last = (t == nt - 2);
            const char* a1 = cA + (size_t)(t + 1) * kstep;
            const char* a2 = last ? nA : cA + (size_t)(t + 2) * kstep; const char* b2 = last ? nB : cB + (size_t)(t + 2) * kstep;
            const char* a3 = a2 + kstep; const char* b3 = b2 + kstep;
            if (last && has_next) S.a_ready(nxt);
            PG8_LDB(B0, 0, 0); PG8_LDB(B1, 0, 1); PG8_SCHED; PG8_LDA(At, 0, 0); PG8_STAGE(PG8_SA(1, 1), a1 + hstepA, voffA);
            PG8_WAIT_V(8); PG8_WAIT_L(0); PG8_BAR; PG8_MMA(0, 0, At, B0); PG8_MMA(0, 1, At, B1); PG8_BAR; PG8_SCHED;
            PG8_LDA(At, 0, 1); PG8_STAGE(PG8_SB(0, 0), b2, voffB); PG8_STAGE(PG8_SB(0, 1), b2 + hstepB, voffB); PG8_STAGE(PG8_SA(0, 0), a2, voffA);
            PG8_WAIT_V(8); PG8_WAIT_L(0); PG8_BAR; PG8_MMA(1, 0, At, B0); PG8_MMA(1, 1, At, B1); PG8_BAR; PG8_SCHED;
            PG8_LDB(B0, 1, 0); PG8_LDB(B1, 1, 1); PG8_SCHED; PG8_LDA(At, 1, 0); PG8_STAGE(PG8_SA(0, 1), a2 + hstepA, voffA);
            PG8_WAIT_V(8); PG8_WAIT_L(0); PG8_BAR; PG8_MMA(0, 0, At, B0); PG8_MMA(0, 1, At, B1); PG8_BAR; PG8_SCHED;
            PG8_LDA(At, 1, 1); PG8_STAGE(PG8_SB(1, 0), b3, voffB); PG8_STAGE(PG8_SB(1, 1), b3 + hstepB, voffB); PG8_STAGE(PG8_SA(1, 0), a3, voffA);
            PG8_WAIT_V(8); PG8_WAIT_L(0); PG8_BAR; PG8_MMA(1, 0, At, B0); PG8_MMA(1, 1, At, B1); PG8_BAR; PG8_SCHED;
        }
        if constexpr (ALIGN_EPI) { if (wr == 0) PG8_BAR; }
        E(acc, cur, wr, wc, fr, fq); S.done(cur);
        if (!has_next) break;
#pragma unroll
        for (int a = 0; a < 2; ++a)
#pragma unroll
            for (int b = 0; b < 2; ++b)
#pragma unroll
                for (int m = 0; m < 4; ++m)
#pragma unroll
                    for (int n = 0; n < 2; ++n) acc[a][b][m][n] = (f32x4){0.f, 0.f, 0.f, 0.f};
        cur = nxt; cA = nA; cB = nB; ++ui;
        if constexpr (ALIGN_EPI) { if (wr == 1) PG8_BAR; }
    }
    PG8_WAIT_V(0);
    if constexpr (!ALIGN_EPI) { if (wr == 0) PG8_BAR; }
    PG8_BAR;
#undef PG8_SA
#undef PG8_SB
#undef PG8_STAGE
#undef PG8_LDA
#undef PG8_LDB
#undef PG8_MMA
#undef PG8_WAIT_V
#undef PG8_WAIT_L
#undef PG8_BAR
#undef PG8_SCHED
}
}
#define GAS __attribute__((address_space(1)))
#define LAS __attribute__((address_space(3)))
typedef unsigned short bf16;
typedef unsigned v4u __attribute__((ext_vector_type(4)));
typedef float f32x4 __attribute__((ext_vector_type(4)));
typedef short bf16x8 __attribute__((ext_vector_type(8)));
typedef GAS unsigned gu32;
typedef GAS unsigned long long gu64;
#define RLX_AGENT __ATOMIC_RELAXED, __HIP_MEMORY_SCOPE_AGENT
#define LDS_WAIT() asm volatile("s_waitcnt lgkmcnt(0)" ::: "memory")
#define VM_WAIT() asm volatile("s_waitcnt vmcnt(0)" ::: "memory")
__device__ __forceinline__ unsigned long long rt() { return __builtin_amdgcn_s_memrealtime(); }
__device__ __forceinline__ unsigned f2bf(float f) { unsigned u = __builtin_bit_cast(unsigned, f); return (u + 0x7fffu + ((u >> 16) & 1u)) >> 16; }
__device__ __forceinline__ unsigned pk2(float lo, float hi) { return f2bf(lo) | (f2bf(hi) << 16); }

#define XB_TMO      128
#define XB_XCNT(j)  (256  + 64 * (j))
#define XB_XSUB(j)  (1280 + 64 * (j))
#define XB_XGEN(j)  (2304 + 64 * (j))
#define XB_TOP      3328
#define XB_TOPGEN   3392
#define XCD_BAR_WORDS 3456
#define XB_SPIN_CAP (1u << 18)

__device__ __forceinline__ unsigned xb_ld(unsigned* p)              { return __hip_atomic_load(p, __ATOMIC_RELAXED, __HIP_MEMORY_SCOPE_AGENT); }
__device__ __forceinline__ unsigned xb_add(unsigned* p, unsigned v) { return __hip_atomic_fetch_add(p, v, __ATOMIC_RELAXED, __HIP_MEMORY_SCOPE_AGENT); }
__device__ __forceinline__ unsigned xb_xcc_id() { return (unsigned)__builtin_amdgcn_s_getreg((3 << 11) | 20) & 0xFu; }
#define XB_SPIN(cond, bar) do { unsigned _sp = 0; while (cond) { __builtin_amdgcn_s_sleep(1); \
    if ((++_sp & 255u) == 0u) { if (xb_ld(&(bar)[XB_TMO])) break; if (_sp > XB_SPIN_CAP) { atomicAdd(&(bar)[XB_TMO], 1u); break; } } } } while (0)

struct XcdBarrier {
    unsigned* bar; unsigned x;
    volatile LAS unsigned* st;
};

__device__ __forceinline__ XcdBarrier xcd_barrier_post(unsigned* bar, volatile LAS unsigned* st) {
    XcdBarrier b; b.bar = bar; b.x = xb_xcc_id(); b.st = st;
    if (threadIdx.x == 0) (void)xb_add(&bar[XB_XCNT(b.x)], 1u);
    return b;
}
__device__ __forceinline__ void xcd_barrier_complete(unsigned* bar, unsigned x, unsigned& nloc, unsigned& nx) {
    const unsigned G = gridDim.x * gridDim.y * gridDim.z;
    unsigned sum, cnt, mine, sp = 0u;
    for (;;) {
        sum = 0u; cnt = 0u; mine = 0u;
#pragma unroll
        for (unsigned j = 0; j < 16; ++j) { const unsigned c = xb_ld(&bar[XB_XCNT(j)]); sum += c; cnt += (c > 0u) ? 1u : 0u; mine = (j == x) ? c : mine; }
        if (sum == G) break;
        __builtin_amdgcn_s_sleep(1);
        if ((++sp & 255u) == 0u) { if (xb_ld(&bar[XB_TMO])) break; if (sp > XB_SPIN_CAP) { atomicAdd(&bar[XB_TMO], 1u); break; } }
    }
    nloc = mine > 0u ? mine : 1u; nx = cnt > 0u ? cnt : 1u;
}

__device__ __forceinline__ void xcd_barrier(const XcdBarrier& b) {
    asm volatile("s_waitcnt vmcnt(0)" ::: "memory");
    __syncthreads();
    if (threadIdx.x == 0) {
        unsigned* bar = b.bar;
        __builtin_amdgcn_s_waitcnt(0);
        unsigned nloc = b.st[0], nx = b.st[1];
        if (nloc == 0u) { xcd_barrier_complete(bar, b.x, nloc, nx); b.st[0] = nloc; b.st[1] = nx; }
        const unsigned old = xb_add(&bar[XB_XSUB(b.x)], 1u);
        const unsigned gen = old / nloc;
        if (old + 1u == (gen + 1u) * nloc) {
            __builtin_amdgcn_fence(__ATOMIC_RELEASE, "agent");
            asm volatile("s_waitcnt vmcnt(0)" ::: "memory");
            const unsigned og = xb_add(&bar[XB_TOP], 1u);
            const unsigned tg = og / nx;
            if (og + 1u == (tg + 1u) * nx) xb_add(&bar[XB_TOPGEN], 1u);
            else XB_SPIN(xb_ld(&bar[XB_TOPGEN]) == tg, bar);
            __builtin_amdgcn_fence(__ATOMIC_ACQUIRE, "agent");
            xb_add(&bar[XB_XGEN(b.x)], 1u);
            asm volatile("s_waitcnt vmcnt(0)" ::: "memory");
        } else {
            XB_SPIN(xb_ld(&bar[XB_XGEN(b.x)]) == gen, bar);
            __builtin_amdgcn_fence(__ATOMIC_ACQUIRE, "agent");
            asm volatile("s_waitcnt vmcnt(0)" ::: "memory");
        }
    }
    __syncthreads();
}
constexpr int NWAVES = 8, NTHR = 512;
constexpr int DM = 2048, TP = 8192, DB = 128, DS = 4, NSAMP = DB * DS, M = TP + NSAMP;
constexpr int FF = 5504, PASTL = 2048, PAGE = 128, NPAGES = 16;
constexpr int HGH = 8, HGD = 128, HGW = 1024;
constexpr int NH = 16, NKV = 2, GRP = 8, HD = 64, NSAW = 1024, KVW = 128;
constexpr int CMPB = 32, CMPS = 16, CMPH = 256, SLCB = 64, SLCT = 16, WIN = 512;
constexpr int NCP = (TP - CMPB) / CMPS + 1;
constexpr int NCS = (PASTL + DS - CMPB) / CMPS + 1;
constexpr int NSP = TP / SLCB;
constexpr int NSS = (PASTL + DS + SLCB - 1) / SLCB;
constexpr int DIN = 10032, DINP = 10240;
constexpr float EPS = 1e-6f;
constexpr int C_HQ = 0, C_HF = 1024, C_HI = 2048, C_HG = 3072, C_NQ = 4096, C_KV = 5120, C_WN = 5632, C_GA = 5888, C_GB = 7936, C_NG = 9984;
constexpr size_t O_Y = 0, O_KV = (size_t)M * DM, O_WINP = O_KV + (size_t)M * 512, O_WINS = O_WINP + 512 * 256, O_HGP = O_WINS + (size_t)DB * 512 * 256, O_HGS = O_HGP + 131072, O_END = O_HGS + (size_t)DB * 131072;
static_assert(O_END == 56098816, "d_out size");
constexpr size_t MiB = 1u << 20;
constexpr size_t alignup(size_t x) { return (x + MiB - 1) / MiB * MiB; }
constexpr size_t WS_CTL = 0, CTL_ZERO_BYTES = 1 * MiB;
constexpr size_t WS_W1GU = 1 * MiB;
constexpr size_t WS_W1D  = WS_W1GU + alignup((size_t)2 * FF * DM * 2);
constexpr size_t WS_W2GU = WS_W1D + alignup((size_t)DM * FF * 2);
constexpr size_t WS_W2D  = WS_W2GU + alignup((size_t)2 * FF * DM * 2);
constexpr size_t WS_WIN  = WS_W2D + alignup((size_t)DM * FF * 2);
constexpr size_t WS_WPH  = WS_WIN + alignup((size_t)DINP * DM * 2);
constexpr size_t WS_WPN  = WS_WPH + alignup((size_t)DM * 1024 * 2);
constexpr size_t WS_WO   = WS_WPN + alignup((size_t)DM * 1024 * 2);
constexpr size_t WS_XN   = WS_WO + alignup((size_t)DM * DM * 2);
constexpr size_t WS_HB   = WS_XN + alignup((size_t)M * DM * 2);
constexpr size_t WS_Y    = WS_HB + alignup((size_t)M * FF * 2);
constexpr size_t WS_X1   = WS_Y + alignup((size_t)M * DM * 4);
constexpr size_t WS_X2   = WS_X1 + alignup((size_t)M * DM * 4);
constexpr size_t WS_QH   = WS_X2 + alignup((size_t)M * DM * 4);
constexpr size_t WS_LOGF = WS_QH + alignup((size_t)M * 1024 * 4);
constexpr size_t WS_KH   = WS_LOGF + alignup((size_t)M * 1024 * 4);
constexpr size_t WS_VH   = WS_KH + alignup((size_t)M * 1024 * 4);
constexpr size_t WS_GH   = WS_VH + alignup((size_t)M * 1024 * 4);
constexpr size_t WS_QN   = WS_GH + alignup((size_t)M * 1024 * 4);
constexpr size_t WS_WINF = WS_QN + alignup((size_t)M * 1024 * 4);
constexpr size_t WS_NG   = WS_WINF + alignup((size_t)M * 256 * 4);
constexpr size_t WS_GA   = WS_NG + alignup((size_t)M * 48 * 4);
constexpr size_t WS_GB   = WS_GA + alignup((size_t)M * DM * 4);
constexpr size_t WS_KCP  = WS_GB + alignup((size_t)M * DM * 4);
constexpr size_t WS_VCP  = WS_KCP + 1 * MiB;
constexpr size_t WS_KCS  = WS_VCP + 1 * MiB;
constexpr size_t WS_VCS  = WS_KCS + alignup((size_t)DB * 2 * NCS * 64 * 4);
constexpr size_t WS_CB   = WS_VCS + alignup((size_t)DB * 2 * NCS * 64 * 4);
constexpr size_t WS_OHR  = WS_CB + 1 * MiB;
constexpr size_t WS_OHG  = WS_OHR + alignup((size_t)M * 1024 * 4);
constexpr size_t WS_ONSA = WS_OHG + alignup((size_t)M * 1024 * 2);
constexpr size_t WS_T1   = WS_ONSA + alignup((size_t)M * 1024 * 2);
constexpr size_t WS_MIX  = WS_T1 + alignup((size_t)M * DM * 4);
constexpr size_t WS_END  = WS_MIX + alignup((size_t)M * DM * 2);
static_assert(WS_END < (size_t)2600 * MiB, "workspace");
constexpr int CW_TMO = 0, CW_CODE = 1, CW_BAR = 4096;
constexpr int RING_OFF = 0, RING_BYTES = 131072;
constexpr int LDSCTL_OFF = RING_BYTES, MISC_OFF = LDSCTL_OFF + 320;
constexpr int LDS_BYTES = 147456;
namespace pg8 {
__device__ __forceinline__ float sigm(float x) { return __builtin_amdgcn_rcpf(1.f + __expf(-x)); }
#define EPI_FOR(...) _Pragma("unroll") for (int ai = 0; ai < 2; ++ai) _Pragma("unroll") for (int m = 0; m < 4; ++m) { const int row = row0 + ai * 128 + m * 16; \
    _Pragma("unroll") for (int bj = 0; bj < 2; ++bj) _Pragma("unroll") for (int n = 0; n < 2; ++n) { const int cl = cl0 + bj * 128 + 4 * n; f32x4 v = acc[ai][bj][m][n]; __VA_ARGS__ } }
struct EpiSwiglu {
    static constexpr bool PERM = true;
    bf16_t* H; int ldh;
    __device__ __forceinline__ void operator()(const f32x4 (&acc)[2][2][4][2], const Unit& u, int wr, int wc, int fr, int fq) const {
        const int row0 = u.pm * BM + wr * 64 + fr, col = u.pn * 128 + wc * 32 + 8 * fq;
#pragma unroll
        for (int ai = 0; ai < 2; ++ai)
#pragma unroll
            for (int m = 0; m < 4; ++m) { const int row = row0 + ai * 128 + m * 16; float h[8];
#pragma unroll
                for (int n = 0; n < 2; ++n)
#pragma unroll
                    for (int j = 0; j < 4; ++j) { const float g = acc[ai][0][m][n][j], up = acc[ai][1][m][n][j]; h[4 * n + j] = g * sigm(g) * up; }
                u32x4 w; w.x = cvt_pk_bf16(h[0], h[1]); w.y = cvt_pk_bf16(h[2], h[3]); w.z = cvt_pk_bf16(h[4], h[5]); w.w = cvt_pk_bf16(h[6], h[7]);
                *(u32x4*)(H + (size_t)row * ldh + col) = w; }
    }
};
struct EpiF32 {
    static constexpr bool PERM = true;
    float* Y; int ldc;
    __device__ __forceinline__ void operator()(const f32x4 (&acc)[2][2][4][2], const Unit& u, int wr, int wc, int fr, int fq) const {
        const int row0 = u.pm * BM + wr * 64 + fr, cl0 = u.pn * BM + wc * 32 + 8 * fq;
        EPI_FOR( *(f32x4*)(Y + (size_t)row * ldc + cl) = v; )
    }
};
struct EpiGate1 {
    static constexpr bool PERM = true;
    const float* GA; float* T1; int ldc;
    __device__ __forceinline__ void operator()(const f32x4 (&acc)[2][2][4][2], const Unit& u, int wr, int wc, int fr, int fq) const {
        const int row0 = u.pm * BM + wr * 64 + fr, cl0 = u.pn * BM + wc * 32 + 8 * fq;
        EPI_FOR( const f32x4 g = *(const f32x4*)(GA + (size_t)row * ldc + cl); *(f32x4*)(T1 + (size_t)row * ldc + cl) = g * v; )
    }
};
struct EpiGate2 {
    static constexpr bool PERM = true;
    const float* GB; const float* T1; bf16_t* MIX; int ldc;
    __device__ __forceinline__ void operator()(const f32x4 (&acc)[2][2][4][2], const Unit& u, int wr, int wc, int fr, int fq) const {
        const int row0 = u.pm * BM + wr * 64 + fr, cl0 = u.pn * BM + wc * 32 + 8 * fq;
#pragma unroll
        for (int ai = 0; ai < 2; ++ai)
#pragma unroll
            for (int m = 0; m < 4; ++m) { const int row = row0 + ai * 128 + m * 16;
#pragma unroll
                for (int bj = 0; bj < 2; ++bj) { const size_t off = (size_t)row * ldc + cl0 + bj * 128;
                    const f32x4 g0 = *(const f32x4*)(GB + off), g1 = *(const f32x4*)(GB + off + 4), t0 = *(const f32x4*)(T1 + off), t1 = *(const f32x4*)(T1 + off + 4);
                    const f32x4 a = t0 + g0 * acc[ai][bj][m][0], b = t1 + g1 * acc[ai][bj][m][1];
                    u32x4 w; w.x = cvt_pk_bf16(a[0], a[1]); w.y = cvt_pk_bf16(a[2], a[3]); w.z = cvt_pk_bf16(b[0], b[1]); w.w = cvt_pk_bf16(b[2], b[3]);
                    *(u32x4*)(MIX + off) = w; } }
    }
};
struct EpiInProj {
    static constexpr bool PERM = true;
    float *QH, *LOGF, *KH, *VH, *GH, *QN, *KVO, *WINF, *WINP, *WINS, *NG, *GA, *GB; const float* hg_lb;
    __device__ __forceinline__ void operator()(const f32x4 (&acc)[2][2][4][2], const Unit& u, int wr, int wc, int fr, int fq) const {
        const int row0 = u.pm * BM + wr * 64 + fr, cl0 = wc * 32 + 8 * fq, pn = u.pn;
        if (pn < 4) { const int cb = pn * 256;
            EPI_FOR( f32x4 o; for (int j = 0; j < 4; ++j) o[j] = v[j] * sigm(v[j]); *(f32x4*)(QH + (size_t)row * 1024 + cb + cl) = o; )
        } else if (pn < 8) { const int cb = (pn - 4) * 256;
#pragma unroll
            for (int bj = 0; bj < 2; ++bj)
#pragma unroll
                for (int n = 0; n < 2; ++n) { const int c = cb + cl0 + bj * 128 + 4 * n;
                    const f32x4 a0 = *(const f32x4*)(hg_lb + c), a1 = *(const f32x4*)(hg_lb + 1024 + c); f32x4 lb; for (int j = 0; j < 4; ++j) lb[j] = 1.f / (1.f + expf(a1[j] - a0[j]));
#pragma unroll
                    for (int ai = 0; ai < 2; ++ai)
#pragma unroll
                        for (int m = 0; m < 4; ++m) { const int row = row0 + ai * 128 + m * 16; const f32x4 v = acc[ai][bj][m][n]; f32x4 lf, kk;
                            for (int j = 0; j < 4; ++j) { const float sg = 1.f / (1.f + expf(-v[j])), sn = 1.f / (1.f + expf(v[j])); const float f = lb[j] + (1.f - lb[j]) * sg; lf[j] = logf(f); kk[j] = (1.f - lb[j]) * sn; }
                            *(f32x4*)(LOGF + (size_t)row * 1024 + c) = lf; *(f32x4*)(KH + (size_t)row * 1024 + c) = kk; } }
        } else if (pn < 12) { const int cb = (pn - 8) * 256;
            EPI_FOR( *(f32x4*)(VH + (size_t)row * 1024 + cb + cl) = v; )
        } else if (pn < 16) { const int cb = (pn - 12) * 256;
            EPI_FOR( f32x4 o; for (int j = 0; j < 4; ++j) o[j] = v[j] * sigm(v[j]); *(f32x4*)(GH + (size_t)row * 1024 + cb + cl) = o; )
        } else if (pn < 20) { const int cb = (pn - 16) * 256;
            EPI_FOR( *(f32x4*)(QN + (size_t)row * 1024 + cb + cl) = v * 0.125f; )
        } else if (pn < 22) { const int cb = (pn - 20) * 256;
            EPI_FOR( *(f32x4*)(KVO + (size_t)row * 512 + cb + cl) = v; )
        } else if (pn == 22) {
            EPI_FOR( *(f32x4*)(WINF + (size_t)row * 256 + cl) = v;
                     if (row >= 7680 && row < 8192) *(f32x4*)(WINP + (size_t)(row - 7680) * 256 + cl) = v;
                     if (row >= 8192) { const int b = (row - 8192) >> 2, tt = (row - 8192) & 3; *(f32x4*)(WINS + ((size_t)b * 512 + 508 + tt) * 256 + cl) = v; } )
        } else if (pn < 31) { const int cb = (pn - 23) * 256;
            EPI_FOR( f32x4 o; for (int j = 0; j < 4; ++j) o[j] = sigm(v[j]); *(f32x4*)(GA + (size_t)row * 2048 + cb + cl) = o; )
        } else if (pn < 39) { const int cb = (pn - 31) * 256;
            EPI_FOR( f32x4 o; for (int j = 0; j < 4; ++j) o[j] = sigm(v[j]); *(f32x4*)(GB + (size_t)row * 2048 + cb + cl) = o; )
        } else {
            EPI_FOR( if (cl < 48) { f32x4 o; for (int j = 0; j < 4; ++j) o[j] = sigm(v[j]); *(f32x4*)(NG + (size_t)row * 48 + cl) = o; } )
        }
    }
};
#undef EPI_FOR
}
typedef float f4 __attribute__((ext_vector_type(4)));
typedef float f2 __attribute__((ext_vector_type(2)));
typedef unsigned u2 __attribute__((ext_vector_type(2)));
__device__ __forceinline__ float wsum(float v) {
#pragma unroll
    for (int o = 32; o > 0; o >>= 1) v += __shfl_xor(v, o);
    return v;
}
__device__ __forceinline__ float wmax(float v) {
#pragma unroll
    for (int o = 32; o > 0; o >>= 1) v = fmaxf(v, __shfl_xor(v, o));
    return v;
}
struct Ctx { int tid, lane, wave, gw, NGW, G, bid; LAS unsigned char* lds; };

template <int MAP> __device__ __forceinline__ int dest_row(int n) {
    if (MAP == 1) return (n >> 7) * 256 + (n & 127);
    if (MAP == 2) return (n >> 7) * 256 + 128 + (n & 127);
    if (MAP == 3) return n < 5888 ? n : (n < 5936 ? C_NG + (n - 5888) : C_GA + (n - 5936));
    return n;
}
template <int MAP> __device__ __forceinline__ void transpose_item(const float* W, int K, int N, bf16* WT, LAS float* scr, int item, int lane) {
    const int nblk = (N + 31) / 32, kb = item / nblk, nb = item % nblk, k0 = 64 * kb, n0 = 32 * nb;
    const int nn = n0 + (lane & 31);
#pragma unroll 8
    for (int i = 0; i < 32; ++i) { const int kk = 2 * i + (lane >> 5); scr[kk * 33 + (lane & 31)] = nn < N ? W[(size_t)(k0 + kk) * N + nn] : 0.f; }
    LDS_WAIT(); asm volatile("" ::: "memory");
    const int c = lane & 7;
#pragma unroll
    for (int j = 0; j < 4; ++j) { const int n = (lane >> 3) + 8 * j; const LAS float* s = scr + (8 * c) * 33 + n;
        v4u o; o.x = pk2(s[0 * 33], s[1 * 33]); o.y = pk2(s[2 * 33], s[3 * 33]); o.z = pk2(s[4 * 33], s[5 * 33]); o.w = pk2(s[6 * 33], s[7 * 33]);
        if (n0 + n < N) *(GAS v4u*)(WT + (size_t)dest_row<MAP>(n0 + n) * K + k0 + 8 * c) = o; }
    LDS_WAIT(); asm volatile("" ::: "memory");
}
__device__ __forceinline__ void rms_row_to_bf16(const float* xrow, const float* g, bf16* orow, int lane) {
    const f4* xr = (const f4*)xrow + lane; const f4* gr = (const f4*)g + lane;
    f4 v[8]; float s = 0.f;
#pragma unroll
    for (int j = 0; j < 8; ++j) { v[j] = xr[64 * j]; s += (v[j].x * v[j].x + v[j].y * v[j].y) + (v[j].z * v[j].z + v[j].w * v[j].w); }
    const float r = rsqrtf(wsum(s) * (1.f / DM) + EPS);
    unsigned long long* o8 = (unsigned long long*)orow + lane;
#pragma unroll
    for (int j = 0; j < 8; ++j) { const f4 gg = gr[64 * j]; o8[64 * j] = (unsigned long long)pk2(v[j].x * r * gg.x, v[j].y * r * gg.y) | ((unsigned long long)pk2(v[j].z * r * gg.z, v[j].w * r * gg.w) << 32); }
}
__device__ __forceinline__ void norm_mid_row(const float* yrow, const float* xin, const float* gpost, float scale, float* xout, const float* gpre, bf16* xn, int lane) {
    const f4* yr = (const f4*)yrow + lane; const f4* xr = (const f4*)xin + lane; const f4* gp = (const f4*)gpost + lane;
    f4 v[8]; float s = 0.f;
#pragma unroll
    for (int j = 0; j < 8; ++j) { v[j] = yr[64 * j]; s += (v[j].x * v[j].x + v[j].y * v[j].y) + (v[j].z * v[j].z + v[j].w * v[j].w); }
    const float r = rsqrtf(wsum(s) * (1.f / DM) + EPS) * scale;
    float s2 = 0.f;
#pragma unroll
    for (int j = 0; j < 8; ++j) { const f4 xi = xr[64 * j], gg = gp[64 * j]; v[j] = xi + v[j] * gg * r; ((f4*)xout + lane)[64 * j] = v[j];
        s2 += (v[j].x * v[j].x + v[j].y * v[j].y) + (v[j].z * v[j].z + v[j].w * v[j].w); }
    if (xn) {
        const float r2 = rsqrtf(wsum(s2) * (1.f / DM) + EPS); const f4* gr = (const f4*)gpre + lane;
        unsigned long long* o8 = (unsigned long long*)xn + lane;
#pragma unroll
        for (int j = 0; j < 8; ++j) { const f4 gg = gr[64 * j]; o8[64 * j] = (unsigned long long)pk2(v[j].x * r2 * gg.x, v[j].y * r2 * gg.y) | ((unsigned long long)pk2(v[j].z * r2 * gg.z, v[j].w * r2 * gg.w) << 32); }
    }
}

__device__ __forceinline__ void hgrn_seq_unit(int rowbase, int T, int h, int vg, const float* S0, float* Sout, const float* QH, const float* LOGF, const float* KH, const float* VH, float* OHR, int lane) {
    const int kq = lane >> 1, vh = lane & 1, kc = h * 128 + 4 * kq, vc = h * 128 + 8 * vg + 4 * vh;
    f4 s[4];
#pragma unroll
    for (int i = 0; i < 4; ++i) s[i] = S0 ? *(const f4*)(S0 + (size_t)(4 * kq + i) * 128 + 8 * vg + 4 * vh) : (f4){0.f, 0.f, 0.f, 0.f};
#pragma unroll 4
    for (int t = 0; t < T; ++t) {
        const size_t base = (size_t)(rowbase + t) * 1024;
        const f4 q4 = *(const f4*)(QH + base + kc), lf = *(const f4*)(LOGF + base + kc), k4 = *(const f4*)(KH + base + kc), v4 = *(const f4*)(VH + base + vc);
        f4 o = (f4){0.f, 0.f, 0.f, 0.f};
#pragma unroll
        for (int i = 0; i < 4; ++i) { const float f = __expf(lf[i]); s[i] = s[i] * f + v4 * k4[i]; o += s[i] * q4[i]; }
#pragma unroll
        for (int off = 2; off < 64; off <<= 1) { o.x += __shfl_xor(o.x, off); o.y += __shfl_xor(o.y, off); o.z += __shfl_xor(o.z, off); o.w += __shfl_xor(o.w, off); }
        if (kq == 0) *(f4*)(OHR + base + vc) = o;
    }
#pragma unroll
    for (int i = 0; i < 4; ++i) *(f4*)(Sout + (size_t)(4 * kq + i) * 128 + 8 * vg + 4 * vh) = s[i];
}
__device__ __forceinline__ void hgrn_finish_row(const float* orow, const float* grow, const float* gn, bf16* out, int lane) {
#pragma unroll
    for (int j = 0; j < 4; ++j) { const int idx = lane + 64 * j; const f4 o = ((const f4*)orow)[idx], g = ((const f4*)grow)[idx], w = ((const f4*)gn)[idx & 31];
        float s = (o.x * o.x + o.y * o.y) + (o.z * o.z + o.w * o.w);
#pragma unroll
        for (int off = 1; off < 32; off <<= 1) s += __shfl_xor(s, off);
        const float r = rsqrtf(s * (1.f / 128.f) + EPS);
        ((unsigned long long*)out)[idx] = (unsigned long long)pk2(o.x * r * w.x * g.x, o.y * r * w.y * g.y) | ((unsigned long long)pk2(o.z * r * w.z * g.z, o.w * r * w.w * g.w) << 32); }
}

__device__ __forceinline__ float gelu_tanh(float x) { return 0.5f * x * (1.f + tanhf(0.7978845608028654f * (x + 0.044715f * x * x * x))); }
struct CmpArgs { const float* kvo; const float* cache; const int* pt; const float* w1k; const float* w1v; const float* w2k; const float* w2v; const float* cb; unsigned char* ws; };
__device__ __forceinline__ void compress_group(const Ctx& C, const CmpArgs& A, int id) {
    LAS float* SEG = (LAS float*)C.lds;
    LAS float* PART = (LAS float*)(C.lds + 69632);
    LAS float* HID = (LAS float*)(C.lds + 69632 + 32768);
    int type, n, cg, b = -1, NC;
    if (id < 128) { type = id >> 6; n = (id >> 5) & 1; cg = id & 31; NC = NCP; }
    else { const int i2 = id - 128; cg = i2 & 7; n = (i2 >> 3) & 1; b = (i2 >> 4) & 127; type = i2 >> 11; NC = NCS; }
    const int c0 = 16 * cg, L = b < 0 ? TP : PASTL;
    __syncthreads();
    for (int idx = C.tid; idx < 17 * 256; idx += NTHR) { const int pl = idx >> 4, d4 = idx & 15, pos = 16 * c0 + pl; f4 v = (f4){0.f, 0.f, 0.f, 0.f};
        if (pos < L) { const float* src = b < 0 ? A.kvo + (size_t)pos * 512 + type * 128 + n * 64 : A.cache + ((size_t)(A.pt[b * 16 + (pos >> 7)] * 128 + (pos & 127)) * 4 + type) * 128 + n * 64; v = ((const f4*)src)[d4]; }
        ((LAS f4*)SEG)[idx] = v; }
    __syncthreads();
    const int j = C.tid & 255, half = C.tid >> 8;
    float acc[16];
#pragma unroll
    for (int cc = 0; cc < 16; ++cc) acc[cc] = 0.f;
    const float* w1 = (type ? A.w1v : A.w1k) + (size_t)half * 1024 * 256 + j;
    for (int i4 = 0; i4 < 256; ++i4) {
        const float w0 = w1[(size_t)(4 * i4) * 256], wA = w1[(size_t)(4 * i4 + 1) * 256], wB = w1[(size_t)(4 * i4 + 2) * 256], wC = w1[(size_t)(4 * i4 + 3) * 256];
#pragma unroll
        for (int cc = 0; cc < 16; ++cc) { const f4 x = ((const LAS f4*)SEG)[cc * 256 + half * 256 + i4]; acc[cc] += (x.x * w0 + x.y * wA) + (x.z * wB + x.w * wC); }
    }
#pragma unroll
    for (int cc = 0; cc < 16; ++cc) PART[(half * 16 + cc) * 256 + j] = acc[cc];
    __syncthreads();
    for (int idx = C.tid; idx < 4096; idx += NTHR) { const int jj = idx & 255; HID[idx] = gelu_tanh(PART[idx] + PART[4096 + idx] + A.cb[type * 256 + jj]); }
    __syncthreads();
    { const int cc = C.tid >> 5, d2 = (C.tid & 31) * 2; float o0 = 0.f, o1 = 0.f; const float* w2 = (type ? A.w2v : A.w2k) + d2;
        for (int jj = 0; jj < 256; ++jj) { const float hv = HID[cc * 256 + jj]; const f2 w = *(const f2*)(w2 + jj * 64); o0 += hv * w.x; o1 += hv * w.y; }
        const int c = c0 + cc;
        if (c < NC) { const size_t boff = b < 0 ? (type ? WS_VCP : WS_KCP) : (type ? WS_VCS : WS_KCS); const size_t eoff = b < 0 ? ((size_t)n * NCP + c) * 64 : ((size_t)(b * 2 + n) * NCS + c) * 64;
            *(f2*)((float*)(A.ws + boff) + eoff + d2) = (f2){o0, o1}; } }
}

struct KeyBlk { const float* kb; const float* vb; int stride, nk, kpos0, kstep; };
struct NsaArgs { const float* QN; const float* KVO; const float* WINF; const float* NG; const float* cache; const float* cwin; const int* pt; const float* kcp; const float* vcp; const float* kcs; const float* vcs; bf16* ONSA; };
__device__ __forceinline__ void qk_block(const KeyBlk& B, int qpos, int wlim, const float (&slope)[8], const LAS float* qbuf, float (&sv)[8], int lane) {
    const bool inr = lane < B.nk; const int dist = qpos - (B.kpos0 + lane * B.kstep); const bool valid = inr && dist >= 0 && dist < wlim;
    float s[8];
#pragma unroll
    for (int g = 0; g < 8; ++g) s[g] = 0.f;
    if (inr) { const f4* kp = (const f4*)(B.kb + (size_t)lane * B.stride);
#pragma unroll 4
        for (int d4 = 0; d4 < 16; ++d4) { const f4 kk = kp[d4];
#pragma unroll
            for (int g = 0; g < 8; ++g) { const f4 qq = ((const LAS f4*)qbuf)[g * 16 + d4]; s[g] += (qq.x * kk.x + qq.y * kk.y) + (qq.z * kk.z + qq.w * kk.w); } } }
#pragma unroll
    for (int g = 0; g < 8; ++g) sv[g] = valid ? s[g] - slope[g] * (float)dist : -INFINITY;
}
__device__ __forceinline__ void attend_block(const KeyBlk& B, int qpos, int wlim, const float (&slope)[8], const LAS float* qbuf, LAS float* pbuf, float (&m)[8], float (&l)[8], float (&o)[8], int lane) {
    float sv[8];
    qk_block(B, qpos, wlim, slope, qbuf, sv, lane);
#pragma unroll
    for (int g = 0; g < 8; ++g) { const float mn = fmaxf(m[g], wmax(sv[g])); const float p = __expf(sv[g] - mn), a = __expf(m[g] - mn);
        l[g] = l[g] * a + wsum(p); m[g] = mn; o[g] *= a; pbuf[g * 64 + lane] = p; }
    __builtin_amdgcn_wave_barrier(); LDS_WAIT();
    for (int j4 = 0; j4 * 4 < B.nk; ++j4) {
        f4 p4[8];
#pragma unroll
        for (int g = 0; g < 8; ++g) p4[g] = ((const LAS f4*)pbuf)[g * 16 + j4];
#pragma unroll
        for (int jj = 0; jj < 4; ++jj) { const int j = 4 * j4 + jj; const float vv = j < B.nk ? B.vb[(size_t)j * B.stride + lane] : 0.f;
#pragma unroll
            for (int g = 0; g < 8; ++g) o[g] += p4[g][jj] * vv; }
    }
    __builtin_amdgcn_wave_barrier();
}
__device__ __forceinline__ void nsa_unit(const Ctx& C, const NsaArgs& A, int mrow, int n) {
    const int lane = C.lane;
    LAS float* wl = (LAS float*)(C.lds + C.wave * 8192);
    LAS float* qbuf = wl; LAS float* pbuf = wl + 512; LAS float* pbar = wl + 1024; LAS float* scb = wl + 1024 + 544;
    const bool smp = mrow >= TP; const int b = smp ? (mrow - TP) >> 2 : 0, tt = (mrow - TP) & 3; const int qpos = smp ? PASTL + tt : mrow;
    __builtin_amdgcn_wave_barrier();
#pragma unroll
    for (int j = 0; j < 8; ++j) qbuf[lane + 64 * j] = A.QN[(size_t)mrow * 1024 + n * 512 + lane + 64 * j];
    for (int i = lane; i < 544; i += 64) pbar[i] = 0.f;
    float slope[8], m[8], l[8], o[8], oacc[8], inv[8];
#pragma unroll
    for (int g = 0; g < 8; ++g) { slope[g] = exp2f(-0.5f * (float)(n * 8 + g + 1)); oacc[g] = 0.f; }
    const float* gates = A.NG + (size_t)mrow * 48 + n * 24;
    __builtin_amdgcn_wave_barrier(); LDS_WAIT();
#define NSA_INIT() _Pragma("unroll") for (int g = 0; g < 8; ++g) { m[g] = -1e30f; l[g] = 0.f; o[g] = 0.f; }
#define NSA_FIN(br) _Pragma("unroll") for (int g = 0; g < 8; ++g) { inv[g] = 1.f / fmaxf(l[g], 1e-30f); oacc[g] += gates[g * 3 + (br)] * o[g] * inv[g]; }
    const int NC = smp ? NCS : NCP;
    const float* kc = smp ? A.kcs + (size_t)(b * 2 + n) * NCS * 64 : A.kcp + (size_t)n * NCP * 64;
    const float* vc = smp ? A.vcs + (size_t)(b * 2 + n) * NCS * 64 : A.vcp + (size_t)n * NCP * 64;
    int ncv = qpos >= 31 ? (qpos - 31) / 16 + 1 : 0; if (ncv > NC) ncv = NC;
    NSA_INIT();
    for (int c0 = 0; c0 < ncv; c0 += 64) { KeyBlk B{kc + (size_t)c0 * 64, vc + (size_t)c0 * 64, 64, (NC - c0) < 64 ? (NC - c0) : 64, 16 * c0 + 31, 16};
        attend_block(B, qpos, 0x7fffffff, slope, qbuf, pbuf, m, l, o, lane); }
    NSA_FIN(0);
    for (int c0 = 0; c0 < ncv; c0 += 64) { KeyBlk B{kc + (size_t)c0 * 64, vc + (size_t)c0 * 64, 64, (NC - c0) < 64 ? (NC - c0) : 64, 16 * c0 + 31, 16};
        float sv[8]; qk_block(B, qpos, 0x7fffffff, slope, qbuf, sv, lane); float pb = 0.f;
#pragma unroll
        for (int g = 0; g < 8; ++g) pb += __expf(sv[g] - m[g]) * inv[g];
        if (lane < B.nk) pbar[1 + c0 + lane] = pb; }
    __builtin_amdgcn_wave_barrier(); LDS_WAIT();
    const int ns = smp ? NSS : NSP, qblk = qpos >> 6;
    float sc[2]; bool vld[2];
#pragma unroll
    for (int r = 0; r < 2; ++r) { const int blk = lane + 64 * r; vld[r] = blk < ns && blk <= qblk; float s = 0.f;
        if (blk < ns) s = (((pbar[4 * blk] + pbar[4 * blk + 1]) + pbar[4 * blk + 2]) + pbar[4 * blk + 3]) + pbar[4 * blk + 4];
        const bool forced = blk == 0 || blk == qblk || blk == qblk - 1;
        sc[r] = vld[r] ? (forced ? 1.0e4f : s) : -INFINITY; scb[blk] = sc[r]; }
    __builtin_amdgcn_wave_barrier(); LDS_WAIT();
    int rk0 = 0, rk1 = 0;
    for (int i = 0; i < ns; ++i) { const float x = scb[i]; rk0 += (x > sc[0] || (x == sc[0] && i < lane)) ? 1 : 0; rk1 += (x > sc[1] || (x == sc[1] && i < lane + 64)) ? 1 : 0; }
    const unsigned long long sel0 = __ballot(vld[0] && rk0 < SLCT), sel1 = __ballot(vld[1] && rk1 < SLCT);
    NSA_INIT();
    for (int blk = 0; blk <= qblk; ++blk) {
        const bool on = blk < 64 ? ((sel0 >> blk) & 1ull) : ((sel1 >> (blk - 64)) & 1ull);
        if (!on) continue;
        KeyBlk B;
        if (!smp) { const float* base = A.KVO + (size_t)(blk * 64) * 512 + n * 64; B = KeyBlk{base + 256, base + 384, 512, 64, blk * 64, 1}; }
        else if (blk < 32) { const int page = A.pt[b * 16 + (blk >> 1)]; const float* base = A.cache + ((size_t)(page * 128 + (blk & 1) * 64) * 4) * 128 + n * 64; B = KeyBlk{base + 256, base + 384, 512, 64, blk * 64, 1}; }
        else { const float* base = A.KVO + (size_t)(TP + b * 4) * 512 + n * 64; B = KeyBlk{base + 256, base + 384, 512, 4, PASTL, 1}; }
        attend_block(B, qpos, 0x7fffffff, slope, qbuf, pbuf, m, l, o, lane);
    }
    NSA_FIN(1);
    NSA_INIT();
    if (!smp) { int k0 = qpos - (WIN - 1); if (k0 < 0) k0 = 0; k0 &= ~63;
        for (; k0 <= qpos; k0 += 64) { const float* base = A.WINF + (size_t)k0 * 256 + n * 64; KeyBlk B{base, base + 128, 256, 64, k0, 1}; attend_block(B, qpos, WIN, slope, qbuf, pbuf, m, l, o, lane); } }
    else { for (int w0 = 0; w0 < 512; w0 += 64) { const float* base = A.cwin + ((size_t)b * 512 + w0) * 256 + n * 64; KeyBlk B{base, base + 128, 256, 64, PASTL - 512 + w0, 1}; attend_block(B, qpos, WIN, slope, qbuf, pbuf, m, l, o, lane); }
        const float* base = A.WINF + (size_t)(TP + b * 4) * 256 + n * 64; KeyBlk B{base, base + 128, 256, 4, PASTL, 1}; attend_block(B, qpos, WIN, slope, qbuf, pbuf, m, l, o, lane); }
    NSA_FIN(2);
#pragma unroll
    for (int g = 0; g < 8; ++g) A.ONSA[(size_t)mrow * 1024 + (n * 8 + g) * 64 + lane] = (bf16)f2bf(oacc[g]);
#undef NSA_INIT
#undef NSA_FIN
}
constexpr int NPHASE = 13;
struct Args { const void* in[30]; float* out; unsigned char* ws; int ph_lo, ph_hi; };
__global__ void __launch_bounds__(NTHR, 2) mk_fwd(Args args) {
    extern __shared__ __attribute__((aligned(16))) unsigned char lds_raw[];
    Ctx C; C.lds = (LAS unsigned char*)lds_raw; C.tid = threadIdx.x; C.lane = C.tid & 63; C.wave = __builtin_amdgcn_readfirstlane(C.tid >> 6);
    C.G = gridDim.x; C.bid = blockIdx.x; C.gw = C.bid * NWAVES + C.wave; C.NGW = C.G * NWAVES;
    unsigned char* ws = args.ws; float* out = args.out;
    gu32* ctl = (gu32*)(ws + WS_CTL);
    volatile LAS unsigned* MISC = (volatile LAS unsigned*)(C.lds + MISC_OFF);
    for (int u = C.tid; u < (LDS_BYTES - LDSCTL_OFF) / 4; u += NTHR) ((LAS unsigned*)(C.lds + LDSCTL_OFF))[u] = 0u;
    __syncthreads();
    const int lo = args.ph_lo, hi = args.ph_hi;
    XcdBarrier bar; bar.bar = (unsigned*)(ctl + CW_BAR); bar.x = 0; bar.st = nullptr;
    if (hi - lo > 1) bar = xcd_barrier_post((unsigned*)(ctl + CW_BAR), MISC + 8);
#define IN(k) (lo <= (k) && (k) < hi)
#define SEAM(k) do { if (IN(k) && IN((k) + 1)) xcd_barrier(bar); } while (0)
    const float* x_p = (const float*)args.in[0]; const float* x_s = (const float*)args.in[1]; const float* cache_kv = (const float*)args.in[2]; const float* cache_win = (const float*)args.in[3];
    const float* state_hgrn = (const float*)args.in[4]; const int* page_table = (const int*)args.in[5];
    const float* n_pre1 = (const float*)args.in[6]; const float* n_post1 = (const float*)args.in[7]; const float* n_pre2 = (const float*)args.in[11]; const float* n_post2 = (const float*)args.in[12];
    const float* n_pre3 = (const float*)args.in[25]; const float* n_post3 = (const float*)args.in[26];
    const float* hg_lb = (const float*)args.in[14]; const float* hg_gnorm = (const float*)args.in[15];
    bf16* W1GU = (bf16*)(ws + WS_W1GU); bf16* W1D = (bf16*)(ws + WS_W1D); bf16* W2GU = (bf16*)(ws + WS_W2GU); bf16* W2D = (bf16*)(ws + WS_W2D); bf16* WINt = (bf16*)(ws + WS_WIN);
    bf16* WPH = (bf16*)(ws + WS_WPH); bf16* WPN = (bf16*)(ws + WS_WPN); bf16* WOt = (bf16*)(ws + WS_WO);
    bf16* XN = (bf16*)(ws + WS_XN); bf16* HB = (bf16*)(ws + WS_HB); float* Y = (float*)(ws + WS_Y); float* X1 = (float*)(ws + WS_X1); float* X2 = (float*)(ws + WS_X2);
    float* QH = (float*)(ws + WS_QH); float* LOGF = (float*)(ws + WS_LOGF); float* KH = (float*)(ws + WS_KH); float* VH = (float*)(ws + WS_VH); float* GH = (float*)(ws + WS_GH);
    float* QN = (float*)(ws + WS_QN); float* WINF = (float*)(ws + WS_WINF); float* NG = (float*)(ws + WS_NG); float* GA = (float*)(ws + WS_GA); float* GB = (float*)(ws + WS_GB);
    float* KCP = (float*)(ws + WS_KCP); float* VCP = (float*)(ws + WS_VCP); float* KCS = (float*)(ws + WS_KCS); float* VCS = (float*)(ws + WS_VCS); float* CB = (float*)(ws + WS_CB);
    float* OHR = (float*)(ws + WS_OHR); bf16* OHG = (bf16*)(ws + WS_OHG); bf16* ONSA = (bf16*)(ws + WS_ONSA); float* T1 = (float*)(ws + WS_T1); bf16* MIX = (bf16*)(ws + WS_MIX);
    float* KVO = out + O_KV; float* WINP = out + O_WINP; float* WINS = out + O_WINS;

    if (IN(0)) {
        LAS float* scr = (LAS float*)(C.lds + C.wave * 16384);
        constexpr int I_GU = (DM / 64) * (FF / 32), I_D = (FF / 64) * (DM / 32), I_IN = (DM / 64) * ((DIN + 31) / 32), I_P = (1024 / 64) * (DM / 32), I_O = (DM / 64) * (DM / 32);
        constexpr int NITEMS = 4 * I_GU + 2 * I_D + I_IN + 2 * I_P + I_O;
        for (int it = C.gw; it < NITEMS; it += C.NGW) {
            int r = it;
            if (r < I_GU) { transpose_item<1>((const float*)args.in[8], DM, FF, W1GU, scr, r, C.lane); continue; } r -= I_GU;
            if (r < I_GU) { transpose_item<2>((const float*)args.in[9], DM, FF, W1GU, scr, r, C.lane); continue; } r -= I_GU;
            if (r < I_D)  { transpose_item<0>((const float*)args.in[10], FF, DM, W1D, scr, r, C.lane); continue; } r -= I_D;
            if (r < I_IN) { transpose_item<3>((const float*)args.in[13], DM, DIN, WINt, scr, r, C.lane); continue; } r -= I_IN;
            if (r < I_P)  { transpose_item<0>((const float*)args.in[22], 1024, DM, WPH, scr, r, C.lane); continue; } r -= I_P;
            if (r < I_P)  { transpose_item<0>((const float*)args.in[23], 1024, DM, WPN, scr, r, C.lane); continue; } r -= I_P;
            if (r < I_O)  { transpose_item<0>((const float*)args.in[24], DM, DM, WOt, scr, r, C.lane); continue; } r -= I_O;
            if (r < I_GU) { transpose_item<1>((const float*)args.in[27], DM, FF, W2GU, scr, r, C.lane); continue; } r -= I_GU;
            if (r < I_GU) { transpose_item<2>((const float*)args.in[28], DM, FF, W2GU, scr, r, C.lane); continue; } r -= I_GU;
            transpose_item<0>((const float*)args.in[29], FF, DM, W2D, scr, r, C.lane);
        }
        for (int i = C.bid * NTHR + C.tid; i < (DINP - DIN) * DM / 8; i += C.G * NTHR) ((v4u*)(WINt + (size_t)DIN * DM))[i] = (v4u){0u, 0u, 0u, 0u};
        for (int m = C.gw; m < M; m += C.NGW) rms_row_to_bf16(m < TP ? x_p + (size_t)m * DM : x_s + (size_t)(m - TP) * DM, n_pre1, XN + (size_t)m * DM, C.lane);
        for (size_t i = (size_t)C.bid * NTHR + C.tid; i < (size_t)DB * 508 * 64; i += (size_t)C.G * NTHR) { const size_t b = i / (508 * 64), r = i % (508 * 64);
            ((f4*)WINS)[b * 512 * 64 + r] = ((const f4*)cache_win)[b * 512 * 64 + 4 * 64 + r]; }
        if (C.bid < 8) { const int type = C.bid >> 2, jb = C.bid & 3, ig = C.tid >> 6, jl = C.tid & 63; const float* pos = (const float*)args.in[type ? 19 : 16]; const float* w1 = (const float*)args.in[type ? 20 : 17];
            float s = 0.f; for (int i = ig; i < 2048; i += 8) s += pos[i] * w1[(size_t)i * 256 + jb * 64 + jl];
            LAS float* red = (LAS float*)C.lds;
            __syncthreads(); red[C.tid] = s; __syncthreads();
            if (C.tid < 64) { float t = 0.f; for (int k = 0; k < 8; ++k) t += red[k * 64 + C.tid]; CB[type * 256 + jb * 64 + C.tid] = t; }
        }
    }
    SEAM(0);
    if (IN(1)) { pg8::Gemm g{XN, W1GU, M, 2 * FF, DM, DM, DM}; pg8::StaticOrder S; S.init(M, 2 * FF, C.G, C.bid); pg8::EpiSwiglu E{HB, FF};
        pg8::gemm_phase<pg8::EpiSwiglu, pg8::StaticOrder, true>(C.lds + RING_OFF, g, S, E); }
    SEAM(1);
    if (IN(2)) { pg8::Gemm g{HB, W1D, M, DM, FF, FF, FF}; pg8::StaticOrder S; S.init(M, DM, C.G, C.bid); pg8::EpiF32 E{Y, DM};
        pg8::gemm_phase<pg8::EpiF32, pg8::StaticOrder, true>(C.lds + RING_OFF, g, S, E); }
    SEAM(2);
    if (IN(3)) { for (int m = C.gw; m < M; m += C.NGW) norm_mid_row(Y + (size_t)m * DM, m < TP ? x_p + (size_t)m * DM : x_s + (size_t)(m - TP) * DM, n_post1, 0.5f, X1 + (size_t)m * DM, n_pre2, XN + (size_t)m * DM, C.lane); }
    SEAM(3);
    if (IN(4)) { pg8::Gemm g{XN, WINt, M, DINP, DM, DM, DM}; pg8::StaticOrder S; S.init(M, DINP, C.G, C.bid);
        pg8::EpiInProj E{QH, LOGF, KH, VH, GH, QN, KVO, WINF, WINP, WINS, NG, GA, GB, hg_lb};
        pg8::gemm_phase<pg8::EpiInProj, pg8::StaticOrder, true>(C.lds + RING_OFF, g, S, E); }
    SEAM(4);
    if (IN(5)) {
        CmpArgs A{KVO, cache_kv, page_table, (const float*)args.in[17], (const float*)args.in[20], (const float*)args.in[18], (const float*)args.in[21], CB, ws};
        for (int id = C.bid; id < 128 + 4096; id += C.G) compress_group(C, A, id);
        for (int u = C.gw; u < 128 + DB * 128; u += C.NGW) {
            if (u < 128) hgrn_seq_unit(0, TP, u >> 4, u & 15, nullptr, out + O_HGP + (size_t)(u >> 4) * 16384, QH, LOGF, KH, VH, OHR, C.lane);
            else { const int v = u - 128, b = v >> 7, h = (v >> 4) & 7, vg = v & 15;
                hgrn_seq_unit(TP + b * 4, DS, h, vg, state_hgrn + (size_t)b * 131072 + (size_t)h * 16384, out + O_HGS + (size_t)b * 131072 + (size_t)h * 16384, QH, LOGF, KH, VH, OHR, C.lane); }
        }
    }
    SEAM(5);
    if (IN(6)) {
        for (int m = C.gw; m < M; m += C.NGW) hgrn_finish_row(OHR + (size_t)m * 1024, GH + (size_t)m * 1024, hg_gnorm, OHG + (size_t)m * 1024, C.lane);
        NsaArgs A{QN, KVO, WINF, NG, cache_kv, cache_win, page_table, KCP, VCP, KCS, VCS, ONSA};
        for (int u = C.gw; u < 2 * M; u += C.NGW) { const int uu = 2 * M - 1 - u; nsa_unit(C, A, uu >> 1, uu & 1); }
    }
    SEAM(6);
    if (IN(7)) { pg8::StaticOrder S; S.init(M, DM, C.G, C.bid);
        { pg8::Gemm g{OHG, WPH, M, DM, 1024, 1024, 1024}; pg8::EpiGate1 E{GA, T1, DM}; pg8::gemm_phase<pg8::EpiGate1, pg8::StaticOrder, true>(C.lds + RING_OFF, g, S, E); }
        { pg8::Gemm g{ONSA, WPN, M, DM, 1024, 1024, 1024}; pg8::EpiGate2 E{GB, T1, MIX, DM}; pg8::gemm_phase<pg8::EpiGate2, pg8::StaticOrder, true>(C.lds + RING_OFF, g, S, E); } }
    SEAM(7);
    if (IN(8)) { pg8::Gemm g{MIX, WOt, M, DM, DM, DM, DM}; pg8::StaticOrder S; S.init(M, DM, C.G, C.bid); pg8::EpiF32 E{Y, DM};
        pg8::gemm_phase<pg8::EpiF32, pg8::StaticOrder, true>(C.lds + RING_OFF, g, S, E); }
    SEAM(8);
    if (IN(9)) { for (int m = C.gw; m < M; m += C.NGW) norm_mid_row(Y + (size_t)m * DM, X1 + (size_t)m * DM, n_post2, 1.0f, X2 + (size_t)m * DM, n_pre3, XN + (size_t)m * DM, C.lane); }
    SEAM(9);
    if (IN(10)) { pg8::Gemm g{XN, W2GU, M, 2 * FF, DM, DM, DM}; pg8::StaticOrder S; S.init(M, 2 * FF, C.G, C.bid); pg8::EpiSwiglu E{HB, FF};
        pg8::gemm_phase<pg8::EpiSwiglu, pg8::StaticOrder, true>(C.lds + RING_OFF, g, S, E); }
    SEAM(10);
    if (IN(11)) { pg8::Gemm g{HB, W2D, M, DM, FF, FF, FF}; pg8::StaticOrder S; S.init(M, DM, C.G, C.bid); pg8::EpiF32 E{Y, DM};
        pg8::gemm_phase<pg8::EpiF32, pg8::StaticOrder, true>(C.lds + RING_OFF, g, S, E); }
    SEAM(11);
    if (IN(12)) { for (int m = C.gw; m < M; m += C.NGW) norm_mid_row(Y + (size_t)m * DM, X2 + (size_t)m * DM, n_post3, 0.5f, out + O_Y + (size_t)m * DM, nullptr, nullptr, C.lane); }
#undef IN
#undef SEAM
}

#ifndef MK_ONE_LAUNCH
#define MK_ONE_LAUNCH 1
#endif
extern "C" void kernel_launch(void* const* d_in, const int* in_sizes, int n_in, void* d_out, int out_size, void* d_ws, size_t ws_size, hipStream_t stream) {
    static int grid = 0;
    if (grid == 0) {
        if (n_in != 30 || out_size != (int)O_END || ws_size < WS_END) { fprintf(stderr, "kernel_launch: unexpected sizes (n_in %d out %d ws %zu)\n", n_in, out_size, ws_size); grid = -1; return; }
        int dev = 0, cus = 0, per_cu = 0;
        if (hipGetDevice(&dev) != hipSuccess || hipDeviceGetAttribute(&cus, hipDeviceAttributeMultiprocessorCount, dev) != hipSuccess) { grid = -1; return; }
        if (hipFuncSetAttribute((const void*)mk_fwd, hipFuncAttributeMaxDynamicSharedMemorySize, LDS_BYTES) != hipSuccess) { fprintf(stderr, "kernel_launch: hipFuncSetAttribute failed\n"); grid = -1; return; }
        if (hipOccupancyMaxActiveBlocksPerMultiprocessor(&per_cu, (const void*)mk_fwd, NTHR, LDS_BYTES) != hipSuccess || per_cu < 1) { fprintf(stderr, "kernel_launch: occupancy query says %d\n", per_cu); }
        (void)hipGetLastError();
        grid = cus;
    }
    if (grid < 0) return;
    (void)hipMemsetAsync((char*)d_ws + WS_CTL, 0, CTL_ZERO_BYTES, stream);
    Args a{};
    for (int i = 0; i < 30; ++i) a.in[i] = d_in[i];
    a.out = (float*)d_out; a.ws = (unsigned char*)d_ws;
#if MK_ONE_LAUNCH
    a.ph_lo = 0; a.ph_hi = NPHASE;
    hipLaunchKernelGGL(mk_fwd, dim3(grid), dim3(NTHR), LDS_BYTES, stream, a);
#else
    for (int p = 0; p < NPHASE; ++p) { a.ph_lo = p; a.ph_hi = p + 1; hipLaunchKernelGGL(mk_fwd, dim3(grid), dim3(NTHR), LDS_BYTES, stream, a); }
#endif
}
```

```cpp
#include <hip/hip_runtime.h>
#include <cstdio>
#include <cstdint>
#ifndef PROBE_MASK
#define PROBE_MASK 0
#endif
#ifndef PROBE_K
#define PROBE_K 1
#endif
#ifndef PROBE_SUB
#define PROBE_SUB 0
#endif
#if PROBE_MASK
#define STAMP(C, id) do { __syncthreads(); if ((C).tid == 0) { volatile __attribute__((address_space(3))) unsigned long long* P_ = (volatile __attribute__((address_space(3))) unsigned long long*)((C).lds + 131072 + 320 + 256); \
    const unsigned long long t_ = __builtin_amdgcn_s_memrealtime(); P_[id] += t_ - P_[0]; P_[0] = t_; } } while (0)
#else
#define STAMP(C, id) do {} while (0)
#endif
namespace pg8 {
#define PG8_LAS __attribute__((address_space(3)))
typedef unsigned short bf16_t;
typedef short bf16x8 __attribute__((ext_vector_type(8)));
typedef float f32x4 __attribute__((ext_vector_type(4)));
typedef unsigned u32x4 __attribute__((ext_vector_type(4)));
constexpr int BM = 256, BK = 64, HALF = 128, HTB = HALF * BK * 2  , STAGE_BYTES = 8 * HTB, NXCD = 8, WGM = 8;

__host__ __device__ __forceinline__ int lds_byte(int r, int c) { const int st = (r >> 4) * 2 + (c >> 5), rr = r & 15, cc = c & 31, ob = rr * 64 + cc * 2; return st * 1024 + (ob ^ (((ob >> 9) & 1) << 5)); }
__host__ __device__ __forceinline__ void stage_rc(int b, int& R, int& C) { const int st = b / 1024, sb = b % 1024, swz = sb ^ (((sb >> 9) & 1) << 5); R = (st >> 1) * 16 + swz / 64; C = (st & 1) * 32 + (swz % 64) / 2; }
__host__ __device__ __forceinline__ int perm32(int rho) { const int n = rho >> 4, i = rho & 15; return 8 * (i >> 2) + 4 * n + (i & 3); }

struct Unit { int pm, pn; };
struct Gemm { const bf16_t* A; const bf16_t* Bt; int M, N, K, lda, ldb; };

struct StaticOrder {
    int nM, nN, nwg, G, c;
    __host__ __device__ void init(int M, int N, int G_, int c_) { nM = M / BM; nN = N / BM; nwg = nM * nN; G = G_; c = c_; }
    __host__ __device__ bool next(int i, Unit& u) const {
        const long L = (long)i * G + c; if (L >= nwg) return false;
        int wgid = (int)L; { const int q = nwg / NXCD, r = nwg % NXCD, xcd = wgid % NXCD, off = wgid / NXCD; wgid = (xcd < r ? xcd * (q + 1) : r * (q + 1) + (xcd - r) * q) + off; }
        const int nig = WGM * nN, gid = wgid / nig, fm = gid * WGM, gsz = (nM - fm) < WGM ? (nM - fm) : WGM;
        u.pm = fm + ((wgid % nig) % gsz); u.pn = (wgid % nig) / gsz; return true;
    }
    __device__ __forceinline__ void a_ready(const Unit&) const {}
    __device__ __forceinline__ void done(const Unit&) const {}
};

typedef float cvt_f32x2 __attribute__((ext_vector_type(2))); typedef __bf16 cvt_bf16x2 __attribute__((ext_vector_type(2)));
__device__ __forceinline__ unsigned cvt_pk_bf16(float lo, float hi) { const cvt_f32x2 v = {lo, hi}; const cvt_bf16x2 b = __builtin_convertvector(v, cvt_bf16x2); return __builtin_bit_cast(unsigned, b); }
typedef float f32x2 __attribute__((ext_vector_type(2)));
template <class Epi, class Sched, bool ALIGN_EPI = false>
__device__ __forceinline__ void gemm_phase(PG8_LAS unsigned char* lds, const Gemm g, const Sched& S, const Epi& E) {
    int tid = threadIdx.x; asm volatile("" : "+v"(tid));
    const int wid = __builtin_amdgcn_readfirstlane(tid >> 6), lane = tid & 63, wr = wid >> 2, wc = wid & 3, fr = lane & 15, fq = lane >> 4;
    const int K = g.K, nt = K / BK;
    unsigned voffA, voffB;
    { int R, C; stage_rc(tid * 16, R, C); const int Rb = Epi::PERM ? ((R & ~31) + perm32(R & 31)) : R; voffA = (unsigned)(R * g.lda + C) * 2u; voffB = (unsigned)(Rb * g.ldb + C) * 2u; }
    const size_t r64A = (size_t)64 * g.lda * 2, r64B = (size_t)64 * g.ldb * 2;
    const size_t kstep = (size_t)(BK * 2);
    const size_t hstepA = (size_t)HALF * g.lda * 2, hstepB = (size_t)HALF * g.ldb * 2;
    const size_t tstepA = 2 * hstepA, tstepB = 2 * hstepB;
    const unsigned ldsw = (unsigned)wid * 1024u;
    const int aoff = lds_byte(wr * 64 + fr, fq * 8), boff = lds_byte(wc * 32 + fr, fq * 8);
#define PG8_SA(b, h) (((b) * 2 + (h)) * HTB)
#define PG8_SB(b, h) ((4 + (b) * 2 + (h)) * HTB)
#define PG8_STAGE(bufoff, gbase, sfx) do { _Pragma("unroll") for (int _i = 0; _i < 2; ++_i) \
        __builtin_amdgcn_global_load_lds((const unsigned*)((const char*)(gbase) + (size_t)_i * r64##sfx + voff##sfx), (PG8_LAS unsigned*)(lds + (bufoff) + ldsw + _i * 8192), 16, 0, 0); } while (0)
#define PG8_LDA(dst, b, h) do { _Pragma("unroll") for (int m = 0; m < 4; ++m) _Pragma("unroll") for (int k = 0; k < 2; ++k) dst[m][k] = *(const PG8_LAS bf16x8*)(lds + PG8_SA(b, h) + aoff + m * 2048 + k * 1024); } while (0)
#define PG8_LDB(dst, b, h) do { _Pragma("unroll") for (int n = 0; n < 2; ++n) _Pragma("unroll") for (int k = 0; k < 2; ++k) dst[n][k] = *(const PG8_LAS bf16x8*)(lds + PG8_SB(b, h) + boff + n * 2048 + k * 1024); } while (0)
#define PG8_MMA(ai, bj, At, Bt) do { __builtin_amdgcn_s_setprio(1); _Pragma("unroll") for (int m = 0; m < 4; ++m) _Pragma("unroll") for (int n = 0; n < 2; ++n) _Pragma("unroll") for (int k = 0; k < 2; ++k) \
        acc[ai][bj][m][n] = __builtin_amdgcn_mfma_f32_16x16x32_bf16(Bt[n][k], At[m][k], acc[ai][bj][m][n], 0, 0, 0); __builtin_amdgcn_s_setprio(0); } while (0)
#define PG8_WAIT_V(n) asm volatile("s_waitcnt vmcnt(" #n ")" ::: "memory")
#define PG8_WAIT_L(n) asm volatile("s_waitcnt lgkmcnt(" #n ")" ::: "memory")
#define PG8_BAR __builtin_amdgcn_s_barrier()
#define PG8_SCHED __builtin_amdgcn_sched_barrier(0)
    Unit cur, nxt; int ui = 0;
    if (!S.next(0, cur)) return;
    f32x4 acc[2][2][4][2];
#pragma unroll
    for (int a = 0; a < 2; ++a)
#pragma unroll
        for (int b = 0; b < 2; ++b)
#pragma unroll
            for (int m = 0; m < 4; ++m)
#pragma unroll
                for (int n = 0; n < 2; ++n) acc[a][b][m][n] = (f32x4){0.f, 0.f, 0.f, 0.f};
    bf16x8 At[4][2], B0[2][2], B1[2][2];
    const char* cA = (const char*)g.A + (size_t)cur.pm * tstepA; const char* cB = (const char*)g.Bt + (size_t)cur.pn * tstepB;
    S.a_ready(cur);
    PG8_STAGE(PG8_SB(0, 0), cB, B); PG8_STAGE(PG8_SB(0, 1), cB + hstepB, B); PG8_STAGE(PG8_SA(0, 0), cA, A); PG8_STAGE(PG8_SA(0, 1), cA + hstepA, A);
    if (wr == 1) PG8_BAR;
    PG8_WAIT_V(2); PG8_BAR;
    PG8_STAGE(PG8_SB(1, 0), cB + kstep, B); PG8_STAGE(PG8_SA(1, 0), cA + kstep, A); PG8_STAGE(PG8_SB(1, 1), cB + hstepB + kstep, B);
    PG8_WAIT_V(6); PG8_BAR;
    for (;;) {
        const bool has_next = S.next(ui + 1, nxt);
        const char* nA = has_next ? (const char*)g.A + (size_t)nxt.pm * tstepA : cA; const char* nB = has_next ? (const char*)g.Bt + (size_t)nxt.pn * tstepB : cB;
        for (int t = 0; t < nt; t += 2) {
            const bool last = (t == nt - 2);
            const char* a1 = cA + (size_t)(t + 1) * kstep;
            const char* a2 = last ? nA : cA + (size_t)(t + 2) * kstep; const char* b2 = last ? nB : cB + (size_t)(t + 2) * kstep;
            const char* a3 = a2 + kstep; const char* b3 = b2 + kstep;
            if (last && has_next) S.a_ready(nxt);
            PG8_LDB(B0, 0, 0); PG8_LDB(B1, 0, 1); PG8_SCHED; PG8_LDA(At, 0, 0); PG8_STAGE(PG8_SA(1, 1), a1 + hstepA, A);
            PG8_WAIT_V(8); PG8_WAIT_L(0); PG8_BAR; PG8_MMA(0, 0, At, B0); PG8_MMA(0, 1, At, B1); PG8_BAR; PG8_SCHED;
            PG8_LDA(At, 0, 1); PG8_STAGE(PG8_SB(0, 0), b2, B); PG8_STAGE(PG8_SB(0, 1), b2 + hstepB, B); PG8_STAGE(PG8_SA(0, 0), a2, A);
            PG8_WAIT_V(8); PG8_WAIT_L(0); PG8_BAR; PG8_MMA(1, 0, At, B0); PG8_MMA(1, 1, At, B1); PG8_BAR; PG8_SCHED;
            PG8_LDB(B0, 1, 0); PG8_LDB(B1, 1, 1); PG8_SCHED; PG8_LDA(At, 1, 0); PG8_STAGE(PG8_SA(0, 1), a2 + hstepA, A);
            PG8_WAIT_V(8); PG8_WAIT_L(0); PG8_BAR; PG8_MMA(0, 0, At, B0); PG8_MMA(0, 1, At, B1); PG8_BAR; PG8_SCHED;
            PG8_LDA(At, 1, 1); PG8_STAGE(PG8_SB(1, 0), b3, B); PG8_STAGE(PG8_SB(1, 1), b3 + hstepB, B); PG8_STAGE(PG8_SA(1, 0), a3, A);
            PG8_WAIT_V(8); PG8_WAIT_L(0); PG8_BAR; PG8_MMA(1, 0, At, B0); PG8_MMA(1, 1, At, B1); PG8_BAR; PG8_SCHED;
        }
        if constexpr (ALIGN_EPI) { if (wr == 0) PG8_BAR; }
        E(acc, cur, wr, wc, fr, fq); S.done(cur);
        if (!has_next) break;
#pragma unroll
        for (int a = 0; a < 2; ++a)
#pragma unroll
            for (int b = 0; b < 2; ++b)
#pragma unroll
                for (int m = 0; m < 4; ++m)
#pragma unroll
                    for (int n = 0; n < 2; ++n) acc[a][b][m][n] = (f32x4){0.f, 0.f, 0.f, 0.f};
        cur = nxt; cA = nA; cB = nB; ++ui;
        if constexpr (ALIGN_EPI) { if (wr == 1) PG8_BAR; }
    }
    PG8_WAIT_V(0);
    if constexpr (!ALIGN_EPI) { if (wr == 0) PG8_BAR; }
    PG8_BAR;
#undef PG8_SA
#undef PG8_SB
#undef PG8_STAGE
#undef PG8_LDA
#undef PG8_LDB
#undef PG8_MMA
#undef PG8_WAIT_V
#undef PG8_WAIT_L
#undef PG8_BAR
#undef PG8_SCHED
}

struct UnitG : Unit { const char* A; const char* B; int nt, kind, aux; };
template <class Epi, class Sched, bool ALIGN_EPI = false>
__device__ __forceinline__ void gemm_phase_g(PG8_LAS unsigned char* lds, int lda, int ldb, const Sched& S, const Epi& E) {
    int tid = threadIdx.x; asm volatile("" : "+v"(tid));
    const int wid = __builtin_amdgcn_readfirstlane(tid >> 6), lane = tid & 63, wr = wid >> 2, wc = wid & 3, fr = lane & 15, fq = lane >> 4;
    unsigned voffA, voffB;
    { int R, C; stage_rc(tid * 16, R, C); const int Rb = Epi::PERM ? ((R & ~31) + perm32(R & 31)) : R; voffA = (unsigned)(R * lda + C) * 2u; voffB = (unsigned)(Rb * ldb + C) * 2u; }
    const size_t r64A = (size_t)64 * lda * 2, r64B = (size_t)64 * ldb * 2;
    const size_t kstep = (size_t)(BK * 2);
    const size_t hstepA = (size_t)HALF * lda * 2, hstepB = (size_t)HALF * ldb * 2;
    const size_t tstepA = 2 * hstepA, tstepB = 2 * hstepB;
    const unsigned ldsw = (unsigned)wid * 1024u;
    const int aoff = lds_byte(wr * 64 + fr, fq * 8), boff = lds_byte(wc * 32 + fr, fq * 8);
#define PG8_SA(b, h) (((b) * 2 + (h)) * HTB)
#define PG8_SB(b, h) ((4 + (b) * 2 + (h)) * HTB)
#define PG8_STAGE(bufoff, gbase, sfx) do { _Pragma("unroll") for (int _i = 0; _i < 2; ++_i) \
        __builtin_amdgcn_global_load_lds((const unsigned*)((const char*)(gbase) + (size_t)_i * r64##sfx + voff##sfx), (PG8_LAS unsigned*)(lds + (bufoff) + ldsw + _i * 8192), 16, 0, 0); } while (0)
#define PG8_LDA(dst, b, h) do { _Pragma("unroll") for (int m = 0; m < 4; ++m) _Pragma("unroll") for (int k = 0; k < 2; ++k) dst[m][k] = *(const PG8_LAS bf16x8*)(lds + PG8_SA(b, h) + aoff + m * 2048 + k * 1024); } while (0)
#define PG8_LDB(dst, b, h) do { _Pragma("unroll") for (int n = 0; n < 2; ++n) _Pragma("unroll") for (int k = 0; k < 2; ++k) dst[n][k] = *(const PG8_LAS bf16x8*)(lds + PG8_SB(b, h) + boff + n * 2048 + k * 1024); } while (0)
#define PG8_MMA(ai, bj, At, Bt) do { __builtin_amdgcn_s_setprio(1); _Pragma("unroll") for (int m = 0; m < 4; ++m) _Pragma("unroll") for (int n = 0; n < 2; ++n) _Pragma("unroll") for (int k = 0; k < 2; ++k) \
        acc[ai][bj][m][n] = __builtin_amdgcn_mfma_f32_16x16x32_bf16(Bt[n][k], At[m][k], acc[ai][bj][m][n], 0, 0, 0); __builtin_amdgcn_s_setprio(0); } while (0)
#define PG8_WAIT_V(n) asm volatile("s_waitcnt vmcnt(" #n ")" ::: "memory")
#define PG8_WAIT_L(n) asm volatile("s_waitcnt lgkmcnt(" #n ")" ::: "memory")
#define PG8_BAR __builtin_amdgcn_s_barrier()
#define PG8_SCHED __builtin_amdgcn_sched_barrier(0)
    UnitG cur, nxt; int ui = 0;
    if (!S.next(0, cur)) return;
    f32x4 acc[2][2][4][2];
#pragma unroll
    for (int a = 0; a < 2; ++a)
#pragma unroll
        for (int b = 0; b < 2; ++b)
#pragma unroll
            for (int m = 0; m < 4; ++m)
#pragma unroll
                for (int n = 0; n < 2; ++n) acc[a][b][m][n] = (f32x4){0.f, 0.f, 0.f, 0.f};
    bf16x8 At[4][2], B0[2][2], B1[2][2];
    const char* cA = cur.A; const char* cB = cur.B;
    S.a_ready(cur);
    PG8_STAGE(PG8_SB(0, 0), cB, B); PG8_STAGE(PG8_SB(0, 1), cB + hstepB, B); PG8_STAGE(PG8_SA(0, 0), cA, A); PG8_STAGE(PG8_SA(0, 1), cA + hstepA, A);
    if (wr == 1) PG8_BAR;
    PG8_WAIT_V(2); PG8_BAR;
    PG8_STAGE(PG8_SB(1, 0), cB + kstep, B); PG8_STAGE(PG8_SA(1, 0), cA + kstep, A); PG8_STAGE(PG8_SB(1, 1), cB + hstepB + kstep, B);
    PG8_WAIT_V(6); PG8_BAR;
    for (;;) {
        const bool has_next = S.next(ui + 1, nxt);
        const char* nA = has_next ? nxt.A : cA; const char* nB = has_next ? nxt.B : cB; const int nt = cur.nt;
        for (int t = 0; t < nt; t += 2) {
            const bool last = (t == nt - 2);
            const char* a1 = cA + (size_t)(t + 1) * kstep;
            const char* a2 = last ? nA : cA + (size_t)(t + 2) * kstep; const char* b2 = last ? nB : cB + (size_t)(t + 2) * kstep;
            const char* a3 = a2 + kstep; const char* b3 = b2 + kstep;
            if (last && has_next) S.a_ready(nxt);
            PG8_LDB(B0, 0, 0); PG8_LDB(B1, 0, 1); PG8_SCHED; PG8_LDA(At, 0, 0); PG8_STAGE(PG8_SA(1, 1), a1 + hstepA, A);
            PG8_WAIT_V(8); PG8_WAIT_L(0); PG8_BAR; PG8_MMA(0, 0, At, B0); PG8_MMA(0, 1, At, B1); PG8_BAR; PG8_SCHED;
            PG8_LDA(At, 0, 1); PG8_STAGE(PG8_SB(0, 0), b2, B); PG8_STAGE(PG8_SB(0, 1), b2 + hstepB, B); PG8_STAGE(PG8_SA(0, 0), a2, A);
            PG8_WAIT_V(8); PG8_WAIT_L(0); PG8_BAR; PG8_MMA(1, 0, At, B0); PG8_MMA(1, 1, At, B1); PG8_BAR; PG8_SCHED;
            PG8_LDB(B0, 1, 0); PG8_LDB(B1, 1, 1); PG8_SCHED; PG8_LDA(At, 1, 0); PG8_STAGE(PG8_SA(0, 1), a2 + hstepA, A);
            PG8_WAIT_V(8); PG8_WAIT_L(0); PG8_BAR; PG8_MMA(0, 0, At, B0); PG8_MMA(0, 1, At, B1); PG8_BAR; PG8_SCHED;
            PG8_LDA(At, 1, 1); PG8_STAGE(PG8_SB(1, 0), b3, B); PG8_STAGE(PG8_SB(1, 1), b3 + hstepB, B); PG8_STAGE(PG8_SA(1, 0), a3, A);
            PG8_WAIT_V(8); PG8_WAIT_L(0); PG8_BAR; PG8_MMA(1, 0, At, B0); PG8_MMA(1, 1, At, B1); PG8_BAR; PG8_SCHED;
        }
        if constexpr (ALIGN_EPI) { if (wr == 0) PG8_BAR; }
        E(acc, cur, wr, wc, fr, fq); S.done(cur);
        if (!has_next) break;
#pragma unroll
        for (int a = 0; a < 2; ++a)
#pragma unroll
            for (int b = 0; b < 2; ++b)
#pragma unroll
                for (int m = 0; m < 4; ++m)
#pragma unroll
                    for (int n = 0; n < 2; ++n) acc[a][b][m][n] = (f32x4){0.f, 0.f, 0.f, 0.f};
        cur = nxt; cA = nA; cB = nB; ++ui;
        if constexpr (ALIGN_EPI) { if (wr == 1) PG8_BAR; }
    }
    PG8_WAIT_V(0);
    if constexpr (!ALIGN_EPI) { if (wr == 0) PG8_BAR; }
    PG8_BAR;
#undef PG8_SA
#undef PG8_SB
#undef PG8_STAGE
#undef PG8_LDA
#undef PG8_LDB
#undef PG8_MMA
#undef PG8_WAIT_V
#undef PG8_WAIT_L
#undef PG8_BAR
#undef PG8_SCHED
}
}
#define GAS __attribute__((address_space(1)))
#define LAS __attribute__((address_space(3)))
typedef unsigned short bf16;
typedef unsigned v4u __attribute__((ext_vector_type(4)));
typedef float f32x4 __attribute__((ext_vector_type(4)));
typedef short bf16x8 __attribute__((ext_vector_type(8)));
typedef GAS unsigned gu32;
typedef GAS unsigned long long gu64;
#define RLX_AGENT __ATOMIC_RELAXED, __HIP_MEMORY_SCOPE_AGENT
#define LDS_WAIT() asm volatile("s_waitcnt lgkmcnt(0)" ::: "memory")
#define VM_WAIT() asm volatile("s_waitcnt vmcnt(0)" ::: "memory")
__device__ __forceinline__ unsigned long long rt() { return __builtin_amdgcn_s_memrealtime(); }
__device__ __forceinline__ unsigned f2bf(float f) { unsigned u = __builtin_bit_cast(unsigned, f); return (u + 0x7fffu + ((u >> 16) & 1u)) >> 16; }
__device__ __forceinline__ unsigned pk2(float lo, float hi) { return f2bf(lo) | (f2bf(hi) << 16); }

#define XB_TMO      128
#define XB_XCNT(j)  (256  + 64 * (j))
#define XB_XSUB(j)  (1280 + 64 * (j))
#define XB_XGEN(j)  (2304 + 64 * (j))
#define XB_TOP      3328
#define XB_TOPGEN   3392
#define XCD_BAR_WORDS 3456
#define XB_SPIN_CAP (1u << 18)

__device__ __forceinline__ unsigned xb_ld(unsigned* p)              { return __hip_atomic_load(p, __ATOMIC_RELAXED, __HIP_MEMORY_SCOPE_AGENT); }
__device__ __forceinline__ unsigned xb_add(unsigned* p, unsigned v) { return __hip_atomic_fetch_add(p, v, __ATOMIC_RELAXED, __HIP_MEMORY_SCOPE_AGENT); }
__device__ __forceinline__ unsigned xb_xcc_id() { return (unsigned)__builtin_amdgcn_s_getreg((3 << 11) | 20) & 0xFu; }
#define XB_SPIN(cond, bar) do { unsigned _sp = 0; while (cond) { __builtin_amdgcn_s_sleep(1); \
    if ((++_sp & 255u) == 0u) { if (xb_ld(&(bar)[XB_TMO])) break; if (_sp > XB_SPIN_CAP) { atomicAdd(&(bar)[XB_TMO], 1u); break; } } } } while (0)

struct XcdBarrier {
    unsigned* bar; unsigned x;
    volatile LAS unsigned* st;
};

__device__ __forceinline__ XcdBarrier xcd_barrier_post(unsigned* bar, volatile LAS unsigned* st) {
    XcdBarrier b; b.bar = bar; b.x = xb_xcc_id(); b.st = st;
    if (threadIdx.x == 0) (void)xb_add(&bar[XB_XCNT(b.x)], 1u);
    return b;
}
__device__ __forceinline__ void xcd_barrier_complete(unsigned* bar, unsigned x, unsigned& nloc, unsigned& nx) {
    const unsigned G = gridDim.x * gridDim.y * gridDim.z;
    unsigned sum, cnt, mine, sp = 0u;
    for (;;) {
        sum = 0u; cnt = 0u; mine = 0u;
#pragma unroll
        for (unsigned j = 0; j < 16; ++j) { const unsigned c = xb_ld(&bar[XB_XCNT(j)]); sum += c; cnt += (c > 0u) ? 1u : 0u; mine = (j == x) ? c : mine; }
        if (sum == G) break;
        __builtin_amdgcn_s_sleep(1);
        if ((++sp & 255u) == 0u) { if (xb_ld(&bar[XB_TMO])) break; if (sp > XB_SPIN_CAP) { atomicAdd(&bar[XB_TMO], 1u); break; } }
    }
    nloc = mine > 0u ? mine : 1u; nx = cnt > 0u ? cnt : 1u;
}

__device__ __forceinline__ void xcd_barrier(const XcdBarrier& b) {
    asm volatile("s_waitcnt vmcnt(0)" ::: "memory");
    __syncthreads();
    if (threadIdx.x == 0) {
        unsigned* bar = b.bar;
        __builtin_amdgcn_s_waitcnt(0);
        unsigned nloc = b.st[0], nx = b.st[1];
        if (nloc == 0u) { xcd_barrier_complete(bar, b.x, nloc, nx); b.st[0] = nloc; b.st[1] = nx; }
        const unsigned old = xb_add(&bar[XB_XSUB(b.x)], 1u);
        const unsigned gen = old / nloc;
        if (old + 1u == (gen + 1u) * nloc) {
            __builtin_amdgcn_fence(__ATOMIC_RELEASE, "agent");
            asm volatile("s_waitcnt vmcnt(0)" ::: "memory");
            const unsigned og = xb_add(&bar[XB_TOP], 1u);
            const unsigned tg = og / nx;
            if (og + 1u == (tg + 1u) * nx) xb_add(&bar[XB_TOPGEN], 1u);
            else XB_SPIN(xb_ld(&bar[XB_TOPGEN]) == tg, bar);
            __builtin_amdgcn_fence(__ATOMIC_ACQUIRE, "agent");
            xb_add(&bar[XB_XGEN(b.x)], 1u);
            asm volatile("s_waitcnt vmcnt(0)" ::: "memory");
        } else {
            XB_SPIN(xb_ld(&bar[XB_XGEN(b.x)]) == gen, bar);
            __builtin_amdgcn_fence(__ATOMIC_ACQUIRE, "agent");
            asm volatile("s_waitcnt vmcnt(0)" ::: "memory");
        }
    }
    __syncthreads();
}
constexpr int NWAVES = 8, NTHR = 512;
constexpr int DM = 2048, TP = 8192, DB = 128, DS = 4, NSAMP = DB * DS, M = TP + NSAMP;
constexpr int FF = 5504, PASTL = 2048, PAGE = 128, NPAGES = 16;
constexpr int HGH = 8, HGD = 128, HGW = 1024;
constexpr int NH = 16, NKV = 2, GRP = 8, HD = 64, NSAW = 1024, KVW = 128;
constexpr int CMPB = 32, CMPS = 16, CMPH = 256, SLCB = 64, SLCT = 16, WIN = 512;
constexpr int NCP = (TP - CMPB) / CMPS + 1;
constexpr int NCS = (PASTL + DS - CMPB) / CMPS + 1;
constexpr int NSP = TP / SLCB;
constexpr int NSS = (PASTL + DS + SLCB - 1) / SLCB;
constexpr int DIN = 10032, DINP = 10240;
constexpr float EPS = 1e-6f;
constexpr int C_HQ = 0, C_HF = 1024, C_HI = 2048, C_HG = 3072, C_NQ = 4096, C_KV = 5120, C_WN = 5632, C_GA = 5888, C_GB = 7936, C_NG = 9984;
constexpr size_t O_Y = 0, O_KV = (size_t)M * DM, O_WINP = O_KV + (size_t)M * 512, O_WINS = O_WINP + 512 * 256, O_HGP = O_WINS + (size_t)DB * 512 * 256, O_HGS = O_HGP + 131072, O_END = O_HGS + (size_t)DB * 131072;
static_assert(O_END == 56098816, "d_out size");
constexpr size_t MiB = 1u << 20;
constexpr size_t alignup(size_t x) { return (x + MiB - 1) / MiB * MiB; }
constexpr size_t WS_CTL = 0, CTL_ZERO_BYTES = 1 * MiB;
constexpr size_t WS_W1GU = 1 * MiB;
constexpr size_t WS_W1D  = WS_W1GU + alignup((size_t)2 * FF * DM * 2);
constexpr size_t WS_W2GU = WS_W1D + alignup((size_t)DM * FF * 2);
constexpr size_t WS_W2D  = WS_W2GU + alignup((size_t)2 * FF * DM * 2);
constexpr size_t WS_WIN  = WS_W2D + alignup((size_t)DM * FF * 2);
constexpr size_t WS_WPH  = WS_WIN + alignup((size_t)DINP * DM * 2);
constexpr size_t WS_WPN  = WS_WPH + alignup((size_t)DM * 1024 * 2);
constexpr size_t WS_WO   = WS_WPN + alignup((size_t)DM * 1024 * 2);
constexpr size_t WS_XN   = WS_WO + alignup((size_t)DM * DM * 2);
constexpr size_t WS_HB   = WS_XN + alignup((size_t)M * DM * 2);
constexpr size_t WS_Y    = WS_HB + alignup((size_t)M * FF * 2);
constexpr size_t WS_X1   = WS_Y + alignup((size_t)M * DM * 4);
constexpr size_t WS_X2   = WS_X1 + alignup((size_t)M * DM * 4);
constexpr size_t WS_QH   = WS_X2 + alignup((size_t)M * DM * 4);
constexpr size_t WS_LOGF = WS_QH + alignup((size_t)M * 1024 * 4);
constexpr size_t WS_KH   = WS_LOGF + alignup((size_t)M * 1024 * 4);
constexpr size_t WS_VH   = WS_KH + alignup((size_t)M * 1024 * 4);
constexpr size_t WS_GH   = WS_VH + alignup((size_t)M * 1024 * 4);
constexpr size_t WS_QN   = WS_GH + alignup((size_t)M * 1024 * 4);
constexpr size_t WS_WINF = WS_QN + alignup((size_t)M * 1024 * 4);
constexpr size_t WS_NG   = WS_WINF + alignup((size_t)M * 256 * 4);
constexpr size_t WS_GA   = WS_NG + alignup((size_t)M * 48 * 4);
constexpr size_t WS_GB   = WS_GA + alignup((size_t)M * DM * 4);
constexpr size_t WS_KCP  = WS_GB + alignup((size_t)M * DM * 4);
constexpr size_t WS_VCP  = WS_KCP + 1 * MiB;
constexpr size_t WS_KCS  = WS_VCP + 1 * MiB;
constexpr size_t WS_VCS  = WS_KCS + alignup((size_t)DB * 2 * NCS * 64 * 4);
constexpr size_t WS_CB   = WS_VCS + alignup((size_t)DB * 2 * NCS * 64 * 4);
constexpr size_t WS_OHR  = WS_CB + 1 * MiB;
constexpr size_t WS_OHG  = WS_OHR + alignup((size_t)M * 1024 * 4);
constexpr size_t WS_ONSA = WS_OHG + alignup((size_t)M * 1024 * 2);
constexpr size_t WS_T1   = WS_ONSA + alignup((size_t)M * 1024 * 2);
constexpr size_t WS_MIX  = WS_T1 + alignup((size_t)M * DM * 4);
constexpr size_t WS_UT   = WS_MIX + alignup((size_t)M * DM * 2);
constexpr size_t WS_DD   = WS_UT + alignup((size_t)128 * 8 * 16384 * 4);
constexpr size_t WS_SP   = WS_DD + 1 * MiB;
constexpr size_t WS_QN16 = WS_SP + alignup((size_t)128 * 8 * 16384 * 2);
constexpr size_t WS_KSL  = WS_QN16 + alignup((size_t)M * 1024 * 2);
constexpr size_t WS_VSL  = WS_KSL + 2 * MiB;
constexpr size_t WS_KWN  = WS_VSL + 2 * MiB;
constexpr size_t WS_VWN  = WS_KWN + 2 * MiB;
constexpr size_t WS_KC16 = WS_VWN + 2 * MiB;
constexpr size_t WS_VC16 = WS_KC16 + 1 * MiB;
constexpr int CMP_ROWS_S = DB * 2 * 2 * 128, CMP_ROWS_P = 2 * 2 * 512, CMP_ROWS = CMP_ROWS_S + CMP_ROWS_P;
constexpr size_t WS_CA   = WS_VC16 + 1 * MiB;
constexpr size_t WS_HID  = WS_CA + alignup((size_t)CMP_ROWS * 1024 * 2) + 1 * MiB;
constexpr size_t WS_W1C  = WS_HID + alignup((size_t)CMP_ROWS * 256 * 2);
constexpr size_t WS_W2C  = WS_W1C + 2 * MiB;
constexpr size_t WS_SLAB = WS_W2C + 1 * MiB;
constexpr size_t SLABSZ = (size_t)NSAMP * DM;
constexpr size_t WS_QH16 = WS_SLAB + alignup(16 * SLABSZ * 4);
constexpr size_t WS_KH16 = WS_QH16 + 18 * MiB;
constexpr size_t WS_VH16 = WS_KH16 + 18 * MiB;
constexpr size_t WS_GH16 = WS_VH16 + 18 * MiB;
constexpr size_t WS_RS   = WS_GH16 + 18 * MiB;
constexpr size_t WS_END  = WS_RS + 1 * MiB;
static_assert(WS_END < (size_t)2600 * MiB, "workspace");
constexpr int CW_TMO = 0, CW_CODE = 1, CW_BAR = 4096, CW_Q7 = 8192, CW_Q5 = 8192 + 256;
constexpr int RING_OFF = 0, RING_BYTES = 131072;
constexpr int LDSCTL_OFF = RING_BYTES, MISC_OFF = LDSCTL_OFF + 320;
constexpr int LDS_BYTES = 147456;
namespace pg8 {
__device__ __forceinline__ float sigm(float x) { return __builtin_amdgcn_rcpf(1.f + __expf(-x)); }
#define EPI_FOR(...) _Pragma("unroll") for (int ai = 0; ai < 2; ++ai) _Pragma("unroll") for (int m = 0; m < 4; ++m) { const int row = row0 + ai * 128 + m * 16; \
    _Pragma("unroll") for (int bj = 0; bj < 2; ++bj) _Pragma("unroll") for (int n = 0; n < 2; ++n) { const int cl = cl0 + bj * 128 + 4 * n; f32x4 v = acc[ai][bj][m][n]; __VA_ARGS__ } }
#define EPI_BFSILU(dst, ld, col) _Pragma("unroll") for (int ai = 0; ai < 2; ++ai) _Pragma("unroll") for (int m = 0; m < 4; ++m) { const int row = row0 + ai * 128 + m * 16; \
    _Pragma("unroll") for (int bj = 0; bj < 2; ++bj) { const f32x4 a = acc[ai][bj][m][0], b = acc[ai][bj][m][1]; u32x4 w; \
        w.x = cvt_pk_bf16(a[0] * sigm(a[0]), a[1] * sigm(a[1])); w.y = cvt_pk_bf16(a[2] * sigm(a[2]), a[3] * sigm(a[3])); w.z = cvt_pk_bf16(b[0] * sigm(b[0]), b[1] * sigm(b[1])); w.w = cvt_pk_bf16(b[2] * sigm(b[2]), b[3] * sigm(b[3])); \
        *(u32x4*)((dst) + (size_t)row * (ld) + (col)) = w; } }
#define EPI_BFS(dst, ld, col) _Pragma("unroll") for (int ai = 0; ai < 2; ++ai) _Pragma("unroll") for (int m = 0; m < 4; ++m) { const int row = row0 + ai * 128 + m * 16; \
    _Pragma("unroll") for (int bj = 0; bj < 2; ++bj) { f32x4 a = acc[ai][bj][m][0], b = acc[ai][bj][m][1]; for (int j = 0; j < 4; ++j) { a[j] = sigm(a[j]); b[j] = sigm(b[j]); } u32x4 w; \
        w.x = cvt_pk_bf16(a[0], a[1]); w.y = cvt_pk_bf16(a[2], a[3]); w.z = cvt_pk_bf16(b[0], b[1]); w.w = cvt_pk_bf16(b[2], b[3]); *(u32x4*)((dst) + (size_t)row * (ld) + (col)) = w; } }
#define EPI_BF(dst, ld, col, scale) _Pragma("unroll") for (int ai = 0; ai < 2; ++ai) _Pragma("unroll") for (int m = 0; m < 4; ++m) { const int row = row0 + ai * 128 + m * 16; \
    _Pragma("unroll") for (int bj = 0; bj < 2; ++bj) { const f32x4 a = acc[ai][bj][m][0] * (scale), b = acc[ai][bj][m][1] * (scale); u32x4 w; \
        w.x = cvt_pk_bf16(a[0], a[1]); w.y = cvt_pk_bf16(a[2], a[3]); w.z = cvt_pk_bf16(b[0], b[1]); w.w = cvt_pk_bf16(b[2], b[3]); *(u32x4*)((dst) + (size_t)row * (ld) + (col)) = w; } }
__device__ __forceinline__ void unpack8(const u32x4 w, f32x4& a, f32x4& b) {
    a[0] = __uint_as_float(w.x << 16); a[1] = __uint_as_float(w.x & 0xffff0000u); a[2] = __uint_as_float(w.y << 16); a[3] = __uint_as_float(w.y & 0xffff0000u);
    b[0] = __uint_as_float(w.z << 16); b[1] = __uint_as_float(w.z & 0xffff0000u); b[2] = __uint_as_float(w.w << 16); b[3] = __uint_as_float(w.w & 0xffff0000u); }
struct EpiSwiglu {
    static constexpr bool PERM = true;
    bf16_t* H; int ldh;
    __device__ __forceinline__ void operator()(const f32x4 (&acc)[2][2][4][2], const Unit& u, int wr, int wc, int fr, int fq) const {
        const int row0 = u.pm * BM + wr * 64 + fr, col = u.pn * 128 + wc * 32 + 8 * fq;
#pragma unroll
        for (int ai = 0; ai < 2; ++ai)
#pragma unroll
            for (int m = 0; m < 4; ++m) { const int row = row0 + ai * 128 + m * 16; float h[8];
#pragma unroll
                for (int n = 0; n < 2; ++n)
#pragma unroll
                    for (int j = 0; j < 4; ++j) { const float g = acc[ai][0][m][n][j], up = acc[ai][1][m][n][j]; h[4 * n + j] = g * sigm(g) * up; }
                u32x4 w; w.x = cvt_pk_bf16(h[0], h[1]); w.y = cvt_pk_bf16(h[2], h[3]); w.z = cvt_pk_bf16(h[4], h[5]); w.w = cvt_pk_bf16(h[6], h[7]);
                *(u32x4*)(H + (size_t)row * ldh + col) = w; }
    }
};
struct EpiY16 {
    static constexpr bool PERM = true;
    bf16_t* Y; int ldc;
    __device__ __forceinline__ void operator()(const f32x4 (&acc)[2][2][4][2], const Unit& u, int wr, int wc, int fr, int fq) const {
        const int row0 = u.pm * BM + wr * 64 + fr, cl0 = u.pn * BM + wc * 32 + 8 * fq;
        EPI_BF(Y, ldc, cl0 + bj * 128, 1.f)
    }
};
struct EpiSlab {
    static constexpr bool PERM = true;
    float* S;
    __device__ __forceinline__ void operator()(const f32x4 (&acc)[2][2][4][2], const Unit& u, int wr, int wc, int fr, int fq) const {
        const int row0 = (u.pm - 32) * BM + wr * 64 + fr, cl0 = u.pn * BM + wc * 32 + 8 * fq;
        EPI_FOR( *(f32x4*)(S + (size_t)row * 2048 + cl) = v; )
    }
};
struct OneUnit {
    int su;
    __device__ bool next(int i, Unit& u) const { if (i > 0 || su >= 16) return false; u.pm = 32 + (su >> 3); u.pn = su & 7; return true; }
    __device__ __forceinline__ void a_ready(const Unit&) const {}
    __device__ __forceinline__ void done(const Unit&) const {}
};
struct SplitSched {
    StaticOrder S; const char* A; const char* B; int lda, ldb, K, NS, bid;
    __device__ __forceinline__ void piece(int ks, int& koff, int& klen) const { if (K == FF) { koff = 128 * (ks < 11 ? 3 * ks : 33 + 2 * (ks - 11)); klen = ks < 11 ? 384 : 256; } else { klen = K / NS; koff = ks * klen; } }
    __device__ bool next(int i, UnitG& u) const {
        const int nmain = S.c < S.nwg ? (S.nwg - S.c + S.G - 1) / S.G : 0;
        if (i < nmain) { Unit m; S.next(i, m); u.pm = m.pm; u.pn = m.pn; u.A = A + (size_t)m.pm * 256 * lda * 2; u.B = B + (size_t)m.pn * 256 * ldb * 2; u.nt = K / 64; u.kind = 0; u.aux = 0; return true; }
        if (i > nmain) return false;
        const int ks = bid % NS, su = bid / NS; if (su >= 16) return false;
        int koff, klen; piece(ks, koff, klen);
        u.pm = 32 + (su >> 3); u.pn = su & 7; u.A = A + ((size_t)u.pm * 256 * lda + koff) * 2; u.B = B + ((size_t)u.pn * 256 * ldb + koff) * 2; u.nt = klen / 64; u.kind = 1; u.aux = ks; return true;
    }
    __device__ __forceinline__ void a_ready(const UnitG&) const {}
    __device__ __forceinline__ void done(const UnitG&) const {}
};
struct ProjSched {
    StaticOrder S; const char* Ah; const char* An; const char* Bh; const char* Bn; int bid;
    __device__ bool next(int i, UnitG& u) const {
        const int nmain = S.c < S.nwg ? (S.nwg - S.c + S.G - 1) / S.G : 0;
        if (i < 2 * nmain) { Unit m; S.next(i >> 1, m); const bool n = i & 1; u.pm = m.pm; u.pn = m.pn; u.A = (n ? An : Ah) + (size_t)m.pm * 256 * 1024 * 2; u.B = (n ? Bn : Bh) + (size_t)m.pn * 256 * 1024 * 2; u.nt = 16; u.kind = n ? 2 : 0; u.aux = 0; return true; }
        const int j = i - 2 * nmain; if (j > 1) return false;
        const int ks = bid & 3, su = bid >> 2; if (su >= 16) return false;
        u.pm = 32 + (su >> 3); u.pn = su & 7; u.A = (j ? An : Ah) + ((size_t)u.pm * 256 * 1024 + ks * 256) * 2; u.B = (j ? Bn : Bh) + ((size_t)u.pn * 256 * 1024 + ks * 256) * 2; u.nt = 4; u.kind = 1; u.aux = 4 * j + ks; return true;
    }
    __device__ __forceinline__ void a_ready(const UnitG&) const {}
    __device__ __forceinline__ void done(const UnitG&) const {}
};
__device__ __forceinline__ f32x4 sig4(f32x4 x) { return (f32x4){sigm(x[0]), sigm(x[1]), sigm(x[2]), sigm(x[3])}; }
struct EpiGate1 {
    static constexpr bool PERM = true;
    const bf16_t* GA; bf16_t* T1; int ldc;
    __device__ __forceinline__ void operator()(const f32x4 (&acc)[2][2][4][2], const Unit& u, int wr, int wc, int fr, int fq) const {
        const int row0 = u.pm * BM + wr * 64 + fr, cl0 = u.pn * BM + wc * 32 + 8 * fq;
#pragma unroll
        for (int ai = 0; ai < 2; ++ai)
#pragma unroll
            for (int m = 0; m < 4; ++m) { const int row = row0 + ai * 128 + m * 16;
#pragma unroll
                for (int bj = 0; bj < 2; ++bj) { const size_t off = (size_t)row * ldc + cl0 + bj * 128; f32x4 g0, g1; unpack8(*(const u32x4*)(GA + off), g0, g1);
                    const f32x4 a = sig4(g0) * acc[ai][bj][m][0], b = sig4(g1) * acc[ai][bj][m][1];
                    u32x4 w; w.x = cvt_pk_bf16(a[0], a[1]); w.y = cvt_pk_bf16(a[2], a[3]); w.z = cvt_pk_bf16(b[0], b[1]); w.w = cvt_pk_bf16(b[2], b[3]);
                    *(u32x4*)(T1 + off) = w; } }
    }
};
struct EpiGate2 {
    static constexpr bool PERM = true;
    const bf16_t* GB; const bf16_t* T1; bf16_t* MIX; int ldc;
    __device__ __forceinline__ void operator()(const f32x4 (&acc)[2][2][4][2], const Unit& u, int wr, int wc, int fr, int fq) const {
        const int row0 = u.pm * BM + wr * 64 + fr, cl0 = u.pn * BM + wc * 32 + 8 * fq;
#pragma unroll
        for (int ai = 0; ai < 2; ++ai)
#pragma unroll
            for (int m = 0; m < 4; ++m) { const int row = row0 + ai * 128 + m * 16;
#pragma unroll
                for (int bj = 0; bj < 2; ++bj) { const size_t off = (size_t)row * ldc + cl0 + bj * 128; f32x4 t0, t1, g0, g1; unpack8(*(const u32x4*)(T1 + off), t0, t1); unpack8(*(const u32x4*)(GB + off), g0, g1);
                    const f32x4 a = t0 + sig4(g0) * acc[ai][bj][m][0], b = t1 + sig4(g1) * acc[ai][bj][m][1];
                    u32x4 w; w.x = cvt_pk_bf16(a[0], a[1]); w.y = cvt_pk_bf16(a[2], a[3]); w.z = cvt_pk_bf16(b[0], b[1]); w.w = cvt_pk_bf16(b[2], b[3]);
                    *(u32x4*)(MIX + off) = w; } }
    }
};
template <class Main> struct EpiDual {
    static constexpr bool PERM = true;
    Main main; float* slab;
    __device__ __forceinline__ void operator()(const f32x4 (&acc)[2][2][4][2], const UnitG& u, int wr, int wc, int fr, int fq) const {
        if (u.kind == 0) main(acc, u, wr, wc, fr, fq); else { EpiSlab e{slab + (size_t)u.aux * SLABSZ}; e(acc, u, wr, wc, fr, fq); }
    }
};
struct EpiProj {
    static constexpr bool PERM = true;
    EpiGate1 g1; EpiGate2 g2; float* slab;
    __device__ __forceinline__ void operator()(const f32x4 (&acc)[2][2][4][2], const UnitG& u, int wr, int wc, int fr, int fq) const {
        if (u.kind == 0) g1(acc, u, wr, wc, fr, fq); else if (u.kind == 2) g2(acc, u, wr, wc, fr, fq); else { EpiSlab e{slab + (size_t)u.aux * SLABSZ}; e(acc, u, wr, wc, fr, fq); }
    }
};
struct EpiCmp {
    static constexpr bool PERM = true;
    const float* CB; bf16_t* HID;
    __device__ __forceinline__ void operator()(const f32x4 (&acc)[2][2][4][2], const Unit& u, int wr, int wc, int fr, int fq) const {
        const int row0 = u.pm * BM + wr * 64 + fr, cl0 = wc * 32 + 8 * fq;
#pragma unroll
        for (int bj = 0; bj < 2; ++bj) { const f32x4 b0 = *(const f32x4*)(CB + u.pn * 256 + cl0 + bj * 128), b1 = *(const f32x4*)(CB + u.pn * 256 + cl0 + bj * 128 + 4);
#pragma unroll
            for (int ai = 0; ai < 2; ++ai)
#pragma unroll
                for (int m = 0; m < 4; ++m) { const int row = row0 + ai * 128 + m * 16; f32x4 a = acc[ai][bj][m][0] + b0, b = acc[ai][bj][m][1] + b1;
                    for (int j = 0; j < 4; ++j) { a[j] = a[j] * sigm(1.5957691216057308f * (a[j] + 0.044715f * a[j] * a[j] * a[j])); b[j] = b[j] * sigm(1.5957691216057308f * (b[j] + 0.044715f * b[j] * b[j] * b[j])); }
                    u32x4 w; w.x = cvt_pk_bf16(a[0], a[1]); w.y = cvt_pk_bf16(a[2], a[3]); w.z = cvt_pk_bf16(b[0], b[1]); w.w = cvt_pk_bf16(b[2], b[3]);
                    *(u32x4*)(HID + (size_t)row * 256 + cl0 + bj * 128) = w; } }
    }
};
struct CmpOrder {
    int G, c;
    __device__ bool next(int i, Unit& u) const { const int L = i * G + c; if (L >= CMP_ROWS / 256) return false; u.pm = L; u.pn = L < CMP_ROWS_S / 256 ? (L >= CMP_ROWS_S / 512 ? 1 : 0) : (L - CMP_ROWS_S / 256 >= 4 ? 1 : 0); return true; }
    __device__ __forceinline__ void a_ready(const Unit&) const {}
    __device__ __forceinline__ void done(const Unit&) const {}
};
struct EpiInProj {
    static constexpr bool PERM = true;
    unsigned char* ws; float* out; const float* hg_lb;
    __device__ __forceinline__ void operator()(const f32x4 (&acc)[2][2][4][2], const Unit& u, int wr, int wc, int fr, int fq) const {
        const int row0 = u.pm * BM + wr * 64 + fr, cl0 = wc * 32 + 8 * fq, pn = u.pn;
        float* const LOGF = (float*)(ws + WS_LOGF);
        float* const WINF = (float*)(ws + WS_WINF); float* const NG = (float*)(ws + WS_NG); bf16_t* const GA = (bf16_t*)(ws + WS_GA); bf16_t* const GB = (bf16_t*)(ws + WS_GB);
        float* const KVO = out + O_KV; float* const WINP = out + O_WINP; float* const WINS = out + O_WINS;
        bf16_t* const QN16 = (bf16_t*)(ws + WS_QN16); bf16_t* const KSL = (bf16_t*)(ws + WS_KSL); bf16_t* const VSL = (bf16_t*)(ws + WS_VSL); bf16_t* const KWN = (bf16_t*)(ws + WS_KWN); bf16_t* const VWN = (bf16_t*)(ws + WS_VWN);
        bf16_t* const CP16 = (bf16_t*)(ws + WS_CA) + (size_t)CMP_ROWS_S * 1024;
        bf16_t* const QH16 = (bf16_t*)(ws + WS_QH16); bf16_t* const KH16 = (bf16_t*)(ws + WS_KH16); bf16_t* const VH16 = (bf16_t*)(ws + WS_VH16); bf16_t* const GH16 = (bf16_t*)(ws + WS_GH16);
        if (pn < 4) { const int cb = pn * 256;
            EPI_BFSILU(QH16, 1024, cb + cl0 + bj * 128)
        } else if (pn < 8) { const int cb = (pn - 4) * 256;
#pragma unroll
            for (int bj = 0; bj < 2; ++bj) { const int c = cb + cl0 + bj * 128; f32x4 lb[2];
#pragma unroll
                for (int n = 0; n < 2; ++n) { const f32x4 a0 = *(const f32x4*)(hg_lb + c + 4 * n), a1 = *(const f32x4*)(hg_lb + 1024 + c + 4 * n); for (int j = 0; j < 4; ++j) lb[n][j] = 1.f / (1.f + expf(a1[j] - a0[j])); }
#pragma unroll
                for (int ai = 0; ai < 2; ++ai)
#pragma unroll
                    for (int m = 0; m < 4; ++m) { const int row = row0 + ai * 128 + m * 16; f32x4 kk[2];
#pragma unroll
                        for (int n = 0; n < 2; ++n) { const f32x4 v = acc[ai][bj][m][n]; f32x4 lf;
                            for (int j = 0; j < 4; ++j) { const float sg = 1.f / (1.f + expf(-v[j])), sn = 1.f / (1.f + expf(v[j])); const float f = lb[n][j] + (1.f - lb[n][j]) * sg; lf[j] = logf(f); kk[n][j] = (1.f - lb[n][j]) * sn; }
                            *(f32x4*)(LOGF + (size_t)row * 1024 + c + 4 * n) = lf; }
                        { u32x4 w; w.x = cvt_pk_bf16(kk[0][0], kk[0][1]); w.y = cvt_pk_bf16(kk[0][2], kk[0][3]); w.z = cvt_pk_bf16(kk[1][0], kk[1][1]); w.w = cvt_pk_bf16(kk[1][2], kk[1][3]); *(u32x4*)(KH16 + (size_t)row * 1024 + c) = w; } } }
        } else if (pn < 12) { const int cb = (pn - 8) * 256;
            EPI_BF(VH16, 1024, cb + cl0 + bj * 128, 1.f)
        } else if (pn < 16) { const int cb = (pn - 12) * 256;
            EPI_BFSILU(GH16, 1024, cb + cl0 + bj * 128)
        } else if (pn < 20) { const int cb = (pn - 16) * 256;
            EPI_BF(QN16, 1024, cb + cl0 + bj * 128, 0.125f * 1.4426950408889634f)
        } else if (pn < 22) { const int cb = (pn - 20) * 256;
            EPI_FOR( *(f32x4*)(KVO + (size_t)row * 512 + cb + cl) = v; )
            if (pn == 21 && u.pm < 32) { EPI_BF((bj ? VSL : KSL), 128, cl0, 1.f) }
            if (pn == 20 && u.pm < 32) { EPI_BF(CP16 + (size_t)(bj * 2 + (cl0 >> 6)) * 8192 * 64, 64, cl0 & 63, 1.f) }
        } else if (pn == 22) {
            EPI_FOR( *(f32x4*)(WINF + (size_t)row * 256 + cl) = v;
                     if (row >= 7680 && row < 8192) *(f32x4*)(WINP + (size_t)(row - 7680) * 256 + cl) = v;
                     if (row >= 8192) { const int b = (row - 8192) >> 2, tt = (row - 8192) & 3; *(f32x4*)(WINS + ((size_t)b * 512 + 508 + tt) * 256 + cl) = v; } )
            if (u.pm < 32) { EPI_BF((bj ? VWN : KWN), 128, cl0, 1.f) }
        } else if (pn < 31) { const int cb = (pn - 23) * 256;
            EPI_BF(GA, 2048, cb + cl0 + bj * 128, 1.f)
        } else if (pn < 39) { const int cb = (pn - 31) * 256;
            EPI_BF(GB, 2048, cb + cl0 + bj * 128, 1.f)
        } else {
            EPI_FOR( if (cl < 48) { f32x4 o; for (int j = 0; j < 4; ++j) o[j] = sigm(v[j]); *(f32x4*)(NG + (size_t)row * 48 + cl) = o; } )
        }
    }
};
#undef EPI_FOR
#undef EPI_BF
#undef EPI_BFS
#undef EPI_BFSILU
}
typedef float f4 __attribute__((ext_vector_type(4)));
typedef float f2 __attribute__((ext_vector_type(2)));
typedef unsigned u2 __attribute__((ext_vector_type(2)));
__device__ __forceinline__ float wsum(float v) {
#pragma unroll
    for (int o = 32; o > 0; o >>= 1) v += __shfl_xor(v, o);
    return v;
}
__device__ __forceinline__ float wmax(float v) {
#pragma unroll
    for (int o = 32; o > 0; o >>= 1) v = fmaxf(v, __shfl_xor(v, o));
    return v;
}
__device__ __forceinline__ f4 ld4bf(const bf16* p) { const u2 w = *(const u2*)p; return (f4){__uint_as_float(w.x << 16), __uint_as_float(w.x & 0xffff0000u), __uint_as_float(w.y << 16), __uint_as_float(w.y & 0xffff0000u)}; }
struct Ctx { int tid, lane, wave, gw, NGW, G, bid; LAS unsigned char* lds; };

template <int MAP> __device__ __forceinline__ int dest_row(int n) {
    if (MAP == 1) return (n >> 7) * 256 + (n & 127);
    if (MAP == 2) return (n >> 7) * 256 + 128 + (n & 127);
    if (MAP == 3) return n < 5888 ? n : (n < 5936 ? C_NG + (n - 5888) : C_GA + (n - 5936));
    return n;
}
template <int MAP> __device__ __forceinline__ void transpose_item(const float* W, int K, int N, bf16* WT, LAS float* scr, int item, int lane) {
    const int nblk = (N + 31) / 32, kb = item / nblk, nb = item % nblk, k0 = 64 * kb, n0 = 32 * nb;
    const int nn = n0 + (lane & 31);
#pragma unroll 8
    for (int i = 0; i < 32; ++i) { const int kk = 2 * i + (lane >> 5); scr[kk * 33 + (lane & 31)] = nn < N ? W[(size_t)(k0 + kk) * N + nn] : 0.f; }
    LDS_WAIT(); asm volatile("" ::: "memory");
    const int c = lane & 7;
#pragma unroll
    for (int j = 0; j < 4; ++j) { const int n = (lane >> 3) + 8 * j; const LAS float* s = scr + (8 * c) * 33 + n;
        v4u o; o.x = pk2(s[0 * 33], s[1 * 33]); o.y = pk2(s[2 * 33], s[3 * 33]); o.z = pk2(s[4 * 33], s[5 * 33]); o.w = pk2(s[6 * 33], s[7 * 33]);
        if (n0 + n < N) *(GAS v4u*)(WT + (size_t)dest_row<MAP>(n0 + n) * K + k0 + 8 * c) = o; }
    LDS_WAIT(); asm volatile("" ::: "memory");
}
struct TrMat { int in_idx, K, N, map; size_t dst; };
__device__ __forceinline__ TrMat tr_mat(int m) {
    switch (m) {
        case 0: return TrMat{8, DM, FF, 1, WS_W1GU};              case 1: return TrMat{9, DM, FF, 2, WS_W1GU};
        case 2: return TrMat{13, DM, DIN, 3, WS_WIN};
        case 3: return TrMat{17, 2048, 256, 0, WS_W1C};           case 4: return TrMat{20, 2048, 256, 0, WS_W1C + (size_t)256 * 2048 * 2};
        case 5: return TrMat{18, 256, 64, 0, WS_W2C};             case 6: return TrMat{21, 256, 64, 0, WS_W2C + (size_t)64 * 256 * 2};
        case 7: return TrMat{10, FF, DM, 0, WS_W1D};
        case 8: return TrMat{27, DM, FF, 1, WS_W2GU};             case 9: return TrMat{28, DM, FF, 2, WS_W2GU};
        case 10: return TrMat{22, 1024, DM, 0, WS_WPH};           case 11: return TrMat{23, 1024, DM, 0, WS_WPN};
        case 12: return TrMat{24, DM, DM, 0, WS_WO};
        default: return TrMat{29, FF, DM, 0, WS_W2D};
    }
}
__device__ __forceinline__ int tr_items(const TrMat& t) { return (t.K / 64) * ((t.N + 63) / 64); }
__device__ __forceinline__ int dest_row_rt(int map, int n) {
    if (map == 1) return (n >> 7) * 256 + (n & 127);
    if (map == 2) return (n >> 7) * 256 + 128 + (n & 127);
    if (map == 3) return n < 5888 ? n : (n < 5936 ? C_NG + (n - 5888) : C_GA + (n - 5936));
    return n;
}
__device__ __forceinline__ void tr_item64(const float* W, int K, int N, bf16* WT, int map, LAS unsigned* scr, int item, int lane) {
    const int nblk = (N + 63) / 64, kb = item / nblk, nb = item % nblk, k0 = 64 * kb, n0 = 64 * nb, nn = n0 + lane; const bool ok = nn < N;
    const float* src = W + (size_t)k0 * N + (ok ? nn : 0);
    float v[64];
#pragma unroll
    for (int i = 0; i < 64; ++i) v[i] = src[(size_t)i * N];
#pragma unroll
    for (int i = 0; i < 32; ++i) scr[lane * 33 + i] = pk2(v[2 * i], v[2 * i + 1]);
    LDS_WAIT(); asm volatile("" ::: "memory");
    const int c = lane & 7;
#pragma unroll
    for (int j = 0; j < 8; ++j) { const int n = (lane >> 3) + 8 * j; v4u o; o.x = scr[n * 33 + 4 * c]; o.y = scr[n * 33 + 4 * c + 1]; o.z = scr[n * 33 + 4 * c + 2]; o.w = scr[n * 33 + 4 * c + 3];
        if (n0 + n < N) *(GAS v4u*)(WT + (size_t)dest_row_rt(map, n0 + n) * K + k0 + 8 * c) = o; }
    LDS_WAIT(); asm volatile("" ::: "memory");
}
__device__ __forceinline__ void tr_run(const void* const* in, unsigned char* ws, LAS unsigned* scr, int mlo, int mhi, int widx, int nw, int lane) {
    int total = 0;
    for (int m = mlo; m < mhi; ++m) total += tr_items(tr_mat(m));
    for (int it = widx; it < total; it += nw) { int r = it, m = mlo; TrMat t = tr_mat(m);
        while (r >= tr_items(t)) { r -= tr_items(t); ++m; t = tr_mat(m); }
        tr_item64((const float*)in[t.in_idx], t.K, t.N, (bf16*)(ws + t.dst), t.map, scr, r, lane); }
}
__device__ __forceinline__ void rms_row_to_bf16(const float* xrow, const float* g, bf16* orow, int lane) {
    const f4* xr = (const f4*)xrow + lane; const f4* gr = (const f4*)g + lane;
    f4 v[8]; float s = 0.f;
#pragma unroll
    for (int j = 0; j < 8; ++j) { v[j] = xr[64 * j]; s += (v[j].x * v[j].x + v[j].y * v[j].y) + (v[j].z * v[j].z + v[j].w * v[j].w); }
    const float r = rsqrtf(wsum(s) * (1.f / DM) + EPS);
    unsigned long long* o8 = (unsigned long long*)orow + lane;
#pragma unroll
    for (int j = 0; j < 8; ++j) { const f4 gg = gr[64 * j]; o8[64 * j] = (unsigned long long)pk2(v[j].x * r * gg.x, v[j].y * r * gg.y) | ((unsigned long long)pk2(v[j].z * r * gg.z, v[j].w * r * gg.w) << 32); }
}
__device__ __forceinline__ void norm_mid_row(const void* yrow_, const float* xin, const bf16* xin16, const float* gin, float rs_in, const float* gpost, float scale, float* xout, const float* gpre, bf16* xn, float* rs_out, int lane, int nslab = 0) {
    const f4* yr = (const f4*)yrow_ + lane; const f4* xr = (const f4*)xin + lane; const f4* gp = (const f4*)gpost + lane;
    f4 v[8]; float s = 0.f;
    if (nslab == 0) {
        const unsigned long long* y8 = (const unsigned long long*)yrow_ + lane;
#pragma unroll
        for (int j = 0; j < 8; ++j) { const unsigned long long w = y8[64 * j]; const unsigned lo = (unsigned)w, hi = (unsigned)(w >> 32);
            v[j] = (f4){__uint_as_float(lo << 16), __uint_as_float(lo & 0xffff0000u), __uint_as_float(hi << 16), __uint_as_float(hi & 0xffff0000u)}; }
    } else {
#pragma unroll
        for (int j = 0; j < 8; ++j) v[j] = yr[64 * j];
    }
    for (int k = 1; k + 3 < nslab; k += 4) {
        f4 t[4][8];
#pragma unroll
        for (int kk = 0; kk < 4; ++kk)
#pragma unroll
            for (int j = 0; j < 8; ++j) t[kk][j] = yr[64 * j + (size_t)(k + kk) * (SLABSZ / 4)];
#pragma unroll
        for (int kk = 0; kk < 4; ++kk)
#pragma unroll
            for (int j = 0; j < 8; ++j) v[j] += t[kk][j];
    }
    if (nslab > 0) { const int k0 = 1 + ((nslab - 1) / 4) * 4;
#pragma unroll
        for (int kk = 0; kk < 3; ++kk)
#pragma unroll
            for (int j = 0; j < 8; ++j) v[j] += yr[64 * j + (size_t)(k0 + kk) * (SLABSZ / 4)]; }
#pragma unroll
    for (int j = 0; j < 8; ++j) s += (v[j].x * v[j].x + v[j].y * v[j].y) + (v[j].z * v[j].z + v[j].w * v[j].w);
    const float r = rsqrtf(wsum(s) * (1.f / DM) + EPS) * scale;
    float s2 = 0.f;
#pragma unroll
    for (int j = 0; j < 8; ++j) { f4 xi;
        if (xin) xi = xr[64 * j];
        else { const f4 xb = ld4bf(xin16 + 4 * (lane + 64 * j)), gi = ((const f4*)gin + lane)[64 * j];
            xi = (f4){xb.x * rs_in * __builtin_amdgcn_rcpf(gi.x), xb.y * rs_in * __builtin_amdgcn_rcpf(gi.y), xb.z * rs_in * __builtin_amdgcn_rcpf(gi.z), xb.w * rs_in * __builtin_amdgcn_rcpf(gi.w)}; }
        const f4 gg = gp[64 * j]; v[j] = xi + v[j] * gg * r; if (xout) ((f4*)xout + lane)[64 * j] = v[j];
        s2 += (v[j].x * v[j].x + v[j].y * v[j].y) + (v[j].z * v[j].z + v[j].w * v[j].w); }
    if (xn) {
        const float ms = wsum(s2) * (1.f / DM) + EPS; const float r2 = rsqrtf(ms); const f4* gr = (const f4*)gpre + lane;
        if (rs_out && lane == 0) *rs_out = sqrtf(ms);
        unsigned long long* o8 = (unsigned long long*)xn + lane;
#pragma unroll
        for (int j = 0; j < 8; ++j) { const f4 gg = gr[64 * j]; o8[64 * j] = (unsigned long long)pk2(v[j].x * r2 * gg.x, v[j].y * r2 * gg.y) | ((unsigned long long)pk2(v[j].z * r2 * gg.z, v[j].w * r2 * gg.w) << 32); }
    }
}

__device__ __forceinline__ void hgrn_seq_pair(int rowbase, int h, int vg2, const float* S0, float* Sout, const bf16* QH, const float* LOGF, const bf16* KH, const bf16* VH, float* OHR, int lane) {
    const int kq = lane >> 1, vh = lane & 1, kc = h * 128 + 4 * kq, vc = h * 128 + 16 * vg2 + 4 * vh;
    f4 s[2][4], q4[4], lf[4], k4[4], v4[2][4];
#pragma unroll
    for (int u = 0; u < 2; ++u)
#pragma unroll
        for (int i = 0; i < 4; ++i) s[u][i] = *(const f4*)(S0 + (size_t)(4 * kq + i) * 128 + 16 * vg2 + 8 * u + 4 * vh);
#pragma unroll
    for (int t = 0; t < 4; ++t) { const size_t base = (size_t)(rowbase + t) * 1024; q4[t] = ld4bf(QH + base + kc); lf[t] = *(const f4*)(LOGF + base + kc); k4[t] = ld4bf(KH + base + kc);
        v4[0][t] = ld4bf(VH + base + vc); v4[1][t] = ld4bf(VH + base + vc + 8); }
#pragma unroll
    for (int t = 0; t < 4; ++t) {
        const size_t base = (size_t)(rowbase + t) * 1024;
        f4 o[2] = {(f4){0.f, 0.f, 0.f, 0.f}, (f4){0.f, 0.f, 0.f, 0.f}};
#pragma unroll
        for (int i = 0; i < 4; ++i) { const float f = __expf(lf[t][i]);
#pragma unroll
            for (int u = 0; u < 2; ++u) { s[u][i] = s[u][i] * f + v4[u][t] * k4[t][i]; o[u] += s[u][i] * q4[t][i]; } }
#pragma unroll
        for (int off = 2; off < 64; off <<= 1)
#pragma unroll
            for (int u = 0; u < 2; ++u) { o[u].x += __shfl_xor(o[u].x, off); o[u].y += __shfl_xor(o[u].y, off); o[u].z += __shfl_xor(o[u].z, off); o[u].w += __shfl_xor(o[u].w, off); }
        if (kq == 0) { *(f4*)(OHR + base + vc) = o[0]; *(f4*)(OHR + base + vc + 8) = o[1]; }
    }
#pragma unroll
    for (int u = 0; u < 2; ++u)
#pragma unroll
        for (int i = 0; i < 4; ++i) *(f4*)(Sout + (size_t)(4 * kq + i) * 128 + 16 * vg2 + 8 * u + 4 * vh) = s[u][i];
}
__device__ __forceinline__ void hgrn_finish_row(const float* orow, const bf16* grow, const float* gn, bf16* out, int lane) {
#pragma unroll
    for (int j = 0; j < 4; ++j) { const int idx = lane + 64 * j; const f4 o = ((const f4*)orow)[idx], g = ld4bf(grow + 4 * idx), w = ((const f4*)gn)[idx & 31];
        float s = (o.x * o.x + o.y * o.y) + (o.z * o.z + o.w * o.w);
#pragma unroll
        for (int off = 1; off < 32; off <<= 1) s += __shfl_xor(s, off);
        const float r = rsqrtf(s * (1.f / 128.f) + EPS);
        ((unsigned long long*)out)[idx] = (unsigned long long)pk2(o.x * r * w.x * g.x, o.y * r * w.y * g.y) | ((unsigned long long)pk2(o.z * r * w.z * g.z, o.w * r * w.w * g.w) << 32); }
}

__device__ __forceinline__ float gelu_tanh(float x) { return 0.5f * x * (1.f + tanhf(0.7978845608028654f * (x + 0.044715f * x * x * x))); }
struct CmpArgs { const float* kvo; const float* cache; const int* pt; const float* w1k; const float* w1v; const float* w2k; const float* w2v; const float* cb; unsigned char* ws; };
__device__ __forceinline__ void compress_group(const Ctx& C, const CmpArgs& A, int id) {
    LAS float* SEG = (LAS float*)C.lds;
    LAS float* PART = (LAS float*)(C.lds + 69632);
    LAS float* HID = (LAS float*)(C.lds + 69632 + 32768);
    int type, n, cg, b = -1, NC;
    if (id < 128) { type = id >> 6; n = (id >> 5) & 1; cg = id & 31; NC = NCP; }
    else { const int i2 = id - 128; cg = i2 & 7; n = (i2 >> 3) & 1; b = (i2 >> 4) & 127; type = i2 >> 11; NC = NCS; }
    const int c0 = 16 * cg, L = b < 0 ? TP : PASTL;
    __syncthreads();
    for (int idx = C.tid; idx < 17 * 256; idx += NTHR) { const int pl = idx >> 4, d4 = idx & 15, pos = 16 * c0 + pl; f4 v = (f4){0.f, 0.f, 0.f, 0.f};
        if (pos < L) { const float* src = b < 0 ? A.kvo + (size_t)pos * 512 + type * 128 + n * 64 : A.cache + ((size_t)(A.pt[b * 16 + (pos >> 7)] * 128 + (pos & 127)) * 4 + type) * 128 + n * 64; v = ((const f4*)src)[d4]; }
        ((LAS f4*)SEG)[idx] = v; }
    __syncthreads();
    const int j = C.tid & 255, half = C.tid >> 8;
    float acc[16];
#pragma unroll
    for (int cc = 0; cc < 16; ++cc) acc[cc] = 0.f;
    const float* w1 = (type ? A.w1v : A.w1k) + (size_t)half * 1024 * 256 + j;
    for (int i4 = 0; i4 < 256; ++i4) {
        const float w0 = w1[(size_t)(4 * i4) * 256], wA = w1[(size_t)(4 * i4 + 1) * 256], wB = w1[(size_t)(4 * i4 + 2) * 256], wC = w1[(size_t)(4 * i4 + 3) * 256];
#pragma unroll
        for (int cc = 0; cc < 16; ++cc) { const f4 x = ((const LAS f4*)SEG)[cc * 256 + half * 256 + i4]; acc[cc] += (x.x * w0 + x.y * wA) + (x.z * wB + x.w * wC); }
    }
#pragma unroll
    for (int cc = 0; cc < 16; ++cc) PART[(half * 16 + cc) * 256 + j] = acc[cc];
    __syncthreads();
    for (int idx = C.tid; idx < 4096; idx += NTHR) { const int jj = idx & 255; HID[idx] = gelu_tanh(PART[idx] + PART[4096 + idx] + A.cb[type * 256 + jj]); }
    __syncthreads();
    { const int cc = C.tid >> 5, d2 = (C.tid & 31) * 2; float o0 = 0.f, o1 = 0.f; const float* w2 = (type ? A.w2v : A.w2k) + d2;
        for (int jj = 0; jj < 256; ++jj) { const float hv = HID[cc * 256 + jj]; const f2 w = *(const f2*)(w2 + jj * 64); o0 += hv * w.x; o1 += hv * w.y; }
        const int c = c0 + cc;
        if (c < NC) { const size_t boff = b < 0 ? (type ? WS_VCP : WS_KCP) : (type ? WS_VCS : WS_KCS); const size_t eoff = b < 0 ? ((size_t)n * NCP + c) * 64 : ((size_t)(b * 2 + n) * NCS + c) * 64;
            *(f2*)((float*)(A.ws + boff) + eoff + d2) = (f2){o0, o1};
            if (b < 0) *(unsigned*)((bf16*)(A.ws + (type ? WS_VC16 : WS_KC16)) + ((size_t)n * 512 + c) * 64 + d2) = pk2(o0, o1); } }
}

struct KeyBlk { const float* kb; const float* vb; int stride, nk, kpos0, kstep; };
struct NsaArgs { const float* QN; const float* KVO; const float* WINF; const float* NG; const float* cache; const float* cwin; const int* pt; const float* kcp; const float* vcp; const float* kcs; const float* vcs; bf16* ONSA; };
__device__ __forceinline__ void qk_block(const KeyBlk& B, int qpos, int wlim, const float (&slope)[8], const LAS float* qbuf, float (&sv)[8], int lane) {
    const bool inr = lane < B.nk; const int dist = qpos - (B.kpos0 + lane * B.kstep); const bool valid = inr && dist >= 0 && dist < wlim;
    float s[8];
#pragma unroll
    for (int g = 0; g < 8; ++g) s[g] = 0.f;
    if (inr) { const f4* kp = (const f4*)(B.kb + (size_t)lane * B.stride);
#pragma unroll 4
        for (int d4 = 0; d4 < 16; ++d4) { const f4 kk = kp[d4];
#pragma unroll
            for (int g = 0; g < 8; ++g) { const f4 qq = ((const LAS f4*)qbuf)[g * 16 + d4]; s[g] += (qq.x * kk.x + qq.y * kk.y) + (qq.z * kk.z + qq.w * kk.w); } } }
#pragma unroll
    for (int g = 0; g < 8; ++g) sv[g] = valid ? s[g] - slope[g] * (float)dist : -INFINITY;
}
__device__ __forceinline__ void attend_block(const KeyBlk& B, int qpos, int wlim, const float (&slope)[8], const LAS float* qbuf, LAS float* pbuf, float (&m)[8], float (&l)[8], float (&o)[8], int lane) {
    float sv[8];
    qk_block(B, qpos, wlim, slope, qbuf, sv, lane);
#pragma unroll
    for (int g = 0; g < 8; ++g) { const float mn = fmaxf(m[g], wmax(sv[g])); const float p = __expf(sv[g] - mn), a = __expf(m[g] - mn);
        l[g] = l[g] * a + wsum(p); m[g] = mn; o[g] *= a; pbuf[g * 64 + lane] = p; }
    __builtin_amdgcn_wave_barrier(); LDS_WAIT();
    for (int j4 = 0; j4 * 4 < B.nk; ++j4) {
        f4 p4[8];
#pragma unroll
        for (int g = 0; g < 8; ++g) p4[g] = ((const LAS f4*)pbuf)[g * 16 + j4];
#pragma unroll
        for (int jj = 0; jj < 4; ++jj) { const int j = 4 * j4 + jj; const float vv = j < B.nk ? B.vb[(size_t)j * B.stride + lane] : 0.f;
#pragma unroll
            for (int g = 0; g < 8; ++g) o[g] += p4[g][jj] * vv; }
    }
    __builtin_amdgcn_wave_barrier();
}
__device__ __forceinline__ void nsa_unit(const Ctx& C, const NsaArgs& A, int mrow, int n) {
    const int lane = C.lane;
    LAS float* wl = (LAS float*)(C.lds + C.wave * 8192);
    LAS float* qbuf = wl; LAS float* pbuf = wl + 512; LAS float* pbar = wl + 1024; LAS float* scb = wl + 1024 + 544;
    const bool smp = mrow >= TP; const int b = smp ? (mrow - TP) >> 2 : 0, tt = (mrow - TP) & 3; const int qpos = smp ? PASTL + tt : mrow;
    __builtin_amdgcn_wave_barrier();
#pragma unroll
    for (int j = 0; j < 8; ++j) qbuf[lane + 64 * j] = A.QN[(size_t)mrow * 1024 + n * 512 + lane + 64 * j];
    for (int i = lane; i < 544; i += 64) pbar[i] = 0.f;
    float slope[8], m[8], l[8], o[8], oacc[8], inv[8];
#pragma unroll
    for (int g = 0; g < 8; ++g) { slope[g] = exp2f(-0.5f * (float)(n * 8 + g + 1)); oacc[g] = 0.f; }
    const float* gates = A.NG + (size_t)mrow * 48 + n * 24;
    __builtin_amdgcn_wave_barrier(); LDS_WAIT();
#define NSA_INIT() _Pragma("unroll") for (int g = 0; g < 8; ++g) { m[g] = -1e30f; l[g] = 0.f; o[g] = 0.f; }
#define NSA_FIN(br) _Pragma("unroll") for (int g = 0; g < 8; ++g) { inv[g] = 1.f / fmaxf(l[g], 1e-30f); oacc[g] += gates[g * 3 + (br)] * o[g] * inv[g]; }
    const int NC = smp ? NCS : NCP;
    const float* kc = smp ? A.kcs + (size_t)(b * 2 + n) * NCS * 64 : A.kcp + (size_t)n * NCP * 64;
    const float* vc = smp ? A.vcs + (size_t)(b * 2 + n) * NCS * 64 : A.vcp + (size_t)n * NCP * 64;
    int ncv = qpos >= 31 ? (qpos - 31) / 16 + 1 : 0; if (ncv > NC) ncv = NC;
    NSA_INIT();
    for (int c0 = 0; c0 < ncv; c0 += 64) { KeyBlk B{kc + (size_t)c0 * 64, vc + (size_t)c0 * 64, 64, (NC - c0) < 64 ? (NC - c0) : 64, 16 * c0 + 31, 16};
        attend_block(B, qpos, 0x7fffffff, slope, qbuf, pbuf, m, l, o, lane); }
    NSA_FIN(0);
    for (int c0 = 0; c0 < ncv; c0 += 64) { KeyBlk B{kc + (size_t)c0 * 64, vc + (size_t)c0 * 64, 64, (NC - c0) < 64 ? (NC - c0) : 64, 16 * c0 + 31, 16};
        float sv[8]; qk_block(B, qpos, 0x7fffffff, slope, qbuf, sv, lane); float pb = 0.f;
#pragma unroll
        for (int g = 0; g < 8; ++g) pb += __expf(sv[g] - m[g]) * inv[g];
        if (lane < B.nk) pbar[1 + c0 + lane] = pb; }
    __builtin_amdgcn_wave_barrier(); LDS_WAIT();
    const int ns = smp ? NSS : NSP, qblk = qpos >> 6;
    float sc[2]; bool vld[2];
#pragma unroll
    for (int r = 0; r < 2; ++r) { const int blk = lane + 64 * r; vld[r] = blk < ns && blk <= qblk; float s = 0.f;
        if (blk < ns) s = (((pbar[4 * blk] + pbar[4 * blk + 1]) + pbar[4 * blk + 2]) + pbar[4 * blk + 3]) + pbar[4 * blk + 4];
        const bool forced = blk == 0 || blk == qblk || blk == qblk - 1;
        sc[r] = vld[r] ? (forced ? 1.0e4f : s) : -INFINITY; scb[blk] = sc[r]; }
    __builtin_amdgcn_wave_barrier(); LDS_WAIT();
    int rk0 = 0, rk1 = 0;
    for (int i = 0; i < ns; ++i) { const float x = scb[i]; rk0 += (x > sc[0] || (x == sc[0] && i < lane)) ? 1 : 0; rk1 += (x > sc[1] || (x == sc[1] && i < lane + 64)) ? 1 : 0; }
    const unsigned long long sel0 = __ballot(vld[0] && rk0 < SLCT), sel1 = __ballot(vld[1] && rk1 < SLCT);
    NSA_INIT();
    for (int blk = 0; blk <= qblk; ++blk) {
        const bool on = blk < 64 ? ((sel0 >> blk) & 1ull) : ((sel1 >> (blk - 64)) & 1ull);
        if (!on) continue;
        KeyBlk B;
        if (!smp) { const float* base = A.KVO + (size_t)(blk * 64) * 512 + n * 64; B = KeyBlk{base + 256, base + 384, 512, 64, blk * 64, 1}; }
        else if (blk < 32) { const int page = A.pt[b * 16 + (blk >> 1)]; const float* base = A.cache + ((size_t)(page * 128 + (blk & 1) * 64) * 4) * 128 + n * 64; B = KeyBlk{base + 256, base + 384, 512, 64, blk * 64, 1}; }
        else { const float* base = A.KVO + (size_t)(TP + b * 4) * 512 + n * 64; B = KeyBlk{base + 256, base + 384, 512, 4, PASTL, 1}; }
        attend_block(B, qpos, 0x7fffffff, slope, qbuf, pbuf, m, l, o, lane);
    }
    NSA_FIN(1);
    NSA_INIT();
    if (!smp) { int k0 = qpos - (WIN - 1); if (k0 < 0) k0 = 0; k0 &= ~63;
        for (; k0 <= qpos; k0 += 64) { const float* base = A.WINF + (size_t)k0 * 256 + n * 64; KeyBlk B{base, base + 128, 256, 64, k0, 1}; attend_block(B, qpos, WIN, slope, qbuf, pbuf, m, l, o, lane); } }
    else { for (int w0 = 0; w0 < 512; w0 += 64) { const float* base = A.cwin + ((size_t)b * 512 + w0) * 256 + n * 64; KeyBlk B{base, base + 128, 256, 64, PASTL - 512 + w0, 1}; attend_block(B, qpos, WIN, slope, qbuf, pbuf, m, l, o, lane); }
        const float* base = A.WINF + (size_t)(TP + b * 4) * 256 + n * 64; KeyBlk B{base, base + 128, 256, 4, PASTL, 1}; attend_block(B, qpos, WIN, slope, qbuf, pbuf, m, l, o, lane); }
    NSA_FIN(2);
#pragma unroll
    for (int g = 0; g < 8; ++g) A.ONSA[(size_t)mrow * 1024 + (n * 8 + g) * 64 + lane] = (bf16)f2bf(oacc[g]);
#undef NSA_INIT
#undef NSA_FIN
}

typedef short bfx8 __attribute__((ext_vector_type(8)));
typedef short bfx4 __attribute__((ext_vector_type(4)));
__device__ __forceinline__ unsigned cvtpk(float lo, float hi) { return pg8::cvt_pk_bf16(lo, hi); }
__device__ __forceinline__ bfx8 lds_frag16(const LAS bf16* p) { return *(const LAS bfx8*)p; }
__device__ __forceinline__ bfx8 lds_frag8(const LAS bf16* p) { const bfx4 a = *(const LAS bfx4*)p, b = *(const LAS bfx4*)(p + 4); return (bfx8){a[0], a[1], a[2], a[3], b[0], b[1], b[2], b[3]}; }
__device__ __forceinline__ float bflo(unsigned w) { return __uint_as_float(w << 16); }
__device__ __forceinline__ float bfhi(unsigned w) { return __uint_as_float(w & 0xffff0000u); }
constexpr int HG_NCH = TP / 64;
constexpr int L_BF = 0, L_Q0 = 33792, L_QR = L_Q0 + 17408, L_KI = L_QR + 17408, L_VT = L_KI + 17408, L_AB = L_VT + 17408, L_TOT = L_AB + 9216, L_HEND = L_TOT + 2048;
static_assert(L_HEND <= RING_BYTES, "hgrn lds");
__device__ __forceinline__ void chunk_cumsum(const Ctx& C, const f4 (&lf)[4]) {
    LAS float* Bf = (LAS float*)(C.lds + L_BF); LAS float* tot = (LAS float*)(C.lds + L_TOT);
    __syncthreads();
#pragma unroll
    for (int j = 0; j < 4; ++j) ((LAS f4*)Bf)[C.tid + 512 * j] = lf[j];
    __syncthreads();
    const int k = C.tid & 127, qr = C.tid >> 7; float s = 0.f;
#pragma unroll
    for (int r = 0; r < 16; ++r) { s += Bf[(16 * qr + r) * 128 + k]; Bf[(16 * qr + r) * 128 + k] = s; }
    tot[qr * 128 + k] = s;
    __syncthreads();
    float off = 0.f;
    for (int q2 = 0; q2 < qr; ++q2) off += tot[q2 * 128 + k];
#pragma unroll
    for (int r = 0; r < 16; ++r) Bf[(16 * qr + r) * 128 + k] += off;
    __syncthreads();
}
__device__ __forceinline__ void hgrn_A_unit(const Ctx& C, int h, int c, const float* LOGF, const bf16* KH, const bf16* VH, float* UT, float* DD) {
    const int t0 = 64 * c, cb = h * 128;
    LAS float* Bf = (LAS float*)(C.lds + L_BF); LAS bf16* KT = (LAS bf16*)(C.lds + L_KI); LAS bf16* VT = (LAS bf16*)(C.lds + L_VT);
    f4 lf[4]; v4u kv[2], vv[2];
#pragma unroll
    for (int j = 0; j < 4; ++j) { const int idx = C.tid + 512 * j; lf[j] = *(const f4*)(LOGF + (size_t)(t0 + (idx >> 5)) * 1024 + cb + 4 * (idx & 31)); }
#pragma unroll
    for (int j = 0; j < 2; ++j) { const int idx = C.tid + 512 * j; const size_t g = (size_t)(t0 + (idx >> 4)) * 1024 + cb + 8 * (idx & 15); kv[j] = *(const v4u*)(KH + g); vv[j] = *(const v4u*)(VH + g); }
    chunk_cumsum(C, lf);
#pragma unroll
    for (int j = 0; j < 2; ++j) { const int idx = C.tid + 512 * j, s = idx >> 4, ch = 8 * (idx & 15);
        const f4 bl0 = ((const LAS f4*)Bf)[63 * 32 + (ch >> 2)], bl1 = ((const LAS f4*)Bf)[63 * 32 + (ch >> 2) + 1], bs0 = ((const LAS f4*)Bf)[s * 32 + (ch >> 2)], bs1 = ((const LAS f4*)Bf)[s * 32 + (ch >> 2) + 1];
        const unsigned kw[4] = {kv[j].x, kv[j].y, kv[j].z, kv[j].w}, vw[4] = {vv[j].x, vv[j].y, vv[j].z, vv[j].w};
        const float dl[8] = {bl0.x - bs0.x, bl0.y - bs0.y, bl0.z - bs0.z, bl0.w - bs0.w, bl1.x - bs1.x, bl1.y - bs1.y, bl1.z - bs1.z, bl1.w - bs1.w};
#pragma unroll
        for (int e = 0; e < 8; ++e) { const float kf = (e & 1) ? bfhi(kw[e >> 1]) : bflo(kw[e >> 1]);
            KT[(ch + e) * 68 + s] = (bf16)f2bf(kf * __expf(dl[e])); VT[(ch + e) * 68 + s] = (bf16)((e & 1) ? (vw[e >> 1] >> 16) : (vw[e >> 1] & 0xffffu)); } }
    if (C.tid < 128) DD[(size_t)(c * 8 + h) * 128 + C.tid] = __expf(Bf[63 * 128 + C.tid]);
    __syncthreads();
    const int w = C.wave, lane = C.lane, fr = lane & 15, kg = lane >> 4;
    pg8::f32x4 acc[8];
#pragma unroll
    for (int nt = 0; nt < 8; ++nt) acc[nt] = (pg8::f32x4){0.f, 0.f, 0.f, 0.f};
#pragma unroll
    for (int ks = 0; ks < 2; ++ks) { const bfx8 a = lds_frag8(VT + (16 * w + fr) * 68 + 32 * ks + 8 * kg);
#pragma unroll
        for (int nt = 0; nt < 8; ++nt) { const bfx8 b = lds_frag8(KT + (16 * nt + fr) * 68 + 32 * ks + 8 * kg); acc[nt] = __builtin_amdgcn_mfma_f32_16x16x32_bf16(a, b, acc[nt], 0, 0, 0); } }
    float* ut = UT + (size_t)(c * 8 + h) * 16384;
#pragma unroll
    for (int nt = 0; nt < 8; ++nt)
#pragma unroll
        for (int r = 0; r < 4; ++r) ut[(size_t)(16 * w + 4 * kg + r) * 128 + 16 * nt + fr] = acc[nt][r];
    __syncthreads();
}
__device__ __forceinline__ void hgrn_scan(int tix, int nthr, const float* UT, const float* DD, bf16* SP, float* hgp) {
    for (int e = tix; e < 8 * 16384; e += nthr) { const int h = e >> 14, vk = e & 16383, k = e & 127, v = vk >> 7;
        float S = 0.f;
        for (int c = 0; c < HG_NCH; c += 16) { float u[16], d[16];
#pragma unroll
            for (int i = 0; i < 16; ++i) { u[i] = UT[(size_t)((c + i) * 8 + h) * 16384 + vk]; d[i] = DD[(size_t)((c + i) * 8 + h) * 128 + k]; }
#pragma unroll
            for (int i = 0; i < 16; ++i) { SP[(size_t)((c + i) * 8 + h) * 16384 + vk] = (bf16)f2bf(S); S = S * d[i] + u[i]; } }
        hgp[(size_t)h * 16384 + k * 128 + v] = S; }
}
__device__ __forceinline__ void hgrn_B_unit(const Ctx& C, int h, int c, const bf16* QH, const float* LOGF, const bf16* KH, const bf16* VH, const bf16* GH, const float* gn, const bf16* SP, bf16* OHG) {
    const int t0 = 64 * c, cb = h * 128, tid = C.tid;
    LAS float* Bf = (LAS float*)(C.lds + L_BF); LAS bf16* Q0 = (LAS bf16*)(C.lds + L_Q0); LAS bf16* QR = (LAS bf16*)(C.lds + L_QR); LAS bf16* KI = (LAS bf16*)(C.lds + L_KI);
    LAS bf16* VT = (LAS bf16*)(C.lds + L_VT); LAS bf16* AB = (LAS bf16*)(C.lds + L_AB); LAS float* Of = (LAS float*)(C.lds + L_BF);
    STAMP(C, 9);
    f4 lf[4], q4[4], k4[4], b4[4]; v4u vv[2]; float gh[16];
    const int w = C.wave, lane = C.lane, fr = lane & 15, kg = lane >> 4;
#pragma unroll
    for (int j = 0; j < 4; ++j) { const int idx = tid + 512 * j; const size_t g = (size_t)(t0 + (idx >> 5)) * 1024 + cb + 4 * (idx & 31); lf[j] = *(const f4*)(LOGF + g);
        const u2 qw = *(const u2*)(QH + g), kw = *(const u2*)(KH + g); q4[j] = (f4){bflo(qw.x), bfhi(qw.x), bflo(qw.y), bfhi(qw.y)}; k4[j] = (f4){bflo(kw.x), bfhi(kw.x), bflo(kw.y), bfhi(kw.y)}; }
#pragma unroll
    for (int j = 0; j < 2; ++j) { const int idx = tid + 512 * j; vv[j] = *(const v4u*)(VH + (size_t)(t0 + (idx >> 4)) * 1024 + cb + 8 * (idx & 15)); }
#pragma unroll
    for (int rr = 0; rr < 8; ++rr) { const size_t g = (size_t)(t0 + 8 * w + rr) * 1024 + cb; gh[2 * rr] = bflo((unsigned)GH[g + lane]); gh[2 * rr + 1] = bflo((unsigned)GH[g + lane + 64]); }
    const bf16* sp = SP + (size_t)(c * 8 + h) * 16384; bfx8 spf[4][4];
#pragma unroll
    for (int ks = 0; ks < 4; ++ks)
#pragma unroll
        for (int nt = 0; nt < 4; ++nt) spf[ks][nt] = *(const bfx8*)(sp + (size_t)(16 * (4 * (w >> 2) + nt) + fr) * 128 + 32 * ks + 8 * kg);
    chunk_cumsum(C, lf);
    STAMP(C, 1);
#pragma unroll
    for (int j = 0; j < 4; ++j) { const int idx = tid + 512 * j, t = idx >> 5, c4 = idx & 31, i = t >> 4;
        const f4 q = q4[j]; b4[j] = ((const LAS f4*)Bf)[idx];
        const f4 r = i > 0 ? ((const LAS f4*)Bf)[(16 * i - 1) * 32 + c4] : (f4){0.f, 0.f, 0.f, 0.f};
        u2 w0, w1;
        w0.x = cvtpk(q.x * __expf(b4[j].x), q.y * __expf(b4[j].y)); w0.y = cvtpk(q.z * __expf(b4[j].z), q.w * __expf(b4[j].w));
        w1.x = cvtpk(q.x * __expf(b4[j].x - r.x), q.y * __expf(b4[j].y - r.y)); w1.y = cvtpk(q.z * __expf(b4[j].z - r.z), q.w * __expf(b4[j].w - r.w));
        *(LAS u2*)(Q0 + t * 136 + 4 * c4) = w0; *(LAS u2*)(QR + t * 136 + 4 * c4) = w1; }
#pragma unroll
    for (int j = 0; j < 2; ++j) { const int idx = tid + 512 * j, s = idx >> 4, ch = 8 * (idx & 15); const unsigned vw[4] = {vv[j].x, vv[j].y, vv[j].z, vv[j].w};
#pragma unroll
        for (int e = 0; e < 8; ++e) VT[(ch + e) * 68 + s] = (bf16)((e & 1) ? (vw[e >> 1] >> 16) : (vw[e >> 1] & 0xffffu)); }
    for (int e = tid; e < 64 * 72 / 2; e += 512) ((LAS unsigned*)AB)[e] = 0u;
    STAMP(C, 2);
    for (int i = 0; i < 4; ++i) {
        const f4 r = i > 0 ? ((const LAS f4*)Bf)[(16 * i - 1) * 32 + (tid & 31)] : (f4){0.f, 0.f, 0.f, 0.f};
#pragma unroll
        for (int j = 0; j < 4; ++j) if (j <= i) { const int t = (tid >> 5) + 16 * j; u2 wv;
            wv.x = cvtpk(k4[j].x * __expf(r.x - b4[j].x), k4[j].y * __expf(r.y - b4[j].y)); wv.y = cvtpk(k4[j].z * __expf(r.z - b4[j].z), k4[j].w * __expf(r.w - b4[j].w));
            *(LAS u2*)(KI + t * 136 + 4 * (tid & 31)) = wv; }
        __syncthreads();
        if (w <= i) { pg8::f32x4 a4 = (pg8::f32x4){0.f, 0.f, 0.f, 0.f};
#pragma unroll
            for (int ks = 0; ks < 4; ++ks) { const bfx8 a = lds_frag16(QR + (16 * i + fr) * 136 + 32 * ks + 8 * kg), b = lds_frag16(KI + (16 * w + fr) * 136 + 32 * ks + 8 * kg);
                a4 = __builtin_amdgcn_mfma_f32_16x16x32_bf16(a, b, a4, 0, 0, 0); }
#pragma unroll
            for (int rr = 0; rr < 4; ++rr) { const int tl = 4 * kg + rr; const float val = (w < i || fr <= tl) ? a4[rr] : 0.f; AB[(16 * i + tl) * 72 + 16 * w + fr] = (bf16)f2bf(val); } }
        __syncthreads();
    }
    STAMP(C, 3);
    const int rt = w & 3, chf = w >> 2;
    pg8::f32x4 acc[4];
#pragma unroll
    for (int nt = 0; nt < 4; ++nt) acc[nt] = (pg8::f32x4){0.f, 0.f, 0.f, 0.f};
#pragma unroll
    for (int ks = 0; ks < 4; ++ks) { const bfx8 a = lds_frag16(Q0 + (16 * rt + fr) * 136 + 32 * ks + 8 * kg);
#pragma unroll
        for (int nt = 0; nt < 4; ++nt) acc[nt] = __builtin_amdgcn_mfma_f32_16x16x32_bf16(a, spf[ks][nt], acc[nt], 0, 0, 0); }
#pragma unroll
    for (int ks = 0; ks < 2; ++ks) if (2 * ks <= rt) { const bfx8 a = lds_frag16(AB + (16 * rt + fr) * 72 + 32 * ks + 8 * kg);
#pragma unroll
        for (int nt = 0; nt < 4; ++nt) { const bfx8 b = lds_frag8(VT + (16 * (4 * chf + nt) + fr) * 68 + 32 * ks + 8 * kg); acc[nt] = __builtin_amdgcn_mfma_f32_16x16x32_bf16(a, b, acc[nt], 0, 0, 0); } }
#pragma unroll
    for (int nt = 0; nt < 4; ++nt)
#pragma unroll
        for (int rr = 0; rr < 4; ++rr) Of[(16 * rt + 4 * kg + rr) * 132 + 16 * (4 * chf + nt) + fr] = acc[nt][rr];
    __syncthreads();
#pragma unroll
    for (int rr = 0; rr < 8; ++rr) { const int row = 8 * w + rr; const float o0 = Of[row * 132 + lane], o1 = Of[row * 132 + lane + 64];
        const float rs = rsqrtf(wsum(o0 * o0 + o1 * o1) * (1.f / 128.f) + EPS); const size_t g = (size_t)(t0 + row) * 1024 + cb;
        OHG[g + lane] = (bf16)f2bf(o0 * rs * gn[lane] * gh[2 * rr]); OHG[g + lane + 64] = (bf16)f2bf(o1 * rs * gn[lane + 64] * gh[2 * rr + 1]); }
    __syncthreads();
    STAMP(C, 4);
}
typedef float f16v __attribute__((ext_vector_type(16)));
constexpr float LOG2E = 1.4426950408889634f;
constexpr int NL_KT = 0, NL_VT = 9216, NL_GS = 18432, NL_LS = NL_GS + 16384, NL_SEL = NL_LS + 16384, NL_UNI = NL_SEL + 512, NL_OACC = NL_UNI + 64, NL_END = NL_OACC + 8 * 8192;
static_assert(NL_END <= RING_BYTES, "nsa lds");
struct NsaP { const bf16* QN16; const bf16* KSL; const bf16* VSL; const bf16* KWN; const bf16* VWN; const bf16* KC16; const bf16* VC16; const float* NG; bf16* ONSA; };
__device__ __forceinline__ float ex2(float x) { return __builtin_amdgcn_exp2f(x); }
__device__ __forceinline__ void nsa_fetch(const Ctx& C, const bf16* ksrc, const bf16* vsrc, int pitch, int nvalid, v4u& kr, v4u& vr) {
    { const int key = C.tid >> 3, d8 = C.tid & 7; kr = (v4u){0u, 0u, 0u, 0u}; if (key < nvalid) kr = *(const v4u*)(ksrc + (size_t)key * pitch + 8 * d8); }
    { const int key = C.tid & 63, d8 = C.tid >> 6; vr = (v4u){0u, 0u, 0u, 0u}; if (key < nvalid) vr = *(const v4u*)(vsrc + (size_t)key * pitch + 8 * d8); }
}
__device__ __forceinline__ void nsa_put(const Ctx& C, const v4u& kr, const v4u& vr) {
    LAS bf16* KT = (LAS bf16*)(C.lds + NL_KT); LAS bf16* VT = (LAS bf16*)(C.lds + NL_VT);
    { const int key = C.tid >> 3, d8 = C.tid & 7; *(LAS v4u*)(KT + key * 72 + 8 * d8) = kr; }
    { const int key = C.tid & 63, d8 = C.tid >> 6; const v4u v = vr; LAS bf16* p = VT + (8 * d8) * 72 + key;
        p[0] = (bf16)(v.x & 0xffffu); p[72] = (bf16)(v.x >> 16); p[144] = (bf16)(v.y & 0xffffu); p[216] = (bf16)(v.y >> 16);
        p[288] = (bf16)(v.z & 0xffffu); p[360] = (bf16)(v.z >> 16); p[432] = (bf16)(v.w & 0xffffu); p[504] = (bf16)(v.w >> 16); }
}
__device__ __forceinline__ int prev_bit(const unsigned (&u)[4], int below) {
#pragma unroll
    for (int wi = 3; wi >= 0; --wi) { const int lim = below - 32 * wi; if (lim <= 0) continue; const unsigned m = lim >= 32 ? u[wi] : (u[wi] & ((1u << lim) - 1u)); if (m) return 32 * wi + 31 - __clz(m); }
    return -1;
}
template <int NT> __device__ __forceinline__ void nsa_scores_t(const LAS bf16* KT, int lane, const bfx8 (&qf)[4], int klo, int khi, float base, float inc, f16v (&s)[NT]) {
    const int q = lane & 31, hi = lane >> 5;
    int kl = klo - 4 * hi, kh = khi - 4 * hi; float bh = fmaf(inc, (float)(4 * hi), base);
    asm volatile("" : "+v"(inc), "+v"(bh), "+v"(kl), "+v"(kh));
#pragma unroll
    for (int t = 0; t < NT; ++t) { s[t] = (f16v){0.f, 0.f, 0.f, 0.f, 0.f, 0.f, 0.f, 0.f, 0.f, 0.f, 0.f, 0.f, 0.f, 0.f, 0.f, 0.f};
#pragma unroll
        for (int ks = 0; ks < 4; ++ks) { const bfx8 a = *(const LAS bfx8*)(KT + (32 * t + q) * 72 + 16 * ks + 8 * hi); s[t] = __builtin_amdgcn_mfma_f32_32x32x16_bf16(a, qf[ks], s[t], 0, 0, 0); } }
    if (__builtin_amdgcn_readfirstlane(__all(klo <= 0 && khi >= 32 * NT - 1))) {
#pragma unroll
        for (int t = 0; t < NT; ++t)
#pragma unroll
            for (int r = 0; r < 16; ++r) { const int cr = 32 * t + (r & 3) + 8 * (r >> 2); s[t][r] = s[t][r] + fmaf(inc, (float)cr, bh); }
    } else {
#pragma unroll
        for (int t = 0; t < NT; ++t)
#pragma unroll
            for (int r = 0; r < 16; ++r) { const int cr = 32 * t + (r & 3) + 8 * (r >> 2); const float v = s[t][r] + fmaf(inc, (float)cr, bh); s[t][r] = (cr >= kl && cr <= kh) ? v : -INFINITY; }
    }
}
__device__ __forceinline__ void nsa_scores(const Ctx& C, const bfx8 (&qf)[4], int klo, int khi, float base, float inc, f16v (&s)[2]) { nsa_scores_t<2>((const LAS bf16*)(C.lds + NL_KT), C.lane, qf, klo, khi, base, inc, s); }
template <int NT, int VP> __device__ __forceinline__ void nsa_block_t(const LAS bf16* KT, const LAS bf16* VT, int lane, const bfx8 (&qf)[4], int klo, int khi, float base, float inc, float& m, float& l, f16v (&O)[2]) {
    const int q = lane & 31, hi = lane >> 5;
    if (!__builtin_amdgcn_readfirstlane(__any(khi >= klo))) return;
    f16v s[NT];
    nsa_scores_t<NT>(KT, lane, qf, klo, khi, base, inc, s);
    float mx = -INFINITY;
#pragma unroll
    for (int t = 0; t < NT; ++t)
#pragma unroll
        for (int r = 0; r < 16; ++r) mx = fmaxf(mx, s[t][r]);
    mx = fmaxf(mx, __shfl_xor(mx, 32));
    const float mn = fmaxf(m, mx), alpha = ex2(m - mn); m = mn;
    float rs = 0.f;
#pragma unroll
    for (int t = 0; t < NT; ++t)
#pragma unroll
        for (int r = 0; r < 16; ++r) { const float p = ex2(s[t][r] - mn); s[t][r] = p; rs += p; }
    l = l * alpha + rs;
    if (__builtin_amdgcn_readfirstlane(__any(alpha != 1.0f))) {
#pragma unroll
        for (int dt = 0; dt < 2; ++dt) O[dt] = O[dt] * alpha; }
#pragma unroll
    for (int t = 0; t < NT; ++t)
#pragma unroll
        for (int s2 = 0; s2 < 2; ++s2) {
            union { unsigned u[4]; bfx8 v; } pb;
#pragma unroll
            for (int j = 0; j < 4; ++j) pb.u[j] = cvtpk(s[t][8 * s2 + 2 * j], s[t][8 * s2 + 2 * j + 1]);
#pragma unroll
            for (int dt = 0; dt < 2; ++dt) { const LAS bf16* vp = VT + (32 * dt + q) * VP + 32 * t + 16 * s2 + 4 * hi; const bfx4 va = *(const LAS bfx4*)vp, vb = *(const LAS bfx4*)(vp + 8); const bfx8 a = (bfx8){va[0], va[1], va[2], va[3], vb[0], vb[1], vb[2], vb[3]}; O[dt] = __builtin_amdgcn_mfma_f32_32x32x16_bf16(a, pb.v, O[dt], 0, 0, 0); }
        }
}
__device__ __forceinline__ void nsa_block(const Ctx& C, const bfx8 (&qf)[4], int klo, int khi, float base, float inc, float& m, float& l, f16v (&O)[2]) {
    nsa_block_t<2, 72>((const LAS bf16*)(C.lds + NL_KT), (const LAS bf16*)(C.lds + NL_VT), C.lane, qf, klo, khi, base, inc, m, l, O); }
__device__ __forceinline__ void nsa_prompt_unit(const Ctx& C, const NsaP& A, int qt, int n) {
    int lane = C.lane; asm volatile("" : "+v"(lane));
    const int w = C.wave, q = lane & 31, hi = lane >> 5, tl = q >> 3, g = q & 7, tok = 4 * w + tl, q0 = 32 * qt, qpos = q0 + tok, head = n * 8 + g;
    LAS float* GS = (LAS float*)(C.lds + NL_GS); LAS float* LS = (LAS float*)(C.lds + NL_LS); LAS unsigned* SEL = (LAS unsigned*)(C.lds + NL_SEL); LAS unsigned* UNI = (LAS unsigned*)(C.lds + NL_UNI);
    const float slope2 = exp2f(-0.5f * (float)(head + 1)) * LOG2E;
    bfx8 qf[4];
#pragma unroll
    for (int ks = 0; ks < 4; ++ks) qf[ks] = *(const bfx8*)(A.QN16 + (size_t)qpos * 1024 + head * 64 + 16 * ks + 8 * hi);
    const float* gates = A.NG + (size_t)qpos * 48 + head * 3;
    f16v O[2]; float m, l;
    LAS float* OA = (LAS float*)(C.lds + NL_OACC + w * 8192) + lane;
#define NP_INIT() do { m = -1e30f; l = 0.f; O[0] = (f16v){0.f, 0.f, 0.f, 0.f, 0.f, 0.f, 0.f, 0.f, 0.f, 0.f, 0.f, 0.f, 0.f, 0.f, 0.f, 0.f}; O[1] = O[0]; } while (0)
#define NP_FIN(br) do { const float lt = l + __shfl_xor(l, 32); const float sc = gates[br] / fmaxf(lt, 1e-30f); _Pragma("unroll") for (int dt = 0; dt < 2; ++dt) _Pragma("unroll") for (int r = 0; r < 16; ++r) { \
        const float pv = (br) == 0 ? 0.f : OA[(dt * 16 + r) * 64]; OA[(dt * 16 + r) * 64] = pv + O[dt][r] * sc; } l = lt; } while (0)
    __syncthreads();
    for (int i = C.tid; i < 8192; i += NTHR) GS[i] = 0.f;
    const int cmax = qpos >= 31 ? (qpos - 31) >> 4 : -1;
    const int ncb = ((q0 + 31 - 31) >> 4) / 64 + 1;
    const bf16* kc = A.KC16 + (size_t)n * 512 * 64; const bf16* vc = A.VC16 + (size_t)n * 512 * 64;
    NP_INIT();
    v4u kr, vr;
#define FETCH_C(cb_) nsa_fetch(C, kc + (size_t)(cb_) * 4096, vc + (size_t)(cb_) * 4096, 64, (NCP - 64 * (cb_)) < 64 ? (NCP - 64 * (cb_)) : 64, kr, vr)
    FETCH_C(ncb - 1);
    for (int cb = ncb - 1; cb >= 0; --cb) { const int nk = (NCP - 64 * cb) < 64 ? (NCP - 64 * cb) : 64;
        __syncthreads(); nsa_put(C, kr, vr); __syncthreads();
        if (cb > 0) FETCH_C(cb - 1);
        int khi = cmax - 64 * cb; if (khi > nk - 1) khi = nk - 1;
        nsa_block(C, qf, 0, khi, -slope2 * (float)(qpos - 31 - 1024 * cb), 16.f * slope2, m, l, O); }
    NP_FIN(0);
    { const float invl = 1.f / fmaxf(l, 1e-30f);
      FETCH_C(ncb - 1);
      for (int cb = ncb - 1; cb >= 0; --cb) { const int nk = (NCP - 64 * cb) < 64 ? (NCP - 64 * cb) : 64;
        __syncthreads(); nsa_put(C, kr, vr); __syncthreads();
        if (cb > 0) FETCH_C(cb - 1);
        int khi = cmax - 64 * cb; if (khi > nk - 1) khi = nk - 1;
        f16v s[2]; nsa_scores(C, qf, 0, khi, -slope2 * (float)(qpos - 31 - 1024 * cb), 16.f * slope2, s);
#pragma unroll
        for (int t = 0; t < 2; ++t)
#pragma unroll
            for (int a = 0; a < 4; ++a) { float p[4];
#pragma unroll
                for (int j = 0; j < 4; ++j) { float x = ex2(s[t][4 * a + j] - m) * invl; x += __shfl_xor(x, 1); x += __shfl_xor(x, 2); x += __shfl_xor(x, 4); p[j] = x; }
                if (g == 0) { const int grp = 16 * cb + 8 * t + 2 * a + hi; GS[tok * 128 + grp] = ((p[0] + p[1]) + p[2]) + p[3]; LS[tok * 128 + grp] = p[3]; } } } }
    __syncthreads();
    for (int t4 = 0; t4 < 4; ++t4) { const int tk = 4 * w + t4, qp = q0 + tk, qblk = qp >> 6;
        bool cand[2], forced[2]; unsigned u[2];
#pragma unroll
        for (int r = 0; r < 2; ++r) { const int blk = lane + 64 * r; const bool valid = blk <= qblk; const bool fz = blk == 0 || blk == qblk || blk == qblk - 1;
            const float scv = GS[tk * 128 + blk] + (blk > 0 ? LS[tk * 128 + blk - 1] : 0.f);
            forced[r] = valid && fz; cand[r] = valid && !fz; u[r] = cand[r] ? __float_as_uint(scv) : 0u; }
        const int nforced = qblk == 0 ? 1 : (qblk == 1 ? 2 : 3), need = SLCT - nforced;
        const int ncand = __popcll(__ballot(cand[0])) + __popcll(__ballot(cand[1]));
        bool sel[2];
        if (ncand <= need) { sel[0] = forced[0] || cand[0]; sel[1] = forced[1] || cand[1]; }
        else { unsigned T = 0u;
            for (int bit = 30; bit >= 0; --bit) { const unsigned c = T | (1u << bit); const int cnt = __popcll(__ballot(cand[0] && u[0] >= c)) + __popcll(__ballot(cand[1] && u[1] >= c)); if (cnt >= need) T = c; }
            const bool gt0 = cand[0] && u[0] > T, gt1 = cand[1] && u[1] > T, eq0 = cand[0] && u[0] == T, eq1 = cand[1] && u[1] == T;
            const int rem = need - (__popcll(__ballot(gt0)) + __popcll(__ballot(gt1)));
            const unsigned long long be0 = __ballot(eq0), be1 = __ballot(eq1), lt = (1ull << lane) - 1ull;
            const int i0 = __popcll(be0 & lt), i1 = __popcll(be0) + __popcll(be1 & lt);
            sel[0] = forced[0] || gt0 || (eq0 && i0 < rem); sel[1] = forced[1] || gt1 || (eq1 && i1 < rem); }
        const unsigned long long b0 = __ballot(sel[0]), b1 = __ballot(sel[1]);
        if (lane == 0) { SEL[tk * 4 + 0] = (unsigned)b0; SEL[tk * 4 + 1] = (unsigned)(b0 >> 32); SEL[tk * 4 + 2] = (unsigned)b1; SEL[tk * 4 + 3] = (unsigned)(b1 >> 32); } }
    __syncthreads();
    if (C.tid < 4) { unsigned o = 0u; for (int t = 0; t < 32; ++t) o |= SEL[t * 4 + C.tid]; UNI[C.tid] = o; }
    __syncthreads();
    const unsigned sw0 = SEL[tok * 4 + 0], sw1 = SEL[tok * 4 + 1], sw2 = SEL[tok * 4 + 2], sw3 = SEL[tok * 4 + 3];
    const unsigned un0 = UNI[0], un1 = UNI[1], un2 = UNI[2], un3 = UNI[3];
    NP_INIT();
    { const unsigned un[4] = {un0, un1, un2, un3};
#define FETCH_S(b_) nsa_fetch(C, A.KSL + (size_t)(64 * (b_)) * 128 + n * 64, A.VSL + (size_t)(64 * (b_)) * 128 + n * 64, 128, 64, kr, vr)
      int blk = prev_bit(un, 128);
      if (blk >= 0) FETCH_S(blk);
      while (blk >= 0) {
        __syncthreads(); nsa_put(C, kr, vr); __syncthreads();
        const int nb = prev_bit(un, blk); if (nb >= 0) FETCH_S(nb);
        const unsigned mw = blk < 32 ? sw0 : (blk < 64 ? sw1 : (blk < 96 ? sw2 : sw3));
        int khi = ((mw >> (blk & 31)) & 1u) ? qpos - 64 * blk : -1; if (khi > 63) khi = 63;
        nsa_block(C, qf, 0, khi, -slope2 * (float)(qpos - 64 * blk), slope2, m, l, O);
        blk = nb; } }
    NP_FIN(1);
    NP_INIT();
    { int kb0 = q0 - (WIN - 1); if (kb0 < 0) kb0 = 0; kb0 >>= 6;
#define FETCH_W(b_) nsa_fetch(C, A.KWN + (size_t)(64 * (b_)) * 128 + n * 64, A.VWN + (size_t)(64 * (b_)) * 128 + n * 64, 128, 64, kr, vr)
      FETCH_W((q0 + 31) >> 6);
      for (int kb = (q0 + 31) >> 6; kb >= kb0; --kb) {
        __syncthreads(); nsa_put(C, kr, vr); __syncthreads();
        if (kb > kb0) FETCH_W(kb - 1);
        int klo = qpos - (WIN - 1) - 64 * kb; if (klo < 0) klo = 0; int khi = qpos - 64 * kb; if (khi > 63) khi = 63;
        nsa_block(C, qf, klo, khi, -slope2 * (float)(qpos - 64 * kb), slope2, m, l, O); } }
    NP_FIN(2);
    bf16* orow = A.ONSA + (size_t)qpos * 1024 + head * 64;
#pragma unroll
    for (int dt = 0; dt < 2; ++dt)
#pragma unroll
        for (int a = 0; a < 4; ++a) { const int rb = (dt * 16 + 4 * a) * 64; u2 wv; wv.x = cvtpk(OA[rb], OA[rb + 64]); wv.y = cvtpk(OA[rb + 128], OA[rb + 192]); *(u2*)(orow + 32 * dt + 8 * a + 4 * hi) = wv; }
    __syncthreads();
#undef NP_INIT
#undef NP_FIN
#undef FETCH_C
#undef FETCH_S
#undef FETCH_W
}

struct NsaS { const bf16* QN; const float* KVO; const float* WINF; const float* NG; const float* cache; const float* cwin; const int* pt; const float* kcs; const float* vcs; bf16* ONSA; };
constexpr int SL_MW = 0, SL_LW = 2048, SL_GS = 4096, SL_LS = 6144, SL_SEL = 8192, SL_LIST = 8256, SL_CNT = 8416, SL_ROW = 8448, SL_KT = 12544, SL_VT = SL_KT + 8 * 4608, SL_END = SL_VT + 8 * 5120, SL_OW = SL_KT;
static_assert(SL_END <= RING_BYTES && SL_OW + 8 * 8192 <= SL_END, "nsa sample lds");
__device__ __forceinline__ bool ns_rows(const Ctx& C, const NsaS& A, int mode, int j, int b, int n, int slot, const float*& kp, const float*& vp) {
    if (mode == 0) { if (slot >= NCS) return false; kp = A.kcs + ((size_t)(b * 2 + n) * NCS + slot) * 64; vp = A.vcs + ((size_t)(b * 2 + n) * NCS + slot) * 64; return true; }
    if (mode == 1) { const LAS int* LIST = (const LAS int*)(C.lds + SL_LIST); const int cnt = *(const LAS int*)(C.lds + SL_CNT); const int e = 4 * j + (slot >> 6), kk = slot & 63;
        if (e >= cnt) return false; const int blk = LIST[e];
        if (blk < 32) { const float* base = A.cache + ((size_t)(A.pt[b * 16 + (blk >> 1)] * 128 + (blk & 1) * 64 + kk) * 4) * 128 + n * 64; kp = base + 256; vp = base + 384; return true; }
        if (kk >= DS) return false; const float* base = A.KVO + (size_t)(TP + b * 4 + kk) * 512 + n * 64; kp = base + 256; vp = base + 384; return true; }
    const int wi = 256 * j + slot;
    if (wi < 512) { const float* base = A.cwin + ((size_t)b * 512 + wi) * 256 + n * 64; kp = base; vp = base + 128; return true; }
    if (wi < 512 + DS) { const float* base = A.WINF + (size_t)(TP + b * 4 + wi - 512) * 256 + n * 64; kp = base; vp = base + 128; return true; }
    return false;
}
__device__ __forceinline__ void ns_stage(const Ctx& C, const NsaS& A, int mode, int j, int b, int n) {
    LAS unsigned long long* RK = (LAS unsigned long long*)(C.lds + SL_ROW); LAS unsigned long long* RV = RK + 256;
    if (C.tid < 256) { const float* kp = nullptr; const float* vp = nullptr; const bool ok = ns_rows(C, A, mode, j, b, n, C.tid, kp, vp); RK[C.tid] = ok ? (unsigned long long)kp : 0ull; RV[C.tid] = ok ? (unsigned long long)vp : 0ull; }
    __syncthreads();
    { const int slot = C.tid >> 1, half = C.tid & 1; const float* kp = (const float*)RK[slot];
      LAS bf16* dst = (LAS bf16*)(C.lds + SL_KT + (slot >> 5) * 4608) + (slot & 31) * 72 + 32 * half;
      f4 x[8];
#pragma unroll
      for (int i = 0; i < 8; ++i) x[i] = kp ? *(const f4*)(kp + 32 * half + 4 * i) : (f4){0.f, 0.f, 0.f, 0.f};
#pragma unroll
      for (int i = 0; i < 4; ++i) { v4u o; o.x = cvtpk(x[2 * i].x, x[2 * i].y); o.y = cvtpk(x[2 * i].z, x[2 * i].w); o.z = cvtpk(x[2 * i + 1].x, x[2 * i + 1].y); o.w = cvtpk(x[2 * i + 1].z, x[2 * i + 1].w); *(LAS v4u*)(dst + 8 * i) = o; } }
    { const int slot = C.tid & 255, dq = C.tid >> 8; const float* vp = (const float*)RV[slot];
      LAS bf16* dst = (LAS bf16*)(C.lds + SL_VT + (slot >> 5) * 5120) + (32 * dq) * 40 + (slot & 31);
      f4 x[8];
#pragma unroll
      for (int i = 0; i < 8; ++i) x[i] = vp ? *(const f4*)(vp + 32 * dq + 4 * i) : (f4){0.f, 0.f, 0.f, 0.f};
#pragma unroll
      for (int i = 0; i < 8; ++i) { dst[(4 * i) * 40] = (bf16)f2bf(x[i].x); dst[(4 * i + 1) * 40] = (bf16)f2bf(x[i].y); dst[(4 * i + 2) * 40] = (bf16)f2bf(x[i].z); dst[(4 * i + 3) * 40] = (bf16)f2bf(x[i].w); } }
}
__device__ __forceinline__ void nsa_sample_unit(const Ctx& C, const NsaS& A, int b, int n) {
    int lane = C.lane; asm volatile("" : "+v"(lane));
    const int w = C.wave, q = lane & 31, hi = lane >> 5, tl = q >> 3, g = q & 7, head = n * 8 + g, qpos = PASTL + tl, mrow = TP + 4 * b + tl;
    const LAS bf16* KTw = (const LAS bf16*)(C.lds + SL_KT + w * 4608); const LAS bf16* VTw = (const LAS bf16*)(C.lds + SL_VT + w * 5120);
    LAS float* MW = (LAS float*)(C.lds + SL_MW); LAS float* LW = (LAS float*)(C.lds + SL_LW); LAS float* GS = (LAS float*)(C.lds + SL_GS); LAS float* LS = (LAS float*)(C.lds + SL_LS);
    LAS unsigned* SEL = (LAS unsigned*)(C.lds + SL_SEL); LAS int* LIST = (LAS int*)(C.lds + SL_LIST); LAS int* CNT = (LAS int*)(C.lds + SL_CNT); LAS float* OW = (LAS float*)(C.lds + SL_OW);
    const float slope2 = exp2f(-0.5f * (float)(head + 1)) * LOG2E;
    bfx8 qf[4];
#pragma unroll
    for (int ks = 0; ks < 4; ++ks) qf[ks] = *(const bfx8*)(A.QN + (size_t)mrow * 1024 + head * 64 + 16 * ks + 8 * hi);
    const float* gates = A.NG + (size_t)mrow * 48 + head * 3;
    float acc4[4] = {0.f, 0.f, 0.f, 0.f}; f16v O[2]; float m, l;
#define NS_INIT() do { m = -1e30f; l = 0.f; O[0] = (f16v){0.f, 0.f, 0.f, 0.f, 0.f, 0.f, 0.f, 0.f, 0.f, 0.f, 0.f, 0.f, 0.f, 0.f, 0.f, 0.f}; O[1] = O[0]; } while (0)
#define NS_MERGE(br) do { MW[w * 64 + lane] = m; LW[w * 64 + lane] = l; _Pragma("unroll") for (int dt = 0; dt < 2; ++dt) _Pragma("unroll") for (int r = 0; r < 16; ++r) OW[(w * 32 + dt * 16 + r) * 64 + lane] = O[dt][r]; \
        __syncthreads(); float M_ = -1e30f; _Pragma("unroll") for (int w2 = 0; w2 < 8; ++w2) M_ = fmaxf(M_, MW[w2 * 64 + lane]); float L_ = 0.f, o_[4] = {0.f, 0.f, 0.f, 0.f}; \
        _Pragma("unroll") for (int w2 = 0; w2 < 8; ++w2) { const float sc_ = ex2(MW[w2 * 64 + lane] - M_); L_ += (LW[w2 * 64 + lane] + LW[w2 * 64 + (lane ^ 32)]) * sc_; \
            _Pragma("unroll") for (int r = 0; r < 4; ++r) o_[r] += OW[(w2 * 32 + 4 * w + r) * 64 + lane] * sc_; } \
        const float gs_ = gates[br] / fmaxf(L_, 1e-30f); _Pragma("unroll") for (int r = 0; r < 4; ++r) acc4[r] += o_[r] * gs_; __syncthreads(); } while (0)
    __syncthreads();
    for (int i = C.tid; i < 1024; i += NTHR) GS[i] = 0.f;
    ns_stage(C, A, 0, 0, b, n);
    __syncthreads();
    { int khi = (NCS - 1) - 32 * w; if (khi > 31) khi = 31; const float base = -slope2 * (float)(qpos - 31 - 512 * w), inc = 16.f * slope2;
      NS_INIT(); nsa_block_t<1, 40>(KTw, VTw, lane, qf, 0, khi, base, inc, m, l, O);
      MW[w * 64 + lane] = m; LW[w * 64 + lane] = l;
      __syncthreads();
      float M_ = -1e30f;
#pragma unroll
      for (int w2 = 0; w2 < 8; ++w2) M_ = fmaxf(M_, MW[w2 * 64 + lane]);
      float L_ = 0.f;
#pragma unroll
      for (int w2 = 0; w2 < 8; ++w2) L_ += (LW[w2 * 64 + lane] + LW[w2 * 64 + (lane ^ 32)]) * ex2(MW[w2 * 64 + lane] - M_);
      const float invl = 1.f / fmaxf(L_, 1e-30f);
      f16v s[1]; nsa_scores_t<1>(KTw, lane, qf, 0, khi, base, inc, s);
#pragma unroll
      for (int a = 0; a < 4; ++a) { float p[4];
#pragma unroll
          for (int jj = 0; jj < 4; ++jj) { float x = ex2(s[0][4 * a + jj] - M_) * invl; x += __shfl_xor(x, 1); x += __shfl_xor(x, 2); x += __shfl_xor(x, 4); p[jj] = x; }
          if (g == 0) { const int grp = 8 * w + 2 * a + hi; GS[tl * 128 + grp] = ((p[0] + p[1]) + p[2]) + p[3]; LS[tl * 128 + grp] = p[3]; } }
      __syncthreads();
      NS_MERGE(0); }
    if (w == 0) {
        unsigned long long uni = 0ull;
#pragma unroll 1
        for (int t4 = 0; t4 < 4; ++t4) { const int blk = lane; const bool valid = blk < NSS, fz = blk == 0 || blk == NSS - 1 || blk == NSS - 2; const bool cand = valid && !fz, forced = valid && fz;
            const float scv = valid ? GS[t4 * 128 + blk] + (blk > 0 ? LS[t4 * 128 + blk - 1] : 0.f) : 0.f; const unsigned u = cand ? __float_as_uint(scv) : 0u;
            const int need = SLCT - 3; unsigned T = 0u;
            for (int bit = 30; bit >= 0; --bit) { const unsigned c = T | (1u << bit); if (__popcll(__ballot(cand && u >= c)) >= need) T = c; }
            const bool gt = cand && u > T, eq = cand && u == T; const int rem = need - __popcll(__ballot(gt)); const unsigned long long be = __ballot(eq), lt = (1ull << lane) - 1ull;
            const bool sel = forced || gt || (eq && __popcll(be & lt) < rem); const unsigned long long bs = __ballot(sel);
            if (lane == 0) { SEL[t4 * 2] = (unsigned)bs; SEL[t4 * 2 + 1] = (unsigned)(bs >> 32); } uni |= bs; }
        const bool on = (uni >> lane) & 1ull; const int pos = __popcll(uni & ((1ull << lane) - 1ull)); if (on) LIST[pos] = lane; if (lane == 0) CNT[0] = __popcll(uni);
    }
    __syncthreads();
    { const int cnt = CNT[0]; const unsigned long long mysel = (unsigned long long)SEL[tl * 2] | ((unsigned long long)SEL[tl * 2 + 1] << 32);
      NS_INIT();
#pragma unroll 1
      for (int j = 0; 4 * j < cnt; ++j) { ns_stage(C, A, 1, j, b, n); __syncthreads();
          const int e = 4 * j + (w >> 1), sub = w & 1; int khi = -1, blk = 0;
          if (e < cnt) { blk = LIST[e]; if ((mysel >> blk) & 1ull) khi = blk < 32 ? 31 : (sub == 0 ? (tl < DS - 1 ? tl : DS - 1) : -1); }
          nsa_block_t<1, 40>(KTw, VTw, lane, qf, 0, khi, -slope2 * (float)(qpos - 64 * blk - 32 * sub), slope2, m, l, O);
          __syncthreads(); }
      NS_MERGE(1); }
    { NS_INIT();
#pragma unroll 1
      for (int j = 0; j < 3; ++j) { ns_stage(C, A, 2, j, b, n); __syncthreads();
          const int w0 = 256 * j + 32 * w; int klo = tl + 1 - w0; if (klo < 0) klo = 0; int khi = 512 + tl - w0; if (khi > 31) khi = 31;
          nsa_block_t<1, 40>(KTw, VTw, lane, qf, klo, khi, -slope2 * (float)(qpos - (PASTL - 512) - w0), slope2, m, l, O);
          __syncthreads(); }
      NS_MERGE(2); }
    { u2 wv; wv.x = cvtpk(acc4[0], acc4[1]); wv.y = cvtpk(acc4[2], acc4[3]); *(u2*)(A.ONSA + (size_t)mrow * 1024 + head * 64 + 32 * (w >> 2) + 8 * (w & 3) + 4 * hi) = wv; }
#undef NS_INIT
#undef NS_MERGE
}

__device__ __forceinline__ void cmp_convert_cache(const Ctx& C, const float* cache, const int* pt, bf16* CA) {
    const size_t NIT = (size_t)DB * 2048 * 32, stride = (size_t)C.G * NTHR;
    for (size_t i0 = (size_t)C.bid * NTHR + C.tid; i0 < NIT; i0 += 4 * stride) {
        f4 a[4], c[4]; size_t dsto[4]; bool ok[4];
#pragma unroll
        for (int k = 0; k < 4; ++k) { const size_t i = i0 + k * stride; ok[k] = i < NIT; const size_t ii = ok[k] ? i : 0;
            const int d8 = (int)(ii & 7), n = (int)(ii >> 3) & 1, type = (int)(ii >> 4) & 1; const size_t bp = ii >> 5; const int pos = (int)(bp & 2047), b = (int)(bp >> 11);
            const float* src = cache + ((size_t)(pt[b * 16 + (pos >> 7)] * 128 + (pos & 127)) * 4 + type) * 128 + n * 64 + 8 * d8;
            a[k] = *(const f4*)src; c[k] = *(const f4*)(src + 4); dsto[k] = ((size_t)((type * 128 + b) * 2 + n) * 2048 + pos) * 64 + 8 * d8; }
#pragma unroll
        for (int k = 0; k < 4; ++k) if (ok[k]) { v4u o; o.x = pk2(a[k].x, a[k].y); o.y = pk2(a[k].z, a[k].w); o.z = pk2(c[k].x, c[k].y); o.w = pk2(c[k].z, c[k].w); *(v4u*)(CA + dsto[k]) = o; }
    }
}
__device__ __forceinline__ void cmp_stage2(int widx, int nw, int lane, const bf16* HID, const bf16* W2T, float* KCS_, float* VCS_, bf16* KC16_, bf16* VC16_) {
    const int fr = lane & 15, kg = lane >> 4;
    for (int it = widx; it < CMP_ROWS / 16; it += nw) { const int r0 = 16 * it; const bool smp = r0 < CMP_ROWS_S;
        const int type = smp ? (r0 >= CMP_ROWS_S / 2) : ((r0 - CMP_ROWS_S) >= CMP_ROWS_P / 2);
        pg8::f32x4 acc[4];
#pragma unroll
        for (int nt = 0; nt < 4; ++nt) acc[nt] = (pg8::f32x4){0.f, 0.f, 0.f, 0.f};
#pragma unroll
        for (int ks = 0; ks < 8; ++ks) { const bfx8 a = *(const bfx8*)(HID + (size_t)(r0 + fr) * 256 + 32 * ks + 8 * kg);
#pragma unroll
            for (int nt = 0; nt < 4; ++nt) { const bfx8 b = *(const bfx8*)(W2T + ((size_t)type * 64 + 16 * nt + fr) * 256 + 32 * ks + 8 * kg); acc[nt] = __builtin_amdgcn_mfma_f32_16x16x32_bf16(a, b, acc[nt], 0, 0, 0); } }
#pragma unroll
        for (int rr = 0; rr < 4; ++rr) { const int r = r0 + 4 * kg + rr;
            if (smp) { const int c = r & 127, bn = (r >> 7) & 255; if (c < NCS) { float* dst = (type ? VCS_ : KCS_) + ((size_t)bn * NCS + c) * 64;
#pragma unroll
                    for (int nt = 0; nt < 4; ++nt) dst[16 * nt + fr] = acc[nt][rr]; } }
            else { const int rp = r - CMP_ROWS_S, c = rp & 511, n = (rp >> 9) & 1; if (c < NCP) { bf16* dst = (type ? VC16_ : KC16_) + ((size_t)n * 512 + c) * 64;
#pragma unroll
                    for (int nt = 0; nt < 4; ++nt) dst[16 * nt + fr] = (bf16)f2bf(acc[nt][rr]); } } }
    }
}

__device__ __forceinline__ float sgm(float x) { return __builtin_amdgcn_rcpf(1.f + __expf(-x)); }
__device__ __forceinline__ void mix_sample_row(const bf16* ga, const bf16* gb, const float* slab, bf16* mix, int lane) {
#pragma unroll 2
    for (int j = 0; j < 8; ++j) { const int idx = lane + 64 * j; f4 pacc = ((const f4*)slab)[idx], qacc = ((const f4*)slab)[idx + 4 * (SLABSZ / 4)];
#pragma unroll
        for (int k = 1; k < 4; ++k) { pacc += ((const f4*)slab)[idx + (size_t)k * (SLABSZ / 4)]; qacc += ((const f4*)slab)[idx + (size_t)(4 + k) * (SLABSZ / 4)]; }
        const f4 a = ld4bf(ga + 4 * idx), b = ld4bf(gb + 4 * idx);
        const f4 r = (f4){sgm(a.x) * pacc.x + sgm(b.x) * qacc.x, sgm(a.y) * pacc.y + sgm(b.y) * qacc.y, sgm(a.z) * pacc.z + sgm(b.z) * qacc.z, sgm(a.w) * pacc.w + sgm(b.w) * qacc.w};
        ((unsigned long long*)mix)[idx] = (unsigned long long)pk2(r.x, r.y) | ((unsigned long long)pk2(r.z, r.w) << 32); }
}

__device__ __forceinline__ void win_copy(const float* cache_win, float* wins, size_t tix, size_t nthr) {
    const size_t NF = (size_t)DB * 508 * 64;
    for (size_t i0 = tix; i0 < NF; i0 += 4 * nthr) { f4 v[4];
#pragma unroll
        for (int k = 0; k < 4; ++k) { const size_t i = i0 + k * nthr; if (i < NF) { const size_t b = i / (508 * 64), r = i % (508 * 64); v[k] = ((const f4*)cache_win)[b * 512 * 64 + 4 * 64 + r]; } }
#pragma unroll
        for (int k = 0; k < 4; ++k) { const size_t i = i0 + k * nthr; if (i < NF) { const size_t b = i / (508 * 64), r = i % (508 * 64); ((f4*)wins)[b * 512 * 64 + r] = v[k]; } } }
}
constexpr int NPHASE = 15;
#if PROBE_MASK
#define PSUB(id, ...) do { __syncthreads(); const unsigned long long ts_ = __builtin_amdgcn_s_memrealtime(); __VA_ARGS__ __syncthreads(); if (PROBE_SUB == (id)) pr_acc += __builtin_amdgcn_s_memrealtime() - ts_; } while (0)
#else
#define PSUB(id, ...) do { __VA_ARGS__ } while (0)
#endif
struct Args { const void* in[30]; float* out; unsigned char* ws; int ph_lo, ph_hi; };
__global__ void __launch_bounds__(NTHR, 2) mk_fwd(Args args) {
    extern __shared__ __attribute__((aligned(16))) unsigned char lds_raw[];
#define MKCTX() Ctx C; C.lds = (LAS unsigned char*)lds_raw; C.tid = threadIdx.x; asm volatile("" : "+v"(C.tid)); C.lane = C.tid & 63; C.wave = __builtin_amdgcn_readfirstlane(C.tid >> 6); \
    C.G = gridDim.x; C.bid = blockIdx.x; C.gw = C.bid * NWAVES + C.wave; C.NGW = C.G * NWAVES;
    LAS unsigned char* const lds0 = (LAS unsigned char*)lds_raw;
    unsigned char* ws = args.ws; float* out = args.out;
    gu32* ctl = (gu32*)(ws + WS_CTL);
    volatile LAS unsigned* MISC = (volatile LAS unsigned*)(lds0 + MISC_OFF);
    for (int u = threadIdx.x; u < (LDS_BYTES - LDSCTL_OFF) / 4; u += NTHR) ((LAS unsigned*)(lds0 + LDSCTL_OFF))[u] = 0u;
    __syncthreads();
    const int lo = args.ph_lo, hi = args.ph_hi;
    XcdBarrier bar; bar.bar = (unsigned*)(ctl + CW_BAR); bar.x = 0; bar.st = nullptr;
    if (hi - lo > 1) bar = xcd_barrier_post((unsigned*)(ctl + CW_BAR), MISC + 8);
#define IN(k) (lo <= (k) && (k) < hi)
#if PROBE_MASK
    unsigned long long pr_t = __builtin_amdgcn_s_memrealtime(), pr_acc = 0ull;
#define SEAM(k) do { if (IN(k) && IN((k) + 1)) xcd_barrier(bar); { const unsigned long long t_ = __builtin_amdgcn_s_memrealtime(); if ((PROBE_MASK >> (k)) & 1) pr_acc += t_ - pr_t; pr_t = t_; } } while (0)
#else
#define SEAM(k) do { if (IN(k) && IN((k) + 1)) xcd_barrier(bar); } while (0)
#endif
#define x_p ((const float*)args.in[0])
#define x_s ((const float*)args.in[1])
#define cache_kv ((const float*)args.in[2])
#define cache_win ((const float*)args.in[3])
#define state_hgrn ((const float*)args.in[4])
#define page_table ((const int*)args.in[5])
#define n_pre1 ((const float*)args.in[6])
#define n_post1 ((const float*)args.in[7])
#define n_pre2 ((const float*)args.in[11])
#define n_post2 ((const float*)args.in[12])
#define n_pre3 ((const float*)args.in[25])
#define n_post3 ((const float*)args.in[26])
#define hg_lb ((const float*)args.in[14])
#define hg_gnorm ((const float*)args.in[15])
#define W1GU ((bf16*)(ws + WS_W1GU))
#define W1D ((bf16*)(ws + WS_W1D))
#define W2GU ((bf16*)(ws + WS_W2GU))
#define W2D ((bf16*)(ws + WS_W2D))
#define WINt ((bf16*)(ws + WS_WIN))
#define WPH ((bf16*)(ws + WS_WPH))
#define WPN ((bf16*)(ws + WS_WPN))
#define WOt ((bf16*)(ws + WS_WO))
#define XN ((bf16*)(ws + WS_XN))
#define HB ((bf16*)(ws + WS_HB))
#define Y ((bf16*)(ws + WS_Y))
#define X1 ((float*)(ws + WS_X1))
#define X2 ((float*)(ws + WS_X2))
#define QH ((float*)(ws + WS_QH))
#define LOGF ((float*)(ws + WS_LOGF))
#define KH ((float*)(ws + WS_KH))
#define VH ((float*)(ws + WS_VH))
#define GH ((float*)(ws + WS_GH))
#define QN ((float*)(ws + WS_QN))
#define WINF ((float*)(ws + WS_WINF))
#define NG ((float*)(ws + WS_NG))
#define GA ((bf16*)(ws + WS_GA))
#define GB ((bf16*)(ws + WS_GB))
#define KCP ((float*)(ws + WS_KCP))
#define VCP ((float*)(ws + WS_VCP))
#define KCS ((float*)(ws + WS_KCS))
#define VCS ((float*)(ws + WS_VCS))
#define CB ((float*)(ws + WS_CB))
#define OHR ((float*)(ws + WS_OHR))
#define OHG ((bf16*)(ws + WS_OHG))
#define ONSA ((bf16*)(ws + WS_ONSA))
#define T1 ((bf16*)(ws + WS_T1))
#define MIX ((bf16*)(ws + WS_MIX))
#define UT ((float*)(ws + WS_UT))
#define DD ((float*)(ws + WS_DD))
#define SP ((bf16*)(ws + WS_SP))
#define CA ((bf16*)(ws + WS_CA))
#define HID ((bf16*)(ws + WS_HID))
#define W1C ((bf16*)(ws + WS_W1C))
#define W2C ((bf16*)(ws + WS_W2C))
#define SLAB ((float*)(ws + WS_SLAB))
#define RS ((float*)(ws + WS_RS))
#define QH16 ((bf16*)(ws + WS_QH16))
#define KH16 ((bf16*)(ws + WS_KH16))
#define VH16 ((bf16*)(ws + WS_VH16))
#define GH16 ((bf16*)(ws + WS_GH16))
#define QN16 ((bf16*)(ws + WS_QN16))
#define KSL ((bf16*)(ws + WS_KSL))
#define VSL ((bf16*)(ws + WS_VSL))
#define KWN ((bf16*)(ws + WS_KWN))
#define VWN ((bf16*)(ws + WS_VWN))
#define KC16 ((bf16*)(ws + WS_KC16))
#define VC16 ((bf16*)(ws + WS_VC16))
#define KVO ((float*)(out + O_KV))
#define WINP ((float*)(out + O_WINP))
#define WINS ((float*)(out + O_WINS))
#define SPLITK(Aptr, Bptr, Kfull, NS, slab0) do { const int ks_ = C.bid % (NS), su_ = C.bid / (NS); int koff_, klen_; \
        if ((Kfull) == FF) { koff_ = 128 * (ks_ < 11 ? 3 * ks_ : 33 + 2 * (ks_ - 11)); klen_ = ks_ < 11 ? 384 : 256; } else { klen_ = (Kfull) / (NS); koff_ = ks_ * klen_; } \
        pg8::Gemm g_{(Aptr) + koff_, (Bptr) + koff_, M, DM, klen_, (Kfull), (Kfull)}; pg8::OneUnit S_{su_}; pg8::EpiSlab E_{SLAB + (size_t)((slab0) + ks_) * SLABSZ}; \
        pg8::gemm_phase<pg8::EpiSlab, pg8::OneUnit, true>(C.lds + RING_OFF, g_, S_, E_); } while (0)
    if (IN(0)) { MKCTX();
        if ((C.gw & 15) == 0 && (C.gw >> 4) < 128) { const int task = C.gw >> 4, type = task >> 6, j4 = task & 63;   const float* pos = (const float*)args.in[type ? 19 : 16]; const float* w1 = (const float*)args.in[type ? 20 : 17];
            f4 s = (f4){0.f, 0.f, 0.f, 0.f};
#pragma unroll 8
            for (int k = 0; k < 32; ++k) { const int i = C.lane + 64 * k; s += *(const f4*)(w1 + (size_t)i * 256 + 4 * j4) * pos[i]; }
            s.x = wsum(s.x); s.y = wsum(s.y); s.z = wsum(s.z); s.w = wsum(s.w);
            if (C.lane == 0) *(f4*)(CB + type * 256 + 4 * j4) = s; }
        PSUB(11, tr_run(args.in, ws, (LAS unsigned*)(C.lds + C.wave * 16384), 0, 7, C.gw, C.NGW, C.lane); );
        for (int i = C.bid * NTHR + C.tid; i < (DINP - DIN) * DM / 8; i += C.G * NTHR) ((v4u*)(WINt + (size_t)DIN * DM))[i] = (v4u){0u, 0u, 0u, 0u};
        PSUB(12, cmp_convert_cache(C, cache_kv, page_table, CA); );
        PSUB(13, for (int m = C.gw; m < M; m += C.NGW) rms_row_to_bf16(m < TP ? x_p + (size_t)m * DM : x_s + (size_t)(m - TP) * DM, n_pre1, XN + (size_t)m * DM, C.lane); );
    }
    SEAM(0);
    if (IN(1)) { MKCTX(); pg8::Gemm g{XN, W1GU, M, 2 * FF, DM, DM, DM}; pg8::StaticOrder S; S.init(M, 2 * FF, C.G, C.bid); pg8::EpiSwiglu E{HB, FF};
        pg8::gemm_phase<pg8::EpiSwiglu, pg8::StaticOrder, true>(C.lds + RING_OFF, g, S, E);
        { constexpr int rem = ((M / 256) * (2 * FF / 256)) % 256;
          if (C.G == 256 && C.bid >= rem) tr_run(args.in, ws, (LAS unsigned*)(C.lds + C.wave * 16384), 7, 8, (C.bid - rem) * NWAVES + C.wave, (256 - rem) * NWAVES, C.lane);
          else if (C.G != 256) tr_run(args.in, ws, (LAS unsigned*)(C.lds + C.wave * 16384), 7, 8, C.gw, C.NGW, C.lane); } }
    SEAM(1);
    if (IN(2)) { MKCTX(); pg8::SplitSched S; S.S.init(TP, DM, C.G, C.bid); S.A = (const char*)HB; S.B = (const char*)W1D; S.lda = FF; S.ldb = FF; S.K = FF; S.NS = 16; S.bid = C.bid;
        pg8::EpiDual<pg8::EpiY16> E{pg8::EpiY16{Y, DM}, SLAB}; pg8::gemm_phase_g<pg8::EpiDual<pg8::EpiY16>, pg8::SplitSched, true>(C.lds + RING_OFF, FF, FF, S, E); }
    SEAM(2);
    if (IN(3)) { MKCTX(); for (int m = C.gw; m < M; m += C.NGW) norm_mid_row(m < TP ? (const void*)(Y + (size_t)m * DM) : (const void*)(SLAB + (size_t)(m - TP) * DM), m < TP ? x_p + (size_t)m * DM : x_s + (size_t)(m - TP) * DM, nullptr, nullptr, 0.f,
            n_post1, 0.5f, nullptr, n_pre2, XN + (size_t)m * DM, RS + m, C.lane, m < TP ? 0 : 16); }
    SEAM(3);
    if (IN(4)) { MKCTX(); pg8::Gemm g{XN, WINt, M, DINP, DM, DM, DM}; pg8::StaticOrder S; S.init(M, DINP, C.G, C.bid);
        pg8::EpiInProj E{ws, out, hg_lb};
        pg8::gemm_phase<pg8::EpiInProj, pg8::StaticOrder, true>(C.lds + RING_OFF, g, S, E);
        { constexpr int rem = ((M / 256) * (DINP / 256)) % 256;
          if (C.G == 256 && C.bid >= rem) tr_run(args.in, ws, (LAS unsigned*)(C.lds + C.wave * 16384), 8, 10, (C.bid - rem) * NWAVES + C.wave, (256 - rem) * NWAVES, C.lane);
          else if (C.G != 256) tr_run(args.in, ws, (LAS unsigned*)(C.lds + C.wave * 16384), 8, 10, C.gw, C.NGW, C.lane); } }
    SEAM(4);
    if (IN(5)) { MKCTX();
        { pg8::Gemm g{CA, W1C, CMP_ROWS, 512, 2048, 1024, 2048}; pg8::CmpOrder S{C.G, C.bid}; pg8::EpiCmp E{CB, HID};
          pg8::gemm_phase<pg8::EpiCmp, pg8::CmpOrder, true>(C.lds + RING_OFF, g, S, E); }
        if (C.bid >= 8) for (int u = C.bid - 8; u < 8 * HG_NCH; u += C.G - 8) hgrn_A_unit(C, u & 7, u >> 3, LOGF, KH16, VH16, UT, DD);
    }
    SEAM(5);
    if (IN(6)) { MKCTX();
        if (C.wave < 4) { const int widx = C.bid * 4 + C.wave, nw = C.G * 4;
            cmp_stage2(widx, nw, C.lane, HID, W2C, KCS, VCS, KC16, VC16);
            for (int v = widx; v < DB * 64; v += nw) { const int b = v >> 6, h = (v >> 3) & 7, vg2 = v & 7;
                hgrn_seq_pair(TP + b * 4, h, vg2, state_hgrn + (size_t)b * 131072 + (size_t)h * 16384, out + O_HGS + (size_t)b * 131072 + (size_t)h * 16384, QH16, LOGF, KH16, VH16, OHR, C.lane); }
            hgrn_scan(C.bid * 256 + C.tid, C.G * 256, UT, DD, SP, out + O_HGP);
        } else tr_run(args.in, ws, (LAS unsigned*)(C.lds + C.wave * 16384), 10, 14, C.bid * 4 + (C.wave - 4), C.G * 4, C.lane);
    }
    SEAM(6);
    if (IN(7)) { MKCTX();
        for (int m = TP + C.gw; m < M; m += C.NGW) hgrn_finish_row(OHR + (size_t)m * 1024, GH16 + (size_t)m * 1024, hg_gnorm, OHG + (size_t)m * 1024, C.lane);
        NsaP AP{QN16, KSL, VSL, KWN, VWN, KC16, VC16, NG, ONSA};
        NsaS AS{QN16, KVO, WINF, NG, cache_kv, cache_win, page_table, KCS, VCS, ONSA};
        LAS int* qslot = (LAS int*)(C.lds + MISC_OFF + 128);
#define QUEUE_LOOP(word, count, ...) for (;;) { __syncthreads(); if (C.tid == 0) qslot[0] = (int)__hip_atomic_fetch_add(ctl + (word), 1u, __ATOMIC_RELAXED, __HIP_MEMORY_SCOPE_AGENT); __syncthreads(); \
            const int it = qslot[0]; if (it >= (count)) break; __VA_ARGS__ }
        QUEUE_LOOP(CW_Q7, 512, nsa_prompt_unit(C, AP, 255 - (it >> 1), it & 1); )
        QUEUE_LOOP(CW_Q7 + 64, 2 * DB, nsa_sample_unit(C, AS, it >> 1, it & 1); )
        QUEUE_LOOP(CW_Q7 + 128, 8 * HG_NCH, hgrn_B_unit(C, it & 7, it >> 3, QH16, LOGF, KH16, VH16, GH16, hg_gnorm, SP, OHG); )
    }
    SEAM(7);
    if (IN(8)) { MKCTX(); pg8::ProjSched S; S.S.init(TP, DM, C.G, C.bid); S.Ah = (const char*)OHG; S.An = (const char*)ONSA; S.Bh = (const char*)WPH; S.Bn = (const char*)WPN; S.bid = C.bid;
        pg8::EpiProj E{pg8::EpiGate1{GA, T1, DM}, pg8::EpiGate2{GB, T1, MIX, DM}, SLAB}; pg8::gemm_phase_g<pg8::EpiProj, pg8::ProjSched, true>(C.lds + RING_OFF, 1024, 1024, S, E); }
    SEAM(8);
    if (IN(9)) { MKCTX(); for (int m = TP + C.gw; m < M; m += C.NGW) mix_sample_row(GA + (size_t)m * DM, GB + (size_t)m * DM, SLAB + (size_t)(m - TP) * DM, MIX + (size_t)m * DM, C.lane); }
    SEAM(9);
    if (IN(10)) { MKCTX(); pg8::SplitSched S; S.S.init(TP, DM, C.G, C.bid); S.A = (const char*)MIX; S.B = (const char*)WOt; S.lda = DM; S.ldb = DM; S.K = DM; S.NS = 8; S.bid = C.bid;
        pg8::EpiDual<pg8::EpiY16> E{pg8::EpiY16{Y, DM}, SLAB}; pg8::gemm_phase_g<pg8::EpiDual<pg8::EpiY16>, pg8::SplitSched, true>(C.lds + RING_OFF, DM, DM, S, E); }
    SEAM(10);
    if (IN(11)) { MKCTX(); for (int m = C.gw; m < M; m += C.NGW) norm_mid_row(m < TP ? (const void*)(Y + (size_t)m * DM) : (const void*)(SLAB + (size_t)(m - TP) * DM), nullptr, XN + (size_t)m * DM, n_pre2, RS[m],
            n_post2, 1.0f, nullptr, n_pre3, XN + (size_t)m * DM, RS + m, C.lane, m < TP ? 0 : 8); }
    SEAM(11);
    if (IN(12)) { MKCTX(); pg8::Gemm g{XN, W2GU, M, 2 * FF, DM, DM, DM}; pg8::StaticOrder S; S.init(M, 2 * FF, C.G, C.bid); pg8::EpiSwiglu E{HB, FF};
        pg8::gemm_phase<pg8::EpiSwiglu, pg8::StaticOrder, true>(C.lds + RING_OFF, g, S, E);
        { constexpr int rem = ((M / 256) * (2 * FF / 256)) % 256;
          if (C.G == 256 && C.bid >= rem) win_copy(cache_win, WINS, (size_t)(C.bid - rem) * NTHR + C.tid, (size_t)(256 - rem) * NTHR);
          else if (C.G != 256) win_copy(cache_win, WINS, (size_t)C.bid * NTHR + C.tid, (size_t)C.G * NTHR); } }
    SEAM(12);
    if (IN(13)) { MKCTX(); pg8::SplitSched S; S.S.init(TP, DM, C.G, C.bid); S.A = (const char*)HB; S.B = (const char*)W2D; S.lda = FF; S.ldb = FF; S.K = FF; S.NS = 16; S.bid = C.bid;
        pg8::EpiDual<pg8::EpiY16> E{pg8::EpiY16{Y, DM}, SLAB}; pg8::gemm_phase_g<pg8::EpiDual<pg8::EpiY16>, pg8::SplitSched, true>(C.lds + RING_OFF, FF, FF, S, E); }
    SEAM(13);
    if (IN(14)) { MKCTX(); for (int m = C.gw; m < M; m += C.NGW) norm_mid_row(m < TP ? (const void*)(Y + (size_t)m * DM) : (const void*)(SLAB + (size_t)(m - TP) * DM), nullptr, XN + (size_t)m * DM, n_pre3, RS[m],
            n_post3, 0.5f, out + O_Y + (size_t)m * DM, nullptr, nullptr, nullptr, C.lane, m < TP ? 0 : 16); }
#if PROBE_MASK
    { const unsigned long long t_ = __builtin_amdgcn_s_memrealtime(); if ((PROBE_MASK >> 14) & 1) pr_acc += t_ - pr_t;
      if (PROBE_SUB >= 32) pr_acc += ((volatile LAS unsigned long long*)(lds0 + MISC_OFF + 256))[PROBE_SUB - 32];
      if (blockIdx.x == 0) { const unsigned long long t0_ = __builtin_amdgcn_s_memrealtime(); while (__builtin_amdgcn_s_memrealtime() - t0_ < PROBE_K * pr_acc) __builtin_amdgcn_s_sleep(8); } }
#endif
#undef IN
#undef SEAM
#undef MKCTX
#undef QUEUE_LOOP
#undef x_p
#undef x_s
#undef cache_kv
#undef cache_win
#undef state_hgrn
#undef page_table
#undef n_pre1
#undef n_post1
#undef n_pre2
#undef n_post2
#undef n_pre3
#undef n_post3
#undef hg_lb
#undef hg_gnorm
#undef W1GU
#undef W1D
#undef W2GU
#undef W2D
#undef WINt
#undef WPH
#undef WPN
#undef WOt
#undef XN
#undef HB
#undef Y
#undef X1
#undef X2
#undef QH
#undef LOGF
#undef KH
#undef VH
#undef GH
#undef QN
#undef WINF
#undef NG
#undef GA
#undef GB
#undef KCP
#undef VCP
#undef KCS
#undef VCS
#undef CB
#undef OHR
#undef OHG
#undef ONSA
#undef T1
#undef MIX
#undef UT
#undef DD
#undef SP
#undef CA
#undef HID
#undef W1C
#undef W2C
#undef SLAB
#undef RS
#undef QH16
#undef KH16
#undef VH16
#undef GH16
#undef QN16
#undef KSL
#undef VSL
#undef KWN
#undef VWN
#undef KC16
#undef VC16
#undef KVO
#undef WINP
#undef WINS
}

#ifndef MK_ONE_LAUNCH
#define MK_ONE_LAUNCH 1
#endif
extern "C" void kernel_launch(void* const* d_in, const int* in_sizes, int n_in, void* d_out, int out_size, void* d_ws, size_t ws_size, hipStream_t stream) {
    static int grid = 0;
    if (grid == 0) {
        if (n_in != 30 || out_size != (int)O_END || ws_size < WS_END) { fprintf(stderr, "kernel_launch: unexpected sizes (n_in %d out %d ws %zu)\n", n_in, out_size, ws_size); grid = -1; return; }
        int dev = 0, cus = 0, per_cu = 0;
        if (hipGetDevice(&dev) != hipSuccess || hipDeviceGetAttribute(&cus, hipDeviceAttributeMultiprocessorCount, dev) != hipSuccess) { grid = -1; return; }
        if (hipFuncSetAttribute((const void*)mk_fwd, hipFuncAttributeMaxDynamicSharedMemorySize, LDS_BYTES) != hipSuccess) { fprintf(stderr, "kernel_launch: hipFuncSetAttribute failed\n"); grid = -1; return; }
        if (hipOccupancyMaxActiveBlocksPerMultiprocessor(&per_cu, (const void*)mk_fwd, NTHR, LDS_BYTES) != hipSuccess || per_cu < 1) { fprintf(stderr, "kernel_launch: occupancy query says %d\n", per_cu); }
        (void)hipGetLastError();
        grid = cus;
    }
    if (grid < 0) return;
    (void)hipMemsetAsync((char*)d_ws + WS_CTL, 0, CTL_ZERO_BYTES, stream);
    Args a{};
    for (int i = 0; i < 30; ++i) a.in[i] = d_in[i];
    a.out = (float*)d_out; a.ws = (unsigned char*)d_ws;
#if MK_ONE_LAUNCH
    a.ph_lo = 0; a.ph_hi = NPHASE;
    hipLaunchKernelGGL(mk_fwd, dim3(grid), dim3(NTHR), LDS_BYTES, stream, a);
#else
    for (int p = 0; p < NPHASE; ++p) { a.ph_lo = p; a.ph_hi = p + 1; hipLaunchKernelGGL(mk_fwd, dim3(grid), dim3(NTHR), LDS_BYTES, stream, a); }
#endif
}
```

```cpp
#include <hip/hip_runtime.h>
#include <cstdio>
#include <cstdint>
#ifndef PROBE_MASK
#define PROBE_MASK 0
#endif
#ifndef PROBE_K
#define PROBE_K 1
#endif
#ifndef PROBE_SUB
#define PROBE_SUB 0
#endif
#if PROBE_MASK
#define STAMP(C, id) do { __syncthreads(); if ((C).tid == 0) { volatile __attribute__((address_space(3))) unsigned long long* P_ = (volatile __attribute__((address_space(3))) unsigned long long*)((C).lds + 131072 + 320 + 256); \
    const unsigned long long t_ = __builtin_amdgcn_s_memrealtime(); P_[id] += t_ - P_[0]; P_[0] = t_; } } while (0)
#else
#define STAMP(C, id) do {} while (0)
#endif
namespace pg8 {
#define PG8_LAS __attribute__((address_space(3)))
typedef unsigned short bf16_t;
typedef short bf16x8 __attribute__((ext_vector_type(8)));
typedef float f32x4 __attribute__((ext_vector_type(4)));
typedef unsigned u32x4 __attribute__((ext_vector_type(4)));
constexpr int BM = 256, BK = 64, HALF = 128, HTB = HALF * BK * 2  , STAGE_BYTES = 8 * HTB, NXCD = 8, WGM = 8;

__host__ __device__ __forceinline__ int lds_byte(int r, int c) { const int st = (r >> 4) * 2 + (c >> 5), rr = r & 15, cc = c & 31, ob = rr * 64 + cc * 2; return st * 1024 + (ob ^ (((ob >> 9) & 1) << 5)); }
__host__ __device__ __forceinline__ void stage_rc(int b, int& R, int& C) { const int st = b / 1024, sb = b % 1024, swz = sb ^ (((sb >> 9) & 1) << 5); R = (st >> 1) * 16 + swz / 64; C = (st & 1) * 32 + (swz % 64) / 2; }
__host__ __device__ __forceinline__ int perm32(int rho) { const int n = rho >> 4, i = rho & 15; return 8 * (i >> 2) + 4 * n + (i & 3); }

struct Unit { int pm, pn; };
struct Gemm { const bf16_t* A; const bf16_t* Bt; int M, N, K, lda, ldb; };

struct StaticOrder {
    int nM, nN, nwg, G, c;
    __host__ __device__ void init(int M, int N, int G_, int c_) { nM = M / BM; nN = N / BM; nwg = nM * nN; G = G_; c = c_; }
    __host__ __device__ bool next(int i, Unit& u) const {
        const long L = (long)i * G + c; if (L >= nwg) return false;
        int wgid = (int)L; { const int q = nwg / NXCD, r = nwg % NXCD, xcd = wgid % NXCD, off = wgid / NXCD; wgid = (xcd < r ? xcd * (q + 1) : r * (q + 1) + (xcd - r) * q) + off; }
        const int nig = WGM * nN, gid = wgid / nig, fm = gid * WGM, gsz = (nM - fm) < WGM ? (nM - fm) : WGM;
        u.pm = fm + ((wgid % nig) % gsz); u.pn = (wgid % nig) / gsz; return true;
    }
    __device__ __forceinline__ void a_ready(const Unit&) const {}
    __device__ __forceinline__ void done(const Unit&) const {}
};

typedef float cvt_f32x2 __attribute__((ext_vector_type(2))); typedef __bf16 cvt_bf16x2 __attribute__((ext_vector_type(2)));
__device__ __forceinline__ unsigned cvt_pk_bf16(float lo, float hi) { const cvt_f32x2 v = {lo, hi}; const cvt_bf16x2 b = __builtin_convertvector(v, cvt_bf16x2); return __builtin_bit_cast(unsigned, b); }
typedef float f32x2 __attribute__((ext_vector_type(2)));
template <class Epi, class Sched, bool ALIGN_EPI = false>
__device__ __forceinline__ void gemm_phase(PG8_LAS unsigned char* lds, const Gemm g, const Sched& S, const Epi& E) {
    int tid = threadIdx.x; asm volatile("" : "+v"(tid));
    const int wid = __builtin_amdgcn_readfirstlane(tid >> 6), lane = tid & 63, wr = wid >> 2, wc = wid & 3, fr = lane & 15, fq = lane >> 4;
    const int K = g.K, nt = K / BK;
    unsigned voffA, voffB;
    { int R, C; stage_rc(tid * 16, R, C); const int Rb = Epi::PERM ? ((R & ~31) + perm32(R & 31)) : R; voffA = (unsigned)(R * g.lda + C) * 2u; voffB = (unsigned)(Rb * g.ldb + C) * 2u; }
    const size_t r64A = (size_t)64 * g.lda * 2, r64B = (size_t)64 * g.ldb * 2;
    const size_t kstep = (size_t)(BK * 2);
    const size_t hstepA = (size_t)HALF * g.lda * 2, hstepB = (size_t)HALF * g.ldb * 2;
    const size_t tstepA = 2 * hstepA, tstepB = 2 * hstepB;
    const unsigned ldsw = (unsigned)wid * 1024u;
    const int aoff = lds_byte(wr * 64 + fr, fq * 8), boff = lds_byte(wc * 32 + fr, fq * 8);
#define PG8_SA(b, h) (((b) * 2 + (h)) * HTB)
#define PG8_SB(b, h) ((4 + (b) * 2 + (h)) * HTB)
#define PG8_STAGE(bufoff, gbase, sfx) do { _Pragma("unroll") for (int _i = 0; _i < 2; ++_i) \
        __builtin_amdgcn_global_load_lds((const unsigned*)((const char*)(gbase) + (size_t)_i * r64##sfx + voff##sfx), (PG8_LAS unsigned*)(lds + (bufoff) + ldsw + _i * 8192), 16, 0, 0); } while (0)
#define PG8_LDA(dst, b, h) do { _Pragma("unroll") for (int m = 0; m < 4; ++m) _Pragma("unroll") for (int k = 0; k < 2; ++k) dst[m][k] = *(const PG8_LAS bf16x8*)(lds + PG8_SA(b, h) + aoff + m * 2048 + k * 1024); } while (0)
#define PG8_LDB(dst, b, h) do { _Pragma("unroll") for (int n = 0; n < 2; ++n) _Pragma("unroll") for (int k = 0; k < 2; ++k) dst[n][k] = *(const PG8_LAS bf16x8*)(lds + PG8_SB(b, h) + boff + n * 2048 + k * 1024); } while (0)
#define PG8_MMA(ai, bj, At, Bt) do { __builtin_amdgcn_s_setprio(1); _Pragma("unroll") for (int m = 0; m < 4; ++m) _Pragma("unroll") for (int n = 0; n < 2; ++n) _Pragma("unroll") for (int k = 0; k < 2; ++k) \
        acc[ai][bj][m][n] = __builtin_amdgcn_mfma_f32_16x16x32_bf16(Bt[n][k], At[m][k], acc[ai][bj][m][n], 0, 0, 0); __builtin_amdgcn_s_setprio(0); } while (0)
#define PG8_WAIT_V(n) asm volatile("s_waitcnt vmcnt(" #n ")" ::: "memory")
#define PG8_WAIT_L(n) asm volatile("s_waitcnt lgkmcnt(" #n ")" ::: "memory")
#define PG8_BAR __builtin_amdgcn_s_barrier()
#define PG8_SCHED __builtin_amdgcn_sched_barrier(0)
    Unit cur, nxt; int ui = 0;
    if (!S.next(0, cur)) return;
    f32x4 acc[2][2][4][2];
#pragma unroll
    for (int a = 0; a < 2; ++a)
#pragma unroll
        for (int b = 0; b < 2; ++b)
#pragma unroll
            for (int m = 0; m < 4; ++m)
#pragma unroll
                for (int n = 0; n < 2; ++n) acc[a][b][m][n] = (f32x4){0.f, 0.f, 0.f, 0.f};
    bf16x8 At[4][2], B0[2][2], B1[2][2];
    const char* cA = (const char*)g.A + (size_t)cur.pm * tstepA; const char* cB = (const char*)g.Bt + (size_t)cur.pn * tstepB;
    S.a_ready(cur);
    PG8_STAGE(PG8_SB(0, 0), cB, B); PG8_STAGE(PG8_SB(0, 1), cB + hstepB, B); PG8_STAGE(PG8_SA(0, 0), cA, A); PG8_STAGE(PG8_SA(0, 1), cA + hstepA, A);
    if (wr == 1) PG8_BAR;
    PG8_WAIT_V(2); PG8_BAR;
    PG8_STAGE(PG8_SB(1, 0), cB + kstep, B); PG8_STAGE(PG8_SA(1, 0), cA + kstep, A); PG8_STAGE(PG8_SB(1, 1), cB + hstepB + kstep, B);
    PG8_WAIT_V(6); PG8_BAR;
    for (;;) {
        const bool has_next = S.next(ui + 1, nxt);
        const char* nA = has_next ? (const char*)g.A + (size_t)nxt.pm * tstepA : cA; const char* nB = has_next ? (const char*)g.Bt + (size_t)nxt.pn * tstepB : cB;
        for (int t = 0; t < nt; t += 2) {
            const bool last = (t == nt - 2);
            const char* a1 = cA + (size_t)(t + 1) * kstep;
            const char* a2 = last ? nA : cA + (size_t)(t + 2) * kstep; const char* b2 = last ? nB : cB + (size_t)(t + 2) * kstep;
            const char* a3 = a2 + kstep; const char* b3 = b2 + kstep;
            if (last && has_next) S.a_ready(nxt);
            PG8_LDB(B0, 0, 0); PG8_LDB(B1, 0, 1); PG8_SCHED; PG8_LDA(At, 0, 0); PG8_STAGE(PG8_SA(1, 1), a1 + hstepA, A);
            PG8_WAIT_V(8); PG8_WAIT_L(0); PG8_BAR; PG8_MMA(0, 0, At, B0); PG8_MMA(0, 1, At, B1); PG8_BAR; PG8_SCHED;
            PG8_LDA(At, 0, 1); PG8_STAGE(PG8_SB(0, 0), b2, B); PG8_STAGE(PG8_SB(0, 1), b2 + hstepB, B); PG8_STAGE(PG8_SA(0, 0), a2, A);
            PG8_WAIT_V(8); PG8_WAIT_L(0); PG8_BAR; PG8_MMA(1, 0, At, B0); PG8_MMA(1, 1, At, B1); PG8_BAR; PG8_SCHED;
            PG8_LDB(B0, 1, 0); PG8_LDB(B1, 1, 1); PG8_SCHED; PG8_LDA(At, 1, 0); PG8_STAGE(PG8_SA(0, 1), a2 + hstepA, A);
            PG8_WAIT_V(8); PG8_WAIT_L(0); PG8_BAR; PG8_MMA(0, 0, At, B0); PG8_MMA(0, 1, At, B1); PG8_BAR; PG8_SCHED;
            PG8_LDA(At, 1, 1); PG8_STAGE(PG8_SB(1, 0), b3, B); PG8_STAGE(PG8_SB(1, 1), b3 + hstepB, B); PG8_STAGE(PG8_SA(1, 0), a3, A);
            PG8_WAIT_V(8); PG8_WAIT_L(0); PG8_BAR; PG8_MMA(1, 0, At, B0); PG8_MMA(1, 1, At, B1); PG8_BAR; PG8_SCHED;
        }
        if constexpr (ALIGN_EPI) { if (wr == 0) PG8_BAR; }
        E(acc, cur, wr, wc, fr, fq); S.done(cur);
        if (!has_next) break;
#pragma unroll
        for (int a = 0; a < 2; ++a)
#pragma unroll
            for (int b = 0; b < 2; ++b)
#pragma unroll
                for (int m = 0; m < 4; ++m)
#pragma unroll
                    for (int n = 0; n < 2; ++n) acc[a][b][m][n] = (f32x4){0.f, 0.f, 0.f, 0.f};
        cur = nxt; cA = nA; cB = nB; ++ui;
        if constexpr (ALIGN_EPI) { if (wr == 1) PG8_BAR; }
    }
    PG8_WAIT_V(0);
    if constexpr (!ALIGN_EPI) { if (wr == 0) PG8_BAR; }
    PG8_BAR;
#undef PG8_SA
#undef PG8_SB
#undef PG8_STAGE
#undef PG8_LDA
#undef PG8_LDB
#undef PG8_MMA
#undef PG8_WAIT_V
#undef PG8_WAIT_L
#undef PG8_BAR
#undef PG8_SCHED
}

struct UnitG : Unit { const char* A; const char* B; int nt, kind, aux; };
template <class Epi, class Sched, bool ALIGN_EPI = false>
__device__ __forceinline__ void gemm_phase_g(PG8_LAS unsigned char* lds, int lda, int ldb, const Sched& S, const Epi& E) {
    int tid = threadIdx.x; asm volatile("" : "+v"(tid));
    const int wid = __builtin_amdgcn_readfirstlane(tid >> 6), lane = tid & 63, wr = wid >> 2, wc = wid & 3, fr = lane & 15, fq = lane >> 4;
    unsigned voffA, voffB;
    { int R, C; stage_rc(tid * 16, R, C); const int Rb = Epi::PERM ? ((R & ~31) + perm32(R & 31)) : R; voffA = (unsigned)(R * lda + C) * 2u; voffB = (unsigned)(Rb * ldb + C) * 2u; }
    const size_t r64A = (size_t)64 * lda * 2, r64B = (size_t)64 * ldb * 2;
    const size_t kstep = (size_t)(BK * 2);
    const size_t hstepA = (size_t)HALF * lda * 2, hstepB = (size_t)HALF * ldb * 2;
    const size_t tstepA = 2 * hstepA, tstepB = 2 * hstepB;
    const unsigned ldsw = (unsigned)wid * 1024u;
    const int aoff = lds_byte(wr * 64 + fr, fq * 8), boff = lds_byte(wc * 32 + fr, fq * 8);
#define PG8_SA(b, h) (((b) * 2 + (h)) * HTB)
#define PG8_SB(b, h) ((4 + (b) * 2 + (h)) * HTB)
#define PG8_STAGE(bufoff, gbase, sfx) do { _Pragma("unroll") for (int _i = 0; _i < 2; ++_i) \
        __builtin_amdgcn_global_load_lds((const unsigned*)((const char*)(gbase) + (size_t)_i * r64##sfx + voff##sfx), (PG8_LAS unsigned*)(lds + (bufoff) + ldsw + _i * 8192), 16, 0, 0); } while (0)
#define PG8_LDA(dst, b, h) do { _Pragma("unroll") for (int m = 0; m < 4; ++m) _Pragma("unroll") for (int k = 0; k < 2; ++k) dst[m][k] = *(const PG8_LAS bf16x8*)(lds + PG8_SA(b, h) + aoff + m * 2048 + k * 1024); } while (0)
#define PG8_LDB(dst, b, h) do { _Pragma("unroll") for (int n = 0; n < 2; ++n) _Pragma("unroll") for (int k = 0; k < 2; ++k) dst[n][k] = *(const PG8_LAS bf16x8*)(lds + PG8_SB(b, h) + boff + n * 2048 + k * 1024); } while (0)
#define PG8_MMA(ai, bj, At, Bt) do { __builtin_amdgcn_s_setprio(1); _Pragma("unroll") for (int m = 0; m < 4; ++m) _Pragma("unroll") for (int n = 0; n < 2; ++n) _Pragma("unroll") for (int k = 0; k < 2; ++k) \
        acc[ai][bj][m][n] = __builtin_amdgcn_mfma_f32_16x16x32_bf16(Bt[n][k], At[m][k], acc[ai][bj][m][n], 0, 0, 0); __builtin_amdgcn_s_setprio(0); } while (0)
#define PG8_WAIT_V(n) asm volatile("s_waitcnt vmcnt(" #n ")" ::: "memory")
#define PG8_WAIT_L(n) asm volatile("s_waitcnt lgkmcnt(" #n ")" ::: "memory")
#define PG8_BAR __builtin_amdgcn_s_barrier()
#define PG8_SCHED __builtin_amdgcn_sched_barrier(0)
    UnitG cur, nxt; int ui = 0;
    if (!S.next(0, cur)) return;
    f32x4 acc[2][2][4][2];
#pragma unroll
    for (int a = 0; a < 2; ++a)
#pragma unroll
        for (int b = 0; b < 2; ++b)
#pragma unroll
            for (int m = 0; m < 4; ++m)
#pragma unroll
                for (int n = 0; n < 2; ++n) acc[a][b][m][n] = (f32x4){0.f, 0.f, 0.f, 0.f};
    bf16x8 At[4][2], B0[2][2], B1[2][2];
    const char* cA = cur.A; const char* cB = cur.B;
    S.a_ready(cur);
    PG8_STAGE(PG8_SB(0, 0), cB, B); PG8_STAGE(PG8_SB(0, 1), cB + hstepB, B); PG8_STAGE(PG8_SA(0, 0), cA, A); PG8_STAGE(PG8_SA(0, 1), cA + hstepA, A);
    if (wr == 1) PG8_BAR;
    PG8_WAIT_V(2); PG8_BAR;
    PG8_STAGE(PG8_SB(1, 0), cB + kstep, B); PG8_STAGE(PG8_SA(1, 0), cA + kstep, A); PG8_STAGE(PG8_SB(1, 1), cB + hstepB + kstep, B);
    PG8_WAIT_V(6); PG8_BAR;
    for (;;) {
        const bool has_next = S.next(ui + 1, nxt);
        const char* nA = has_next ? nxt.A : cA; const char* nB = has_next ? nxt.B : cB; const int nt = cur.nt;
        for (int t = 0; t < nt; t += 2) {
            const bool last = (t == nt - 2);
            const char* a1 = cA + (size_t)(t + 1) * kstep;
            const char* a2 = last ? nA : cA + (size_t)(t + 2) * kstep; const char* b2 = last ? nB : cB + (size_t)(t + 2) * kstep;
            const char* a3 = a2 + kstep; const char* b3 = b2 + kstep;
            if (last && has_next) S.a_ready(nxt);
            PG8_LDB(B0, 0, 0); PG8_LDB(B1, 0, 1); PG8_SCHED; PG8_LDA(At, 0, 0); PG8_STAGE(PG8_SA(1, 1), a1 + hstepA, A);
            PG8_WAIT_V(8); PG8_WAIT_L(0); PG8_BAR; PG8_MMA(0, 0, At, B0); PG8_MMA(0, 1, At, B1); PG8_BAR; PG8_SCHED;
            PG8_LDA(At, 0, 1); PG8_STAGE(PG8_SB(0, 0), b2, B); PG8_STAGE(PG8_SB(0, 1), b2 + hstepB, B); PG8_STAGE(PG8_SA(0, 0), a2, A);
            PG8_WAIT_V(8); PG8_WAIT_L(0); PG8_BAR; PG8_MMA(1, 0, At, B0); PG8_MMA(1, 1, At, B1); PG8_BAR; PG8_SCHED;
            PG8_LDB(B0, 1, 0); PG8_LDB(B1, 1, 1); PG8_SCHED; PG8_LDA(At, 1, 0); PG8_STAGE(PG8_SA(0, 1), a2 + hstepA, A);
            PG8_WAIT_V(8); PG8_WAIT_L(0); PG8_BAR; PG8_MMA(0, 0, At, B0); PG8_MMA(0, 1, At, B1); PG8_BAR; PG8_SCHED;
            PG8_LDA(At, 1, 1); PG8_STAGE(PG8_SB(1, 0), b3, B); PG8_STAGE(PG8_SB(1, 1), b3 + hstepB, B); PG8_STAGE(PG8_SA(1, 0), a3, A);
            PG8_WAIT_V(8); PG8_WAIT_L(0); PG8_BAR; PG8_MMA(1, 0, At, B0); PG8_MMA(1, 1, At, B1); PG8_BAR; PG8_SCHED;
        }
        if constexpr (ALIGN_EPI) { if (wr == 0) PG8_BAR; }
        E(acc, cur, wr, wc, fr, fq); S.done(cur);
        if (!has_next) break;
#pragma unroll
        for (int a = 0; a < 2; ++a)
#pragma unroll
            for (int b = 0; b < 2; ++b)
#pragma unroll
                for (int m = 0; m < 4; ++m)
#pragma unroll
                    for (int n = 0; n < 2; ++n) acc[a][b][m][n] = (f32x4){0.f, 0.f, 0.f, 0.f};
        cur = nxt; cA = nA; cB = nB; ++ui;
        if constexpr (ALIGN_EPI) { if (wr == 1) PG8_BAR; }
    }
    PG8_WAIT_V(0);
    if constexpr (!ALIGN_EPI) { if (wr == 0) PG8_BAR; }
    PG8_BAR;
#undef PG8_SA
#undef PG8_SB
#undef PG8_STAGE
#undef PG8_LDA
#undef PG8_LDB
#undef PG8_MMA
#undef PG8_WAIT_V
#undef PG8_WAIT_L
#undef PG8_BAR
#undef PG8_SCHED
}
}
#define GAS __attribute__((address_space(1)))
#define LAS __attribute__((address_space(3)))
typedef unsigned short bf16;
typedef unsigned v4u __attribute__((ext_vector_type(4)));
typedef float f32x4 __attribute__((ext_vector_type(4)));
typedef short bf16x8 __attribute__((ext_vector_type(8)));
typedef GAS unsigned gu32;
typedef GAS unsigned long long gu64;
#define RLX_AGENT __ATOMIC_RELAXED, __HIP_MEMORY_SCOPE_AGENT
#define LDS_WAIT() asm volatile("s_waitcnt lgkmcnt(0)" ::: "memory")
#define VM_WAIT() asm volatile("s_waitcnt vmcnt(0)" ::: "memory")
__device__ __forceinline__ unsigned long long rt() { return __builtin_amdgcn_s_memrealtime(); }
__device__ __forceinline__ unsigned f2bf(float f) { unsigned u = __builtin_bit_cast(unsigned, f); return (u + 0x7fffu + ((u >> 16) & 1u)) >> 16; }
__device__ __forceinline__ unsigned pk2(float lo, float hi) { return f2bf(lo) | (f2bf(hi) << 16); }

#define XB_TMO      128
#define XB_XCNT(j)  (256  + 64 * (j))
#define XB_XSUB(j)  (1280 + 64 * (j))
#define XB_XGEN(j)  (2304 + 64 * (j))
#define XB_TOP      3328
#define XB_TOPGEN   3392
#define XCD_BAR_WORDS 3456
#define XB_SPIN_CAP (1u << 18)

__device__ __forceinline__ unsigned xb_ld(unsigned* p)              { return __hip_atomic_load(p, __ATOMIC_RELAXED, __HIP_MEMORY_SCOPE_AGENT); }
__device__ __forceinline__ unsigned xb_add(unsigned* p, unsigned v) { return __hip_atomic_fetch_add(p, v, __ATOMIC_RELAXED, __HIP_MEMORY_SCOPE_AGENT); }
__device__ __forceinline__ unsigned xb_xcc_id() { return (unsigned)__builtin_amdgcn_s_getreg((3 << 11) | 20) & 0xFu; }
#define XB_SPIN(cond, bar) do { unsigned _sp = 0; while (cond) { __builtin_amdgcn_s_sleep(1); \
    if ((++_sp & 255u) == 0u) { if (xb_ld(&(bar)[XB_TMO])) break; if (_sp > XB_SPIN_CAP) { atomicAdd(&(bar)[XB_TMO], 1u); break; } } } } while (0)

struct XcdBarrier {
    unsigned* bar; unsigned x;
    volatile LAS unsigned* st;
};

__device__ __forceinline__ XcdBarrier xcd_barrier_post(unsigned* bar, volatile LAS unsigned* st) {
    XcdBarrier b; b.bar = bar; b.x = xb_xcc_id(); b.st = st;
    if (threadIdx.x == 0) (void)xb_add(&bar[XB_XCNT(b.x)], 1u);
    return b;
}
__device__ __forceinline__ void xcd_barrier_complete(unsigned* bar, unsigned x, unsigned& nloc, unsigned& nx) {
    const unsigned G = gridDim.x * gridDim.y * gridDim.z;
    unsigned sum, cnt, mine, sp = 0u;
    for (;;) {
        sum = 0u; cnt = 0u; mine = 0u;
#pragma unroll
        for (unsigned j = 0; j < 16; ++j) { const unsigned c = xb_ld(&bar[XB_XCNT(j)]); sum += c; cnt += (c > 0u) ? 1u : 0u; mine = (j == x) ? c : mine; }
        if (sum == G) break;
        __builtin_amdgcn_s_sleep(1);
        if ((++sp & 255u) == 0u) { if (xb_ld(&bar[XB_TMO])) break; if (sp > XB_SPIN_CAP) { atomicAdd(&bar[XB_TMO], 1u); break; } }
    }
    nloc = mine > 0u ? mine : 1u; nx = cnt > 0u ? cnt : 1u;
}

__device__ __forceinline__ void xcd_barrier(const XcdBarrier& b) {
    asm volatile("s_waitcnt vmcnt(0)" ::: "memory");
    __syncthreads();
    if (threadIdx.x == 0) {
        unsigned* bar = b.bar;
        __builtin_amdgcn_s_waitcnt(0);
        unsigned nloc = b.st[0], nx = b.st[1];
        if (nloc == 0u) { xcd_barrier_complete(bar, b.x, nloc, nx); b.st[0] = nloc; b.st[1] = nx; }
        const unsigned old = xb_add(&bar[XB_XSUB(b.x)], 1u);
        const unsigned gen = old / nloc;
        if (old + 1u == (gen + 1u) * nloc) {
            __builtin_amdgcn_fence(__ATOMIC_RELEASE, "agent");
            asm volatile("s_waitcnt vmcnt(0)" ::: "memory");
            const unsigned og = xb_add(&bar[XB_TOP], 1u);
            const unsigned tg = og / nx;
            if (og + 1u == (tg + 1u) * nx) xb_add(&bar[XB_TOPGEN], 1u);
            else XB_SPIN(xb_ld(&bar[XB_TOPGEN]) == tg, bar);
            __builtin_amdgcn_fence(__ATOMIC_ACQUIRE, "agent");
            xb_add(&bar[XB_XGEN(b.x)], 1u);
            asm volatile("s_waitcnt vmcnt(0)" ::: "memory");
        } else {
            XB_SPIN(xb_ld(&bar[XB_XGEN(b.x)]) == gen, bar);
            __builtin_amdgcn_fence(__ATOMIC_ACQUIRE, "agent");
            asm volatile("s_waitcnt vmcnt(0)" ::: "memory");
        }
    }
    __syncthreads();
}
constexpr int NWAVES = 8, NTHR = 512;
constexpr int DM = 2048, TP = 8192, DB = 128, DS = 4, NSAMP = DB * DS, M = TP + NSAMP;
constexpr int FF = 5504, PASTL = 2048, PAGE = 128, NPAGES = 16;
constexpr int HGH = 8, HGD = 128, HGW = 1024;
constexpr int NH = 16, NKV = 2, GRP = 8, HD = 64, NSAW = 1024, KVW = 128;
constexpr int CMPB = 32, CMPS = 16, CMPH = 256, SLCB = 64, SLCT = 16, WIN = 512;
constexpr int NCP = (TP - CMPB) / CMPS + 1;
constexpr int NCS = (PASTL + DS - CMPB) / CMPS + 1;
constexpr int NSP = TP / SLCB;
constexpr int NSS = (PASTL + DS + SLCB - 1) / SLCB;
constexpr int DIN = 10032, DINP = 10240;
constexpr float EPS = 1e-6f;
constexpr int C_HQ = 0, C_HF = 1024, C_HI = 2048, C_HG = 3072, C_NQ = 4096, C_KV = 5120, C_WN = 5632, C_GA = 5888, C_GB = 7936, C_NG = 9984;
constexpr size_t O_Y = 0, O_KV = (size_t)M * DM, O_WINP = O_KV + (size_t)M * 512, O_WINS = O_WINP + 512 * 256, O_HGP = O_WINS + (size_t)DB * 512 * 256, O_HGS = O_HGP + 131072, O_END = O_HGS + (size_t)DB * 131072;
static_assert(O_END == 56098816, "d_out size");
constexpr size_t MiB = 1u << 20;
constexpr size_t alignup(size_t x) { return (x + MiB - 1) / MiB * MiB; }
constexpr size_t WS_CTL = 0, CTL_ZERO_BYTES = 1 * MiB;
constexpr size_t WS_W1GU = 1 * MiB;
constexpr size_t WS_W1D  = WS_W1GU + alignup((size_t)2 * FF * DM * 2);
constexpr size_t WS_W2GU = WS_W1D + alignup((size_t)DM * FF * 2);
constexpr size_t WS_W2D  = WS_W2GU + alignup((size_t)2 * FF * DM * 2);
constexpr size_t WS_WIN  = WS_W2D + alignup((size_t)DM * FF * 2);
constexpr size_t WS_WPH  = WS_WIN + alignup((size_t)DINP * DM * 2);
constexpr size_t WS_WPN  = WS_WPH + alignup((size_t)DM * 1024 * 2);
constexpr size_t WS_WO   = WS_WPN + alignup((size_t)DM * 1024 * 2);
constexpr size_t WS_XN   = WS_WO + alignup((size_t)DM * DM * 2);
constexpr size_t WS_HB   = WS_XN + alignup((size_t)M * DM * 2);
constexpr size_t WS_Y    = WS_HB + alignup((size_t)M * FF * 2);
constexpr size_t WS_X1   = WS_Y + alignup((size_t)M * DM * 4);
constexpr size_t WS_X2   = WS_X1 + alignup((size_t)M * DM * 4);
constexpr size_t WS_QH   = WS_X2 + alignup((size_t)M * DM * 4);
constexpr size_t WS_LOGF = WS_QH + alignup((size_t)M * 1024 * 4);
constexpr size_t WS_KH   = WS_LOGF + alignup((size_t)M * 1024 * 4);
constexpr size_t WS_VH   = WS_KH + alignup((size_t)M * 1024 * 4);
constexpr size_t WS_GH   = WS_VH + alignup((size_t)M * 1024 * 4);
constexpr size_t WS_QN   = WS_GH + alignup((size_t)M * 1024 * 4);
constexpr size_t WS_WINF = WS_QN + alignup((size_t)M * 1024 * 4);
constexpr size_t WS_NG   = WS_WINF + alignup((size_t)M * 256 * 4);
constexpr size_t WS_GA   = WS_NG + alignup((size_t)M * 48 * 4);
constexpr size_t WS_GB   = WS_GA + alignup((size_t)M * DM * 4);
constexpr size_t WS_KCP  = WS_GB + alignup((size_t)M * DM * 4);
constexpr size_t WS_VCP  = WS_KCP + 1 * MiB;
constexpr size_t WS_KCS  = WS_VCP + 1 * MiB;
constexpr size_t WS_VCS  = WS_KCS + alignup((size_t)DB * 2 * NCS * 64 * 4);
constexpr size_t WS_CB   = WS_VCS + alignup((size_t)DB * 2 * NCS * 64 * 4);
constexpr size_t WS_OHR  = WS_CB + 1 * MiB;
constexpr size_t WS_OHG  = WS_OHR + alignup((size_t)M * 1024 * 4);
constexpr size_t WS_ONSA = WS_OHG + alignup((size_t)M * 1024 * 2);
constexpr size_t WS_T1   = WS_ONSA + alignup((size_t)M * 1024 * 2);
constexpr size_t WS_MIX  = WS_T1 + alignup((size_t)M * DM * 4);
constexpr size_t WS_UT   = WS_MIX + alignup((size_t)M * DM * 2);
constexpr size_t WS_DD   = WS_UT + alignup((size_t)128 * 8 * 16384 * 4);
constexpr size_t WS_SP   = WS_DD + 1 * MiB;
constexpr size_t WS_QN16 = WS_SP + alignup((size_t)128 * 8 * 16384 * 2);
constexpr size_t WS_KSL  = WS_QN16 + alignup((size_t)M * 1024 * 2);
constexpr size_t WS_VSL  = WS_KSL + 2 * MiB;
constexpr size_t WS_KWN  = WS_VSL + 2 * MiB;
constexpr size_t WS_VWN  = WS_KWN + 2 * MiB;
constexpr size_t WS_KC16 = WS_VWN + 2 * MiB;
constexpr size_t WS_VC16 = WS_KC16 + 1 * MiB;
constexpr int CMP_ROWS_S = DB * 2 * 2 * 128, CMP_ROWS_P = 2 * 2 * 512, CMP_ROWS = CMP_ROWS_S + CMP_ROWS_P;
constexpr size_t WS_CA   = WS_VC16 + 1 * MiB;
constexpr size_t WS_HID  = WS_CA + alignup((size_t)CMP_ROWS * 1024 * 2) + 1 * MiB;
constexpr size_t WS_W1C  = WS_HID + alignup((size_t)CMP_ROWS * 256 * 2);
constexpr size_t WS_W2C  = WS_W1C + 2 * MiB;
constexpr size_t WS_SLAB = WS_W2C + 1 * MiB;
constexpr size_t SLABSZ = (size_t)NSAMP * DM;
constexpr size_t WS_QH16 = WS_SLAB + alignup(16 * SLABSZ * 4);
constexpr size_t WS_KH16 = WS_QH16 + 18 * MiB;
constexpr size_t WS_VH16 = WS_KH16 + 18 * MiB;
constexpr size_t WS_GH16 = WS_VH16 + 18 * MiB;
constexpr size_t WS_RS   = WS_GH16 + 18 * MiB;
constexpr size_t WS_END  = WS_RS + 1 * MiB;
static_assert(WS_END < (size_t)2600 * MiB, "workspace");
constexpr int CW_TMO = 0, CW_CODE = 1, CW_BAR = 4096, CW_Q7 = 8192, CW_Q5 = 8192 + 256;
constexpr int RING_OFF = 0, RING_BYTES = 131072;
constexpr int LDSCTL_OFF = RING_BYTES, MISC_OFF = LDSCTL_OFF + 320;
constexpr int LDS_BYTES = 147456;
namespace pg8 {
__device__ __forceinline__ float sigm(float x) { return __builtin_amdgcn_rcpf(1.f + __expf(-x)); }
#define EPI_FOR(...) _Pragma("unroll") for (int ai = 0; ai < 2; ++ai) _Pragma("unroll") for (int m = 0; m < 4; ++m) { const int row = row0 + ai * 128 + m * 16; \
    _Pragma("unroll") for (int bj = 0; bj < 2; ++bj) _Pragma("unroll") for (int n = 0; n < 2; ++n) { const int cl = cl0 + bj * 128 + 4 * n; f32x4 v = acc[ai][bj][m][n]; __VA_ARGS__ } }
#define EPI_BFSILU(dst, ld, col) _Pragma("unroll") for (int ai = 0; ai < 2; ++ai) _Pragma("unroll") for (int m = 0; m < 4; ++m) { const int row = row0 + ai * 128 + m * 16; \
    _Pragma("unroll") for (int bj = 0; bj < 2; ++bj) { const f32x4 a = acc[ai][bj][m][0], b = acc[ai][bj][m][1]; u32x4 w; \
        w.x = cvt_pk_bf16(a[0] * sigm(a[0]), a[1] * sigm(a[1])); w.y = cvt_pk_bf16(a[2] * sigm(a[2]), a[3] * sigm(a[3])); w.z = cvt_pk_bf16(b[0] * sigm(b[0]), b[1] * sigm(b[1])); w.w = cvt_pk_bf16(b[2] * sigm(b[2]), b[3] * sigm(b[3])); \
        *(u32x4*)((dst) + (size_t)row * (ld) + (col)) = w; } }
#define EPI_BFS(dst, ld, col) _Pragma("unroll") for (int ai = 0; ai < 2; ++ai) _Pragma("unroll") for (int m = 0; m < 4; ++m) { const int row = row0 + ai * 128 + m * 16; \
    _Pragma("unroll") for (int bj = 0; bj < 2; ++bj) { f32x4 a = acc[ai][bj][m][0], b = acc[ai][bj][m][1]; for (int j = 0; j < 4; ++j) { a[j] = sigm(a[j]); b[j] = sigm(b[j]); } u32x4 w; \
        w.x = cvt_pk_bf16(a[0], a[1]); w.y = cvt_pk_bf16(a[2], a[3]); w.z = cvt_pk_bf16(b[0], b[1]); w.w = cvt_pk_bf16(b[2], b[3]); *(u32x4*)((dst) + (size_t)row * (ld) + (col)) = w; } }
#define EPI_BF(dst, ld, col, scale) _Pragma("unroll") for (int ai = 0; ai < 2; ++ai) _Pragma("unroll") for (int m = 0; m < 4; ++m) { const int row = row0 + ai * 128 + m * 16; \
    _Pragma("unroll") for (int bj = 0; bj < 2; ++bj) { const f32x4 a = acc[ai][bj][m][0] * (scale), b = acc[ai][bj][m][1] * (scale); u32x4 w; \
        w.x = cvt_pk_bf16(a[0], a[1]); w.y = cvt_pk_bf16(a[2], a[3]); w.z = cvt_pk_bf16(b[0], b[1]); w.w = cvt_pk_bf16(b[2], b[3]); *(u32x4*)((dst) + (size_t)row * (ld) + (col)) = w; } }
__device__ __forceinline__ void unpack8(const u32x4 w, f32x4& a, f32x4& b) {
    a[0] = __uint_as_float(w.x << 16); a[1] = __uint_as_float(w.x & 0xffff0000u); a[2] = __uint_as_float(w.y << 16); a[3] = __uint_as_float(w.y & 0xffff0000u);
    b[0] = __uint_as_float(w.z << 16); b[1] = __uint_as_float(w.z & 0xffff0000u); b[2] = __uint_as_float(w.w << 16); b[3] = __uint_as_float(w.w & 0xffff0000u); }
struct EpiSwiglu {
    static constexpr bool PERM = true;
    bf16_t* H; int ldh;
    __device__ __forceinline__ void operator()(const f32x4 (&acc)[2][2][4][2], const Unit& u, int wr, int wc, int fr, int fq) const {
        const int row0 = u.pm * BM + wr * 64 + fr, col = u.pn * 128 + wc * 32 + 8 * fq;
#pragma unroll
        for (int ai = 0; ai < 2; ++ai)
#pragma unroll
            for (int m = 0; m < 4; ++m) { const int row = row0 + ai * 128 + m * 16; float h[8];
#pragma unroll
                for (int n = 0; n < 2; ++n)
#pragma unroll
                    for (int j = 0; j < 4; ++j) { const float g = acc[ai][0][m][n][j], up = acc[ai][1][m][n][j]; h[4 * n + j] = g * sigm(g) * up; }
                u32x4 w; w.x = cvt_pk_bf16(h[0], h[1]); w.y = cvt_pk_bf16(h[2], h[3]); w.z = cvt_pk_bf16(h[4], h[5]); w.w = cvt_pk_bf16(h[6], h[7]);
                *(u32x4*)(H + (size_t)row * ldh + col) = w; }
    }
};
struct EpiY16 {
    static constexpr bool PERM = true;
    bf16_t* Y; int ldc;
    __device__ __forceinline__ void operator()(const f32x4 (&acc)[2][2][4][2], const Unit& u, int wr, int wc, int fr, int fq) const {
        const int row0 = u.pm * BM + wr * 64 + fr, cl0 = u.pn * BM + wc * 32 + 8 * fq;
        EPI_BF(Y, ldc, cl0 + bj * 128, 1.f)
    }
};
struct EpiSlab {
    static constexpr bool PERM = true;
    float* S;
    __device__ __forceinline__ void operator()(const f32x4 (&acc)[2][2][4][2], const Unit& u, int wr, int wc, int fr, int fq) const {
        const int row0 = (u.pm - 32) * BM + wr * 64 + fr, cl0 = u.pn * BM + wc * 32 + 8 * fq;
        EPI_FOR( *(f32x4*)(S + (size_t)row * 2048 + cl) = v; )
    }
};
struct OneUnit {
    int su;
    __device__ bool next(int i, Unit& u) const { if (i > 0 || su >= 16) return false; u.pm = 32 + (su >> 3); u.pn = su & 7; return true; }
    __device__ __forceinline__ void a_ready(const Unit&) const {}
    __device__ __forceinline__ void done(const Unit&) const {}
};
struct SplitSched {
    StaticOrder S; const char* A; const char* B; int lda, ldb, K, NS, bid;
    __device__ __forceinline__ void piece(int ks, int& koff, int& klen) const { if (K == FF) { koff = 128 * (ks < 11 ? 3 * ks : 33 + 2 * (ks - 11)); klen = ks < 11 ? 384 : 256; } else { klen = K / NS; koff = ks * klen; } }
    __device__ bool next(int i, UnitG& u) const {
        const int nmain = S.c < S.nwg ? (S.nwg - S.c + S.G - 1) / S.G : 0;
        if (i < nmain) { Unit m; S.next(i, m); u.pm = m.pm; u.pn = m.pn; u.A = A + (size_t)m.pm * 256 * lda * 2; u.B = B + (size_t)m.pn * 256 * ldb * 2; u.nt = K / 64; u.kind = 0; u.aux = 0; return true; }
        if (i > nmain) return false;
        const int ks = bid % NS, su = bid / NS; if (su >= 16) return false;
        int koff, klen; piece(ks, koff, klen);
        u.pm = 32 + (su >> 3); u.pn = su & 7; u.A = A + ((size_t)u.pm * 256 * lda + koff) * 2; u.B = B + ((size_t)u.pn * 256 * ldb + koff) * 2; u.nt = klen / 64; u.kind = 1; u.aux = ks; return true;
    }
    __device__ __forceinline__ void a_ready(const UnitG&) const {}
    __device__ __forceinline__ void done(const UnitG&) const {}
};
struct ProjSched {
    StaticOrder S; const char* Ah; const char* An; const char* Bh; const char* Bn; int bid;
    __device__ bool next(int i, UnitG& u) const {
        const int nmain = S.c < S.nwg ? (S.nwg - S.c + S.G - 1) / S.G : 0;
        if (i < 2 * nmain) { Unit m; S.next(i >> 1, m); const bool n = i & 1; u.pm = m.pm; u.pn = m.pn; u.A = (n ? An : Ah) + (size_t)m.pm * 256 * 1024 * 2; u.B = (n ? Bn : Bh) + (size_t)m.pn * 256 * 1024 * 2; u.nt = 16; u.kind = n ? 2 : 0; u.aux = 0; return true; }
        const int j = i - 2 * nmain; if (j > 1) return false;
        const int ks = bid & 3, su = bid >> 2; if (su >= 16) return false;
        u.pm = 32 + (su >> 3); u.pn = su & 7; u.A = (j ? An : Ah) + ((size_t)u.pm * 256 * 1024 + ks * 256) * 2; u.B = (j ? Bn : Bh) + ((size_t)u.pn * 256 * 1024 + ks * 256) * 2; u.nt = 4; u.kind = 1; u.aux = 4 * j + ks; return true;
    }
    __device__ __forceinline__ void a_ready(const UnitG&) const {}
    __device__ __forceinline__ void done(const UnitG&) const {}
};
__device__ __forceinline__ f32x4 sig4(f32x4 x) { return (f32x4){sigm(x[0]), sigm(x[1]), sigm(x[2]), sigm(x[3])}; }
struct EpiGate1 {
    static constexpr bool PERM = true;
    const bf16_t* GA; bf16_t* T1; int ldc;
    __device__ __forceinline__ void operator()(const f32x4 (&acc)[2][2][4][2], const Unit& u, int wr, int wc, int fr, int fq) const {
        const int row0 = u.pm * BM + wr * 64 + fr, cl0 = u.pn * BM + wc * 32 + 8 * fq;
#pragma unroll
        for (int ai = 0; ai < 2; ++ai)
#pragma unroll
            for (int m = 0; m < 4; ++m) { const int row = row0 + ai * 128 + m * 16;
#pragma unroll
                for (int bj = 0; bj < 2; ++bj) { const size_t off = (size_t)row * ldc + cl0 + bj * 128; f32x4 g0, g1; unpack8(*(const u32x4*)(GA + off), g0, g1);
                    const f32x4 a = sig4(g0) * acc[ai][bj][m][0], b = sig4(g1) * acc[ai][bj][m][1];
                    u32x4 w; w.x = cvt_pk_bf16(a[0], a[1]); w.y = cvt_pk_bf16(a[2], a[3]); w.z = cvt_pk_bf16(b[0], b[1]); w.w = cvt_pk_bf16(b[2], b[3]);
                    *(u32x4*)(T1 + off) = w; } }
    }
};
struct EpiGate2 {
    static constexpr bool PERM = true;
    const bf16_t* GB; const bf16_t* T1; bf16_t* MIX; int ldc;
    __device__ __forceinline__ void operator()(const f32x4 (&acc)[2][2][4][2], const Unit& u, int wr, int wc, int fr, int fq) const {
        const int row0 = u.pm * BM + wr * 64 + fr, cl0 = u.pn * BM + wc * 32 + 8 * fq;
#pragma unroll
        for (int ai = 0; ai < 2; ++ai)
#pragma unroll
            for (int m = 0; m < 4; ++m) { const int row = row0 + ai * 128 + m * 16;
#pragma unroll
                for (int bj = 0; bj < 2; ++bj) { const size_t off = (size_t)row * ldc + cl0 + bj * 128; f32x4 t0, t1, g0, g1; unpack8(*(const u32x4*)(T1 + off), t0, t1); unpack8(*(const u32x4*)(GB + off), g0, g1);
                    const f32x4 a = t0 + sig4(g0) * acc[ai][bj][m][0], b = t1 + sig4(g1) * acc[ai][bj][m][1];
                    u32x4 w; w.x = cvt_pk_bf16(a[0], a[1]); w.y = cvt_pk_bf16(a[2], a[3]); w.z = cvt_pk_bf16(b[0], b[1]); w.w = cvt_pk_bf16(b[2], b[3]);
                    *(u32x4*)(MIX + off) = w; } }
    }
};
template <class Main> struct EpiDual {
    static constexpr bool PERM = true;
    Main main; float* slab;
    __device__ __forceinline__ void operator()(const f32x4 (&acc)[2][2][4][2], const UnitG& u, int wr, int wc, int fr, int fq) const {
        if (u.kind == 0) main(acc, u, wr, wc, fr, fq); else { EpiSlab e{slab + (size_t)u.aux * SLABSZ}; e(acc, u, wr, wc, fr, fq); }
    }
};
struct EpiProj {
    static constexpr bool PERM = true;
    EpiGate1 g1; EpiGate2 g2; float* slab;
    __device__ __forceinline__ void operator()(const f32x4 (&acc)[2][2][4][2], const UnitG& u, int wr, int wc, int fr, int fq) const {
        if (u.kind == 0) g1(acc, u, wr, wc, fr, fq); else if (u.kind == 2) g2(acc, u, wr, wc, fr, fq); else { EpiSlab e{slab + (size_t)u.aux * SLABSZ}; e(acc, u, wr, wc, fr, fq); }
    }
};
struct EpiCmp {
    static constexpr bool PERM = true;
    const float* CB; bf16_t* HID;
    __device__ __forceinline__ void operator()(const f32x4 (&acc)[2][2][4][2], const Unit& u, int wr, int wc, int fr, int fq) const {
        const int row0 = u.pm * BM + wr * 64 + fr, cl0 = wc * 32 + 8 * fq;
#pragma unroll
        for (int bj = 0; bj < 2; ++bj) { const f32x4 b0 = *(const f32x4*)(CB + u.pn * 256 + cl0 + bj * 128), b1 = *(const f32x4*)(CB + u.pn * 256 + cl0 + bj * 128 + 4);
#pragma unroll
            for (int ai = 0; ai < 2; ++ai)
#pragma unroll
                for (int m = 0; m < 4; ++m) { const int row = row0 + ai * 128 + m * 16; f32x4 a = acc[ai][bj][m][0] + b0, b = acc[ai][bj][m][1] + b1;
                    for (int j = 0; j < 4; ++j) { a[j] = a[j] * sigm(1.5957691216057308f * (a[j] + 0.044715f * a[j] * a[j] * a[j])); b[j] = b[j] * sigm(1.5957691216057308f * (b[j] + 0.044715f * b[j] * b[j] * b[j])); }
                    u32x4 w; w.x = cvt_pk_bf16(a[0], a[1]); w.y = cvt_pk_bf16(a[2], a[3]); w.z = cvt_pk_bf16(b[0], b[1]); w.w = cvt_pk_bf16(b[2], b[3]);
                    *(u32x4*)(HID + (size_t)row * 256 + cl0 + bj * 128) = w; } }
    }
};
struct CmpOrder {
    int G, c;
    __device__ bool next(int i, Unit& u) const { const int L = i * G + c; if (L >= CMP_ROWS / 256) return false; u.pm = L; u.pn = L < CMP_ROWS_S / 256 ? (L >= CMP_ROWS_S / 512 ? 1 : 0) : (L - CMP_ROWS_S / 256 >= 4 ? 1 : 0); return true; }
    __device__ __forceinline__ void a_ready(const Unit&) const {}
    __device__ __forceinline__ void done(const Unit&) const {}
};
struct EpiInProj {
    static constexpr bool PERM = true;
    unsigned char* ws; float* out; const float* hg_lb;
    __device__ __forceinline__ void operator()(const f32x4 (&acc)[2][2][4][2], const Unit& u, int wr, int wc, int fr, int fq) const {
        const int row0 = u.pm * BM + wr * 64 + fr, cl0 = wc * 32 + 8 * fq, pn = u.pn;
        float* const LOGF = (float*)(ws + WS_LOGF);
        float* const WINF = (float*)(ws + WS_WINF); float* const NG = (float*)(ws + WS_NG); bf16_t* const GA = (bf16_t*)(ws + WS_GA); bf16_t* const GB = (bf16_t*)(ws + WS_GB);
        float* const KVO = out + O_KV; float* const WINP = out + O_WINP; float* const WINS = out + O_WINS;
        bf16_t* const QN16 = (bf16_t*)(ws + WS_QN16); bf16_t* const KSL = (bf16_t*)(ws + WS_KSL); bf16_t* const VSL = (bf16_t*)(ws + WS_VSL); bf16_t* const KWN = (bf16_t*)(ws + WS_KWN); bf16_t* const VWN = (bf16_t*)(ws + WS_VWN);
        bf16_t* const CP16 = (bf16_t*)(ws + WS_CA) + (size_t)CMP_ROWS_S * 1024;
        bf16_t* const QH16 = (bf16_t*)(ws + WS_QH16); bf16_t* const KH16 = (bf16_t*)(ws + WS_KH16); bf16_t* const VH16 = (bf16_t*)(ws + WS_VH16); bf16_t* const GH16 = (bf16_t*)(ws + WS_GH16);
        if (pn < 4) { const int cb = pn * 256;
            EPI_BFSILU(QH16, 1024, cb + cl0 + bj * 128)
        } else if (pn < 8) { const int cb = (pn - 4) * 256;
#pragma unroll
            for (int bj = 0; bj < 2; ++bj) { const int c = cb + cl0 + bj * 128; f32x4 lb[2];
#pragma unroll
                for (int n = 0; n < 2; ++n) { const f32x4 a0 = *(const f32x4*)(hg_lb + c + 4 * n), a1 = *(const f32x4*)(hg_lb + 1024 + c + 4 * n); for (int j = 0; j < 4; ++j) lb[n][j] = 1.f / (1.f + expf(a1[j] - a0[j])); }
#pragma unroll
                for (int ai = 0; ai < 2; ++ai)
#pragma unroll
                    for (int m = 0; m < 4; ++m) { const int row = row0 + ai * 128 + m * 16; f32x4 kk[2];
#pragma unroll
                        for (int n = 0; n < 2; ++n) { const f32x4 v = acc[ai][bj][m][n]; f32x4 lf;
                            for (int j = 0; j < 4; ++j) { const float sg = 1.f / (1.f + expf(-v[j])), sn = 1.f / (1.f + expf(v[j])); const float f = lb[n][j] + (1.f - lb[n][j]) * sg; lf[j] = logf(f); kk[n][j] = (1.f - lb[n][j]) * sn; }
                            *(f32x4*)(LOGF + (size_t)row * 1024 + c + 4 * n) = lf; }
                        { u32x4 w; w.x = cvt_pk_bf16(kk[0][0], kk[0][1]); w.y = cvt_pk_bf16(kk[0][2], kk[0][3]); w.z = cvt_pk_bf16(kk[1][0], kk[1][1]); w.w = cvt_pk_bf16(kk[1][2], kk[1][3]); *(u32x4*)(KH16 + (size_t)row * 1024 + c) = w; } } }
        } else if (pn < 12) { const int cb = (pn - 8) * 256;
            EPI_BF(VH16, 1024, cb + cl0 + bj * 128, 1.f)
        } else if (pn < 16) { const int cb = (pn - 12) * 256;
            EPI_BFSILU(GH16, 1024, cb + cl0 + bj * 128)
        } else if (pn < 20) { const int cb = (pn - 16) * 256;
            EPI_BF(QN16, 1024, cb + cl0 + bj * 128, 0.125f * 1.4426950408889634f)
        } else if (pn < 22) { const int cb = (pn - 20) * 256;
            EPI_FOR( *(f32x4*)(KVO + (size_t)row * 512 + cb + cl) = v; )
            if (pn == 21 && u.pm < 32) { EPI_BF((bj ? VSL : KSL), 128, cl0, 1.f) }
            if (pn == 20 && u.pm < 32) { EPI_BF(CP16 + (size_t)(bj * 2 + (cl0 >> 6)) * 8192 * 64, 64, cl0 & 63, 1.f) }
        } else if (pn == 22) {
            EPI_FOR( *(f32x4*)(WINF + (size_t)row * 256 + cl) = v;
                     if (row >= 7680 && row < 8192) *(f32x4*)(WINP + (size_t)(row - 7680) * 256 + cl) = v;
                     if (row >= 8192) { const int b = (row - 8192) >> 2, tt = (row - 8192) & 3; *(f32x4*)(WINS + ((size_t)b * 512 + 508 + tt) * 256 + cl) = v; } )
            if (u.pm < 32) { EPI_BF((bj ? VWN : KWN), 128, cl0, 1.f) }
        } else if (pn < 31) { const int cb = (pn - 23) * 256;
            EPI_BF(GA, 2048, cb + cl0 + bj * 128, 1.f)
        } else if (pn < 39) { const int cb = (pn - 31) * 256;
            EPI_BF(GB, 2048, cb + cl0 + bj * 128, 1.f)
        } else {
            EPI_FOR( if (cl < 48) { f32x4 o; for (int j = 0; j < 4; ++j) o[j] = sigm(v[j]); *(f32x4*)(NG + (size_t)row * 48 + cl) = o; } )
        }
    }
};
#undef EPI_FOR
#undef EPI_BF
#undef EPI_BFS
#undef EPI_BFSILU
}
typedef float f4 __attribute__((ext_vector_type(4)));
typedef float f2 __attribute__((ext_vector_type(2)));
typedef unsigned u2 __attribute__((ext_vector_type(2)));
__device__ __forceinline__ float wsum(float v) {
#pragma unroll
    for (int o = 32; o > 0; o >>= 1) v += __shfl_xor(v, o);
    return v;
}
__device__ __forceinline__ float wmax(float v) {
#pragma unroll
    for (int o = 32; o > 0; o >>= 1) v = fmaxf(v, __shfl_xor(v, o));
    return v;
}
__device__ __forceinline__ f4 ld4bf(const bf16* p) { const u2 w = *(const u2*)p; return (f4){__uint_as_float(w.x << 16), __uint_as_float(w.x & 0xffff0000u), __uint_as_float(w.y << 16), __uint_as_float(w.y & 0xffff0000u)}; }
struct Ctx { int tid, lane, wave, gw, NGW, G, bid; LAS unsigned char* lds; };

struct TrMat { int in_idx, K, N, map; size_t dst; };
__device__ __forceinline__ TrMat tr_mat(int m) {
    switch (m) {
        case 0: return TrMat{8, DM, FF, 1, WS_W1GU};              case 1: return TrMat{9, DM, FF, 2, WS_W1GU};
        case 2: return TrMat{13, DM, DIN, 3, WS_WIN};
        case 3: return TrMat{17, 2048, 256, 0, WS_W1C};           case 4: return TrMat{20, 2048, 256, 0, WS_W1C + (size_t)256 * 2048 * 2};
        case 5: return TrMat{18, 256, 64, 0, WS_W2C};             case 6: return TrMat{21, 256, 64, 0, WS_W2C + (size_t)64 * 256 * 2};
        case 7: return TrMat{10, FF, DM, 0, WS_W1D};
        case 8: return TrMat{27, DM, FF, 1, WS_W2GU};             case 9: return TrMat{28, DM, FF, 2, WS_W2GU};
        case 10: return TrMat{22, 1024, DM, 0, WS_WPH};           case 11: return TrMat{23, 1024, DM, 0, WS_WPN};
        case 12: return TrMat{24, DM, DM, 0, WS_WO};
        default: return TrMat{29, FF, DM, 0, WS_W2D};
    }
}
__device__ __forceinline__ int tr_items(const TrMat& t) { return (t.K / 64) * ((t.N + 63) / 64); }
__device__ __forceinline__ int dest_row_rt(int map, int n) {
    if (map == 1) return (n >> 7) * 256 + (n & 127);
    if (map == 2) return (n >> 7) * 256 + 128 + (n & 127);
    if (map == 3) return n < 5888 ? n : (n < 5936 ? C_NG + (n - 5888) : C_GA + (n - 5936));
    return n;
}
__device__ __forceinline__ void tr_item64(const float* W, int K, int N, bf16* WT, int map, LAS unsigned* scr, int item, int lane) {
    const int nblk = (N + 63) / 64, kb = item / nblk, nb = item % nblk, k0 = 64 * kb, n0 = 64 * nb, nn = n0 + lane; const bool ok = nn < N;
    const float* src = W + (size_t)k0 * N + (ok ? nn : 0);
    float v[64];
#pragma unroll
    for (int i = 0; i < 64; ++i) v[i] = src[(size_t)i * N];
#pragma unroll
    for (int i = 0; i < 32; ++i) scr[lane * 33 + i] = pk2(v[2 * i], v[2 * i + 1]);
    LDS_WAIT(); asm volatile("" ::: "memory");
    const int c = lane & 7;
#pragma unroll
    for (int j = 0; j < 8; ++j) { const int n = (lane >> 3) + 8 * j; v4u o; o.x = scr[n * 33 + 4 * c]; o.y = scr[n * 33 + 4 * c + 1]; o.z = scr[n * 33 + 4 * c + 2]; o.w = scr[n * 33 + 4 * c + 3];
        if (n0 + n < N) *(GAS v4u*)(WT + (size_t)dest_row_rt(map, n0 + n) * K + k0 + 8 * c) = o; }
    LDS_WAIT(); asm volatile("" ::: "memory");
}
__device__ __forceinline__ void tr_run(const void* const* in, unsigned char* ws, LAS unsigned* scr, int mlo, int mhi, int widx, int nw, int lane) {
    int total = 0;
    for (int m = mlo; m < mhi; ++m) total += tr_items(tr_mat(m));
    for (int it = widx; it < total; it += nw) { int r = it, m = mlo; TrMat t = tr_mat(m);
        while (r >= tr_items(t)) { r -= tr_items(t); ++m; t = tr_mat(m); }
        tr_item64((const float*)in[t.in_idx], t.K, t.N, (bf16*)(ws + t.dst), t.map, scr, r, lane); }
}
__device__ __forceinline__ void rms_row_to_bf16(const float* xrow, const float* g, bf16* orow, int lane) {
    const f4* xr = (const f4*)xrow + lane; const f4* gr = (const f4*)g + lane;
    f4 v[8]; float s = 0.f;
#pragma unroll
    for (int j = 0; j < 8; ++j) { v[j] = xr[64 * j]; s += (v[j].x * v[j].x + v[j].y * v[j].y) + (v[j].z * v[j].z + v[j].w * v[j].w); }
    const float r = rsqrtf(wsum(s) * (1.f / DM) + EPS);
    unsigned long long* o8 = (unsigned long long*)orow + lane;
#pragma unroll
    for (int j = 0; j < 8; ++j) { const f4 gg = gr[64 * j]; o8[64 * j] = (unsigned long long)pk2(v[j].x * r * gg.x, v[j].y * r * gg.y) | ((unsigned long long)pk2(v[j].z * r * gg.z, v[j].w * r * gg.w) << 32); }
}
__device__ __forceinline__ void norm_mid_row(const void* yrow_, const float* xin, const bf16* xin16, const float* gin, float rs_in, const float* gpost, float scale, float* xout, const float* gpre, bf16* xn, float* rs_out, int lane, int nslab = 0) {
    const f4* yr = (const f4*)yrow_ + lane; const f4* xr = (const f4*)xin + lane; const f4* gp = (const f4*)gpost + lane;
    f4 v[8]; float s = 0.f;
    if (nslab == 0) {
        const unsigned long long* y8 = (const unsigned long long*)yrow_ + lane;
#pragma unroll
        for (int j = 0; j < 8; ++j) { const unsigned long long w = y8[64 * j]; const unsigned lo = (unsigned)w, hi = (unsigned)(w >> 32);
            v[j] = (f4){__uint_as_float(lo << 16), __uint_as_float(lo & 0xffff0000u), __uint_as_float(hi << 16), __uint_as_float(hi & 0xffff0000u)}; }
    } else {
#pragma unroll
        for (int j = 0; j < 8; ++j) v[j] = yr[64 * j];
    }
    for (int k = 1; k + 3 < nslab; k += 4) {
        f4 t[4][8];
#pragma unroll
        for (int kk = 0; kk < 4; ++kk)
#pragma unroll
            for (int j = 0; j < 8; ++j) t[kk][j] = yr[64 * j + (size_t)(k + kk) * (SLABSZ / 4)];
#pragma unroll
        for (int kk = 0; kk < 4; ++kk)
#pragma unroll
            for (int j = 0; j < 8; ++j) v[j] += t[kk][j];
    }
    if (nslab > 0) { const int k0 = 1 + ((nslab - 1) / 4) * 4;
#pragma unroll
        for (int kk = 0; kk < 3; ++kk)
#pragma unroll
            for (int j = 0; j < 8; ++j) v[j] += yr[64 * j + (size_t)(k0 + kk) * (SLABSZ / 4)]; }
#pragma unroll
    for (int j = 0; j < 8; ++j) s += (v[j].x * v[j].x + v[j].y * v[j].y) + (v[j].z * v[j].z + v[j].w * v[j].w);
    const float r = rsqrtf(wsum(s) * (1.f / DM) + EPS) * scale;
    float s2 = 0.f;
#pragma unroll
    for (int j = 0; j < 8; ++j) { f4 xi;
        if (xin) xi = xr[64 * j];
        else { const f4 xb = ld4bf(xin16 + 4 * (lane + 64 * j)), gi = ((const f4*)gin + lane)[64 * j];
            xi = (f4){xb.x * rs_in * __builtin_amdgcn_rcpf(gi.x), xb.y * rs_in * __builtin_amdgcn_rcpf(gi.y), xb.z * rs_in * __builtin_amdgcn_rcpf(gi.z), xb.w * rs_in * __builtin_amdgcn_rcpf(gi.w)}; }
        const f4 gg = gp[64 * j]; v[j] = xi + v[j] * gg * r; if (xout) ((f4*)xout + lane)[64 * j] = v[j];
        s2 += (v[j].x * v[j].x + v[j].y * v[j].y) + (v[j].z * v[j].z + v[j].w * v[j].w); }
    if (xn) {
        const float ms = wsum(s2) * (1.f / DM) + EPS; const float r2 = rsqrtf(ms); const f4* gr = (const f4*)gpre + lane;
        if (rs_out && lane == 0) *rs_out = sqrtf(ms);
        unsigned long long* o8 = (unsigned long long*)xn + lane;
#pragma unroll
        for (int j = 0; j < 8; ++j) { const f4 gg = gr[64 * j]; o8[64 * j] = (unsigned long long)pk2(v[j].x * r2 * gg.x, v[j].y * r2 * gg.y) | ((unsigned long long)pk2(v[j].z * r2 * gg.z, v[j].w * r2 * gg.w) << 32); }
    }
}

__device__ __forceinline__ void hgrn_seq_pair(int rowbase, int h, int vg2, const float* S0, float* Sout, const bf16* QH, const float* LOGF, const bf16* KH, const bf16* VH, float* OHR, int lane) {
    const int kq = lane >> 1, vh = lane & 1, kc = h * 128 + 4 * kq, vc = h * 128 + 16 * vg2 + 4 * vh;
    f4 s[2][4], q4[4], lf[4], k4[4], v4[2][4];
#pragma unroll
    for (int u = 0; u < 2; ++u)
#pragma unroll
        for (int i = 0; i < 4; ++i) s[u][i] = *(const f4*)(S0 + (size_t)(4 * kq + i) * 128 + 16 * vg2 + 8 * u + 4 * vh);
#pragma unroll
    for (int t = 0; t < 4; ++t) { const size_t base = (size_t)(rowbase + t) * 1024; q4[t] = ld4bf(QH + base + kc); lf[t] = *(const f4*)(LOGF + base + kc); k4[t] = ld4bf(KH + base + kc);
        v4[0][t] = ld4bf(VH + base + vc); v4[1][t] = ld4bf(VH + base + vc + 8); }
#pragma unroll
    for (int t = 0; t < 4; ++t) {
        const size_t base = (size_t)(rowbase + t) * 1024;
        f4 o[2] = {(f4){0.f, 0.f, 0.f, 0.f}, (f4){0.f, 0.f, 0.f, 0.f}};
#pragma unroll
        for (int i = 0; i < 4; ++i) { const float f = __expf(lf[t][i]);
#pragma unroll
            for (int u = 0; u < 2; ++u) { s[u][i] = s[u][i] * f + v4[u][t] * k4[t][i]; o[u] += s[u][i] * q4[t][i]; } }
#pragma unroll
        for (int off = 2; off < 64; off <<= 1)
#pragma unroll
            for (int u = 0; u < 2; ++u) { o[u].x += __shfl_xor(o[u].x, off); o[u].y += __shfl_xor(o[u].y, off); o[u].z += __shfl_xor(o[u].z, off); o[u].w += __shfl_xor(o[u].w, off); }
        if (kq == 0) { *(f4*)(OHR + base + vc) = o[0]; *(f4*)(OHR + base + vc + 8) = o[1]; }
    }
#pragma unroll
    for (int u = 0; u < 2; ++u)
#pragma unroll
        for (int i = 0; i < 4; ++i) *(f4*)(Sout + (size_t)(4 * kq + i) * 128 + 16 * vg2 + 8 * u + 4 * vh) = s[u][i];
}
__device__ __forceinline__ void hgrn_finish_row(const float* orow, const bf16* grow, const float* gn, bf16* out, int lane) {
#pragma unroll
    for (int j = 0; j < 4; ++j) { const int idx = lane + 64 * j; const f4 o = ((const f4*)orow)[idx], g = ld4bf(grow + 4 * idx), w = ((const f4*)gn)[idx & 31];
        float s = (o.x * o.x + o.y * o.y) + (o.z * o.z + o.w * o.w);
#pragma unroll
        for (int off = 1; off < 32; off <<= 1) s += __shfl_xor(s, off);
        const float r = rsqrtf(s * (1.f / 128.f) + EPS);
        ((unsigned long long*)out)[idx] = (unsigned long long)pk2(o.x * r * w.x * g.x, o.y * r * w.y * g.y) | ((unsigned long long)pk2(o.z * r * w.z * g.z, o.w * r * w.w * g.w) << 32); }
}

typedef short bfx8 __attribute__((ext_vector_type(8)));
typedef short bfx4 __attribute__((ext_vector_type(4)));
__device__ __forceinline__ unsigned cvtpk(float lo, float hi) { return pg8::cvt_pk_bf16(lo, hi); }
__device__ __forceinline__ bfx8 lds_frag16(const LAS bf16* p) { return *(const LAS bfx8*)p; }
__device__ __forceinline__ bfx8 lds_frag8(const LAS bf16* p) { const bfx4 a = *(const LAS bfx4*)p, b = *(const LAS bfx4*)(p + 4); return (bfx8){a[0], a[1], a[2], a[3], b[0], b[1], b[2], b[3]}; }
__device__ __forceinline__ float bflo(unsigned w) { return __uint_as_float(w << 16); }
__device__ __forceinline__ float bfhi(unsigned w) { return __uint_as_float(w & 0xffff0000u); }
constexpr int HG_NCH = TP / 64;
constexpr int L_BF = 0, L_Q0 = 33792, L_QR = L_Q0 + 17408, L_KI = L_QR + 17408, L_VT = L_KI + 17408, L_AB = L_VT + 17408, L_TOT = L_AB + 9216, L_HEND = L_TOT + 2048;
static_assert(L_HEND <= RING_BYTES, "hgrn lds");
__device__ __forceinline__ void chunk_cumsum(const Ctx& C, const f4 (&lf)[4]) {
    LAS float* Bf = (LAS float*)(C.lds + L_BF); LAS float* tot = (LAS float*)(C.lds + L_TOT);
    __syncthreads();
#pragma unroll
    for (int j = 0; j < 4; ++j) ((LAS f4*)Bf)[C.tid + 512 * j] = lf[j];
    __syncthreads();
    const int k = C.tid & 127, qr = C.tid >> 7; float s = 0.f;
#pragma unroll
    for (int r = 0; r < 16; ++r) { s += Bf[(16 * qr + r) * 128 + k]; Bf[(16 * qr + r) * 128 + k] = s; }
    tot[qr * 128 + k] = s;
    __syncthreads();
    float off = 0.f;
    for (int q2 = 0; q2 < qr; ++q2) off += tot[q2 * 128 + k];
#pragma unroll
    for (int r = 0; r < 16; ++r) Bf[(16 * qr + r) * 128 + k] += off;
    __syncthreads();
}
__device__ __forceinline__ void hgrn_A_unit(const Ctx& C, int h, int c, const float* LOGF, const bf16* KH, const bf16* VH, float* UT, float* DD) {
    const int t0 = 64 * c, cb = h * 128;
    LAS float* Bf = (LAS float*)(C.lds + L_BF); LAS bf16* KT = (LAS bf16*)(C.lds + L_KI); LAS bf16* VT = (LAS bf16*)(C.lds + L_VT);
    f4 lf[4]; v4u kv[2], vv[2];
#pragma unroll
    for (int j = 0; j < 4; ++j) { const int idx = C.tid + 512 * j; lf[j] = *(const f4*)(LOGF + (size_t)(t0 + (idx >> 5)) * 1024 + cb + 4 * (idx & 31)); }
#pragma unroll
    for (int j = 0; j < 2; ++j) { const int idx = C.tid + 512 * j; const size_t g = (size_t)(t0 + (idx >> 4)) * 1024 + cb + 8 * (idx & 15); kv[j] = *(const v4u*)(KH + g); vv[j] = *(const v4u*)(VH + g); }
    chunk_cumsum(C, lf);
#pragma unroll
    for (int j = 0; j < 2; ++j) { const int idx = C.tid + 512 * j, s = idx >> 4, ch = 8 * (idx & 15);
        const f4 bl0 = ((const LAS f4*)Bf)[63 * 32 + (ch >> 2)], bl1 = ((const LAS f4*)Bf)[63 * 32 + (ch >> 2) + 1], bs0 = ((const LAS f4*)Bf)[s * 32 + (ch >> 2)], bs1 = ((const LAS f4*)Bf)[s * 32 + (ch >> 2) + 1];
        const unsigned kw[4] = {kv[j].x, kv[j].y, kv[j].z, kv[j].w}, vw[4] = {vv[j].x, vv[j].y, vv[j].z, vv[j].w};
        const float dl[8] = {bl0.x - bs0.x, bl0.y - bs0.y, bl0.z - bs0.z, bl0.w - bs0.w, bl1.x - bs1.x, bl1.y - bs1.y, bl1.z - bs1.z, bl1.w - bs1.w};
#pragma unroll
        for (int e = 0; e < 8; ++e) { const float kf = (e & 1) ? bfhi(kw[e >> 1]) : bflo(kw[e >> 1]);
            KT[(ch + e) * 68 + s] = (bf16)f2bf(kf * __expf(dl[e])); VT[(ch + e) * 68 + s] = (bf16)((e & 1) ? (vw[e >> 1] >> 16) : (vw[e >> 1] & 0xffffu)); } }
    if (C.tid < 128) DD[(size_t)(c * 8 + h) * 128 + C.tid] = __expf(Bf[63 * 128 + C.tid]);
    __syncthreads();
    const int w = C.wave, lane = C.lane, fr = lane & 15, kg = lane >> 4;
    pg8::f32x4 acc[8];
#pragma unroll
    for (int nt = 0; nt < 8; ++nt) acc[nt] = (pg8::f32x4){0.f, 0.f, 0.f, 0.f};
#pragma unroll
    for (int ks = 0; ks < 2; ++ks) { const bfx8 a = lds_frag8(VT + (16 * w + fr) * 68 + 32 * ks + 8 * kg);
#pragma unroll
        for (int nt = 0; nt < 8; ++nt) { const bfx8 b = lds_frag8(KT + (16 * nt + fr) * 68 + 32 * ks + 8 * kg); acc[nt] = __builtin_amdgcn_mfma_f32_16x16x32_bf16(a, b, acc[nt], 0, 0, 0); } }
    float* ut = UT + (size_t)(c * 8 + h) * 16384;
#pragma unroll
    for (int nt = 0; nt < 8; ++nt)
#pragma unroll
        for (int r = 0; r < 4; ++r) ut[(size_t)(16 * w + 4 * kg + r) * 128 + 16 * nt + fr] = acc[nt][r];
    __syncthreads();
}
__device__ __forceinline__ void hgrn_scan(int tix, int nthr, const float* UT, const float* DD, bf16* SP, float* hgp) {
    for (int e = tix; e < 8 * 16384; e += nthr) { const int h = e >> 14, vk = e & 16383, k = e & 127, v = vk >> 7;
        float S = 0.f;
        for (int c = 0; c < HG_NCH; c += 16) { float u[16], d[16];
#pragma unroll
            for (int i = 0; i < 16; ++i) { u[i] = UT[(size_t)((c + i) * 8 + h) * 16384 + vk]; d[i] = DD[(size_t)((c + i) * 8 + h) * 128 + k]; }
#pragma unroll
            for (int i = 0; i < 16; ++i) { SP[(size_t)((c + i) * 8 + h) * 16384 + vk] = (bf16)f2bf(S); S = S * d[i] + u[i]; } }
        hgp[(size_t)h * 16384 + k * 128 + v] = S; }
}
__device__ __forceinline__ void hgrn_B_unit(const Ctx& C, int h, int c, const bf16* QH, const float* LOGF, const bf16* KH, const bf16* VH, const bf16* GH, const float* gn, const bf16* SP, bf16* OHG) {
    const int t0 = 64 * c, cb = h * 128, tid = C.tid;
    LAS float* Bf = (LAS float*)(C.lds + L_BF); LAS bf16* Q0 = (LAS bf16*)(C.lds + L_Q0); LAS bf16* QR = (LAS bf16*)(C.lds + L_QR); LAS bf16* KI = (LAS bf16*)(C.lds + L_KI);
    LAS bf16* VT = (LAS bf16*)(C.lds + L_VT); LAS bf16* AB = (LAS bf16*)(C.lds + L_AB); LAS float* Of = (LAS float*)(C.lds + L_BF);
    STAMP(C, 9);
    f4 lf[4], q4[4], k4[4], b4[4]; v4u vv[2]; float gh[16];
    const int w = C.wave, lane = C.lane, fr = lane & 15, kg = lane >> 4;
#pragma unroll
    for (int j = 0; j < 4; ++j) { const int idx = tid + 512 * j; const size_t g = (size_t)(t0 + (idx >> 5)) * 1024 + cb + 4 * (idx & 31); lf[j] = *(const f4*)(LOGF + g);
        const u2 qw = *(const u2*)(QH + g), kw = *(const u2*)(KH + g); q4[j] = (f4){bflo(qw.x), bfhi(qw.x), bflo(qw.y), bfhi(qw.y)}; k4[j] = (f4){bflo(kw.x), bfhi(kw.x), bflo(kw.y), bfhi(kw.y)}; }
#pragma unroll
    for (int j = 0; j < 2; ++j) { const int idx = tid + 512 * j; vv[j] = *(const v4u*)(VH + (size_t)(t0 + (idx >> 4)) * 1024 + cb + 8 * (idx & 15)); }
#pragma unroll
    for (int rr = 0; rr < 8; ++rr) { const size_t g = (size_t)(t0 + 8 * w + rr) * 1024 + cb; gh[2 * rr] = bflo((unsigned)GH[g + lane]); gh[2 * rr + 1] = bflo((unsigned)GH[g + lane + 64]); }
    const bf16* sp = SP + (size_t)(c * 8 + h) * 16384; bfx8 spf[4][4];
#pragma unroll
    for (int ks = 0; ks < 4; ++ks)
#pragma unroll
        for (int nt = 0; nt < 4; ++nt) spf[ks][nt] = *(const bfx8*)(sp + (size_t)(16 * (4 * (w >> 2) + nt) + fr) * 128 + 32 * ks + 8 * kg);
    chunk_cumsum(C, lf);
    STAMP(C, 1);
#pragma unroll
    for (int j = 0; j < 4; ++j) { const int idx = tid + 512 * j, t = idx >> 5, c4 = idx & 31, i = t >> 4;
        const f4 q = q4[j]; b4[j] = ((const LAS f4*)Bf)[idx];
        const f4 r = i > 0 ? ((const LAS f4*)Bf)[(16 * i - 1) * 32 + c4] : (f4){0.f, 0.f, 0.f, 0.f};
        u2 w0, w1;
        w0.x = cvtpk(q.x * __expf(b4[j].x), q.y * __expf(b4[j].y)); w0.y = cvtpk(q.z * __expf(b4[j].z), q.w * __expf(b4[j].w));
        w1.x = cvtpk(q.x * __expf(b4[j].x - r.x), q.y * __expf(b4[j].y - r.y)); w1.y = cvtpk(q.z * __expf(b4[j].z - r.z), q.w * __expf(b4[j].w - r.w));
        *(LAS u2*)(Q0 + t * 136 + 4 * c4) = w0; *(LAS u2*)(QR + t * 136 + 4 * c4) = w1; }
#pragma unroll
    for (int j = 0; j < 2; ++j) { const int idx = tid + 512 * j, s = idx >> 4, ch = 8 * (idx & 15); const unsigned vw[4] = {vv[j].x, vv[j].y, vv[j].z, vv[j].w};
#pragma unroll
        for (int e = 0; e < 8; ++e) VT[(ch + e) * 68 + s] = (bf16)((e & 1) ? (vw[e >> 1] >> 16) : (vw[e >> 1] & 0xffffu)); }
    for (int e = tid; e < 64 * 72 / 2; e += 512) ((LAS unsigned*)AB)[e] = 0u;
    STAMP(C, 2);
    for (int i = 0; i < 4; ++i) {
        const f4 r = i > 0 ? ((const LAS f4*)Bf)[(16 * i - 1) * 32 + (tid & 31)] : (f4){0.f, 0.f, 0.f, 0.f};
#pragma unroll
        for (int j = 0; j < 4; ++j) if (j <= i) { const int t = (tid >> 5) + 16 * j; u2 wv;
            wv.x = cvtpk(k4[j].x * __expf(r.x - b4[j].x), k4[j].y * __expf(r.y - b4[j].y)); wv.y = cvtpk(k4[j].z * __expf(r.z - b4[j].z), k4[j].w * __expf(r.w - b4[j].w));
            *(LAS u2*)(KI + t * 136 + 4 * (tid & 31)) = wv; }
        __syncthreads();
        if (w <= i) { pg8::f32x4 a4 = (pg8::f32x4){0.f, 0.f, 0.f, 0.f};
#pragma unroll
            for (int ks = 0; ks < 4; ++ks) { const bfx8 a = lds_frag16(QR + (16 * i + fr) * 136 + 32 * ks + 8 * kg), b = lds_frag16(KI + (16 * w + fr) * 136 + 32 * ks + 8 * kg);
                a4 = __builtin_amdgcn_mfma_f32_16x16x32_bf16(a, b, a4, 0, 0, 0); }
#pragma unroll
            for (int rr = 0; rr < 4; ++rr) { const int tl = 4 * kg + rr; const float val = (w < i || fr <= tl) ? a4[rr] : 0.f; AB[(16 * i + tl) * 72 + 16 * w + fr] = (bf16)f2bf(val); } }
        __syncthreads();
    }
    STAMP(C, 3);
    const int rt = w & 3, chf = w >> 2;
    pg8::f32x4 acc[4];
#pragma unroll
    for (int nt = 0; nt < 4; ++nt) acc[nt] = (pg8::f32x4){0.f, 0.f, 0.f, 0.f};
#pragma unroll
    for (int ks = 0; ks < 4; ++ks) { const bfx8 a = lds_frag16(Q0 + (16 * rt + fr) * 136 + 32 * ks + 8 * kg);
#pragma unroll
        for (int nt = 0; nt < 4; ++nt) acc[nt] = __builtin_amdgcn_mfma_f32_16x16x32_bf16(a, spf[ks][nt], acc[nt], 0, 0, 0); }
#pragma unroll
    for (int ks = 0; ks < 2; ++ks) if (2 * ks <= rt) { const bfx8 a = lds_frag16(AB + (16 * rt + fr) * 72 + 32 * ks + 8 * kg);
#pragma unroll
        for (int nt = 0; nt < 4; ++nt) { const bfx8 b = lds_frag8(VT + (16 * (4 * chf + nt) + fr) * 68 + 32 * ks + 8 * kg); acc[nt] = __builtin_amdgcn_mfma_f32_16x16x32_bf16(a, b, acc[nt], 0, 0, 0); } }
#pragma unroll
    for (int nt = 0; nt < 4; ++nt)
#pragma unroll
        for (int rr = 0; rr < 4; ++rr) Of[(16 * rt + 4 * kg + rr) * 132 + 16 * (4 * chf + nt) + fr] = acc[nt][rr];
    __syncthreads();
#pragma unroll
    for (int rr = 0; rr < 8; ++rr) { const int row = 8 * w + rr; const float o0 = Of[row * 132 + lane], o1 = Of[row * 132 + lane + 64];
        const float rs = rsqrtf(wsum(o0 * o0 + o1 * o1) * (1.f / 128.f) + EPS); const size_t g = (size_t)(t0 + row) * 1024 + cb;
        OHG[g + lane] = (bf16)f2bf(o0 * rs * gn[lane] * gh[2 * rr]); OHG[g + lane + 64] = (bf16)f2bf(o1 * rs * gn[lane + 64] * gh[2 * rr + 1]); }
    __syncthreads();
    STAMP(C, 4);
}
typedef float f16v __attribute__((ext_vector_type(16)));
constexpr float LOG2E = 1.4426950408889634f;
constexpr int NL_KT = 0, NL_VT = 9216, NL_GS = 18432, NL_LS = NL_GS + 16384, NL_SEL = NL_LS + 16384, NL_UNI = NL_SEL + 512, NL_OACC = NL_UNI + 64, NL_END = NL_OACC + 8 * 8192;
static_assert(NL_END <= RING_BYTES, "nsa lds");
struct NsaP { const bf16* QN16; const bf16* KSL; const bf16* VSL; const bf16* KWN; const bf16* VWN; const bf16* KC16; const bf16* VC16; const float* NG; bf16* ONSA; };
__device__ __forceinline__ float ex2(float x) { return __builtin_amdgcn_exp2f(x); }
__device__ __forceinline__ void nsa_fetch(const Ctx& C, const bf16* ksrc, const bf16* vsrc, int pitch, int nvalid, v4u& kr, v4u& vr) {
    { const int key = C.tid >> 3, d8 = C.tid & 7; kr = (v4u){0u, 0u, 0u, 0u}; if (key < nvalid) kr = *(const v4u*)(ksrc + (size_t)key * pitch + 8 * d8); }
    { const int key = C.tid & 63, d8 = C.tid >> 6; vr = (v4u){0u, 0u, 0u, 0u}; if (key < nvalid) vr = *(const v4u*)(vsrc + (size_t)key * pitch + 8 * d8); }
}
__device__ __forceinline__ void nsa_put(const Ctx& C, const v4u& kr, const v4u& vr) {
    LAS bf16* KT = (LAS bf16*)(C.lds + NL_KT); LAS bf16* VT = (LAS bf16*)(C.lds + NL_VT);
    { const int key = C.tid >> 3, d8 = C.tid & 7; *(LAS v4u*)(KT + key * 72 + 8 * d8) = kr; }
    { const int key = C.tid & 63, d8 = C.tid >> 6; const v4u v = vr; LAS bf16* p = VT + (8 * d8) * 72 + key;
        p[0] = (bf16)(v.x & 0xffffu); p[72] = (bf16)(v.x >> 16); p[144] = (bf16)(v.y & 0xffffu); p[216] = (bf16)(v.y >> 16);
        p[288] = (bf16)(v.z & 0xffffu); p[360] = (bf16)(v.z >> 16); p[432] = (bf16)(v.w & 0xffffu); p[504] = (bf16)(v.w >> 16); }
}
__device__ __forceinline__ int prev_bit(const unsigned (&u)[4], int below) {
#pragma unroll
    for (int wi = 3; wi >= 0; --wi) { const int lim = below - 32 * wi; if (lim <= 0) continue; const unsigned m = lim >= 32 ? u[wi] : (u[wi] & ((1u << lim) - 1u)); if (m) return 32 * wi + 31 - __clz(m); }
    return -1;
}
template <int NT> __device__ __forceinline__ void nsa_scores_t(const LAS bf16* KT, int lane, const bfx8 (&qf)[4], int klo, int khi, float base, float inc, f16v (&s)[NT]) {
    const int q = lane & 31, hi = lane >> 5;
    int kl = klo - 4 * hi, kh = khi - 4 * hi; float bh = fmaf(inc, (float)(4 * hi), base);
    asm volatile("" : "+v"(inc), "+v"(bh), "+v"(kl), "+v"(kh));
#pragma unroll
    for (int t = 0; t < NT; ++t) { s[t] = (f16v){0.f, 0.f, 0.f, 0.f, 0.f, 0.f, 0.f, 0.f, 0.f, 0.f, 0.f, 0.f, 0.f, 0.f, 0.f, 0.f};
#pragma unroll
        for (int ks = 0; ks < 4; ++ks) { const bfx8 a = *(const LAS bfx8*)(KT + (32 * t + q) * 72 + 16 * ks + 8 * hi); s[t] = __builtin_amdgcn_mfma_f32_32x32x16_bf16(a, qf[ks], s[t], 0, 0, 0); } }
    if (__builtin_amdgcn_readfirstlane(__all(klo <= 0 && khi >= 32 * NT - 1))) {
#pragma unroll
        for (int t = 0; t < NT; ++t)
#pragma unroll
            for (int r = 0; r < 16; ++r) { const int cr = 32 * t + (r & 3) + 8 * (r >> 2); s[t][r] = s[t][r] + fmaf(inc, (float)cr, bh); }
    } else {
#pragma unroll
        for (int t = 0; t < NT; ++t)
#pragma unroll
            for (int r = 0; r < 16; ++r) { const int cr = 32 * t + (r & 3) + 8 * (r >> 2); const float v = s[t][r] + fmaf(inc, (float)cr, bh); s[t][r] = (cr >= kl && cr <= kh) ? v : -INFINITY; }
    }
}
__device__ __forceinline__ void nsa_scores(const Ctx& C, const bfx8 (&qf)[4], int klo, int khi, float base, float inc, f16v (&s)[2]) { nsa_scores_t<2>((const LAS bf16*)(C.lds + NL_KT), C.lane, qf, klo, khi, base, inc, s); }
template <int NT, int VP> __device__ __forceinline__ void nsa_block_t(const LAS bf16* KT, const LAS bf16* VT, int lane, const bfx8 (&qf)[4], int klo, int khi, float base, float inc, float& m, float& l, f16v (&O)[2]) {
    const int q = lane & 31, hi = lane >> 5;
    if (!__builtin_amdgcn_readfirstlane(__any(khi >= klo))) return;
    f16v s[NT];
    nsa_scores_t<NT>(KT, lane, qf, klo, khi, base, inc, s);
    float mx = -INFINITY;
#pragma unroll
    for (int t = 0; t < NT; ++t)
#pragma unroll
        for (int r = 0; r < 16; ++r) mx = fmaxf(mx, s[t][r]);
    mx = fmaxf(mx, __shfl_xor(mx, 32));
    const float mn = fmaxf(m, mx), alpha = ex2(m - mn); m = mn;
    float rs = 0.f;
#pragma unroll
    for (int t = 0; t < NT; ++t)
#pragma unroll
        for (int r = 0; r < 16; ++r) { const float p = ex2(s[t][r] - mn); s[t][r] = p; rs += p; }
    l = l * alpha + rs;
    if (__builtin_amdgcn_readfirstlane(__any(alpha != 1.0f))) {
#pragma unroll
        for (int dt = 0; dt < 2; ++dt) O[dt] = O[dt] * alpha; }
#pragma unroll
    for (int t = 0; t < NT; ++t)
#pragma unroll
        for (int s2 = 0; s2 < 2; ++s2) {
            union { unsigned u[4]; bfx8 v; } pb;
#pragma unroll
            for (int j = 0; j < 4; ++j) pb.u[j] = cvtpk(s[t][8 * s2 + 2 * j], s[t][8 * s2 + 2 * j + 1]);
#pragma unroll
            for (int dt = 0; dt < 2; ++dt) { const LAS bf16* vp = VT + (32 * dt + q) * VP + 32 * t + 16 * s2 + 4 * hi; const bfx4 va = *(const LAS bfx4*)vp, vb = *(const LAS bfx4*)(vp + 8); const bfx8 a = (bfx8){va[0], va[1], va[2], va[3], vb[0], vb[1], vb[2], vb[3]}; O[dt] = __builtin_amdgcn_mfma_f32_32x32x16_bf16(a, pb.v, O[dt], 0, 0, 0); }
        }
}
__device__ __forceinline__ void nsa_block(const Ctx& C, const bfx8 (&qf)[4], int klo, int khi, float base, float inc, float& m, float& l, f16v (&O)[2]) {
    nsa_block_t<2, 72>((const LAS bf16*)(C.lds + NL_KT), (const LAS bf16*)(C.lds + NL_VT), C.lane, qf, klo, khi, base, inc, m, l, O); }
__device__ __forceinline__ void nsa_prompt_unit(const Ctx& C, const NsaP& A, int qt, int n) {
    int lane = C.lane; asm volatile("" : "+v"(lane));
    const int w = C.wave, q = lane & 31, hi = lane >> 5, tl = q >> 3, g = q & 7, tok = 4 * w + tl, q0 = 32 * qt, qpos = q0 + tok, head = n * 8 + g;
    LAS float* GS = (LAS float*)(C.lds + NL_GS); LAS float* LS = (LAS float*)(C.lds + NL_LS); LAS unsigned* SEL = (LAS unsigned*)(C.lds + NL_SEL); LAS unsigned* UNI = (LAS unsigned*)(C.lds + NL_UNI);
    const float slope2 = exp2f(-0.5f * (float)(head + 1)) * LOG2E;
    bfx8 qf[4];
#pragma unroll
    for (int ks = 0; ks < 4; ++ks) qf[ks] = *(const bfx8*)(A.QN16 + (size_t)qpos * 1024 + head * 64 + 16 * ks + 8 * hi);
    const float* gates = A.NG + (size_t)qpos * 48 + head * 3;
    f16v O[2]; float m, l;
    LAS float* OA = (LAS float*)(C.lds + NL_OACC + w * 8192) + lane;
#define NP_INIT() do { m = -1e30f; l = 0.f; O[0] = (f16v){0.f, 0.f, 0.f, 0.f, 0.f, 0.f, 0.f, 0.f, 0.f, 0.f, 0.f, 0.f, 0.f, 0.f, 0.f, 0.f}; O[1] = O[0]; } while (0)
#define NP_FIN(br) do { const float lt = l + __shfl_xor(l, 32); const float sc = gates[br] / fmaxf(lt, 1e-30f); _Pragma("unroll") for (int dt = 0; dt < 2; ++dt) _Pragma("unroll") for (int r = 0; r < 16; ++r) { \
        const float pv = (br) == 0 ? 0.f : OA[(dt * 16 + r) * 64]; OA[(dt * 16 + r) * 64] = pv + O[dt][r] * sc; } l = lt; } while (0)
    __syncthreads();
    for (int i = C.tid; i < 8192; i += NTHR) GS[i] = 0.f;
    const int cmax = qpos >= 31 ? (qpos - 31) >> 4 : -1;
    const int ncb = ((q0 + 31 - 31) >> 4) / 64 + 1;
    const bf16* kc = A.KC16 + (size_t)n * 512 * 64; const bf16* vc = A.VC16 + (size_t)n * 512 * 64;
    NP_INIT();
    v4u kr, vr;
#define FETCH_C(cb_) nsa_fetch(C, kc + (size_t)(cb_) * 4096, vc + (size_t)(cb_) * 4096, 64, (NCP - 64 * (cb_)) < 64 ? (NCP - 64 * (cb_)) : 64, kr, vr)
    FETCH_C(ncb - 1);
    for (int cb = ncb - 1; cb >= 0; --cb) { const int nk = (NCP - 64 * cb) < 64 ? (NCP - 64 * cb) : 64;
        __syncthreads(); nsa_put(C, kr, vr); __syncthreads();
        if (cb > 0) FETCH_C(cb - 1);
        int khi = cmax - 64 * cb; if (khi > nk - 1) khi = nk - 1;
        nsa_block(C, qf, 0, khi, -slope2 * (float)(qpos - 31 - 1024 * cb), 16.f * slope2, m, l, O); }
    NP_FIN(0);
    { const float invl = 1.f / fmaxf(l, 1e-30f);
      FETCH_C(ncb - 1);
      for (int cb = ncb - 1; cb >= 0; --cb) { const int nk = (NCP - 64 * cb) < 64 ? (NCP - 64 * cb) : 64;
        __syncthreads(); nsa_put(C, kr, vr); __syncthreads();
        if (cb > 0) FETCH_C(cb - 1);
        int khi = cmax - 64 * cb; if (khi > nk - 1) khi = nk - 1;
        f16v s[2]; nsa_scores(C, qf, 0, khi, -slope2 * (float)(qpos - 31 - 1024 * cb), 16.f * slope2, s);
#pragma unroll
        for (int t = 0; t < 2; ++t)
#pragma unroll
            for (int a = 0; a < 4; ++a) { float p[4];
#pragma unroll
                for (int j = 0; j < 4; ++j) { float x = ex2(s[t][4 * a + j] - m) * invl; x += __shfl_xor(x, 1); x += __shfl_xor(x, 2); x += __shfl_xor(x, 4); p[j] = x; }
                if (g == 0) { const int grp = 16 * cb + 8 * t + 2 * a + hi; GS[tok * 128 + grp] = ((p[0] + p[1]) + p[2]) + p[3]; LS[tok * 128 + grp] = p[3]; } } } }
    __syncthreads();
    for (int t4 = 0; t4 < 4; ++t4) { const int tk = 4 * w + t4, qp = q0 + tk, qblk = qp >> 6;
        bool cand[2], forced[2]; unsigned u[2];
#pragma unroll
        for (int r = 0; r < 2; ++r) { const int blk = lane + 64 * r; const bool valid = blk <= qblk; const bool fz = blk == 0 || blk == qblk || blk == qblk - 1;
            const float scv = GS[tk * 128 + blk] + (blk > 0 ? LS[tk * 128 + blk - 1] : 0.f);
            forced[r] = valid && fz; cand[r] = valid && !fz; u[r] = cand[r] ? __float_as_uint(scv) : 0u; }
        const int nforced = qblk == 0 ? 1 : (qblk == 1 ? 2 : 3), need = SLCT - nforced;
        const int ncand = __popcll(__ballot(cand[0])) + __popcll(__ballot(cand[1]));
        bool sel[2];
        if (ncand <= need) { sel[0] = forced[0] || cand[0]; sel[1] = forced[1] || cand[1]; }
        else { unsigned T = 0u;
            for (int bit = 30; bit >= 0; --bit) { const unsigned c = T | (1u << bit); const int cnt = __popcll(__ballot(cand[0] && u[0] >= c)) + __popcll(__ballot(cand[1] && u[1] >= c)); if (cnt >= need) T = c; }
            const bool gt0 = cand[0] && u[0] > T, gt1 = cand[1] && u[1] > T, eq0 = cand[0] && u[0] == T, eq1 = cand[1] && u[1] == T;
            const int rem = need - (__popcll(__ballot(gt0)) + __popcll(__ballot(gt1)));
            const unsigned long long be0 = __ballot(eq0), be1 = __ballot(eq1), lt = (1ull << lane) - 1ull;
            const int i0 = __popcll(be0 & lt), i1 = __popcll(be0) + __popcll(be1 & lt);
            sel[0] = forced[0] || gt0 || (eq0 && i0 < rem); sel[1] = forced[1] || gt1 || (eq1 && i1 < rem); }
        const unsigned long long b0 = __ballot(sel[0]), b1 = __ballot(sel[1]);
        if (lane == 0) { SEL[tk * 4 + 0] = (unsigned)b0; SEL[tk * 4 + 1] = (unsigned)(b0 >> 32); SEL[tk * 4 + 2] = (unsigned)b1; SEL[tk * 4 + 3] = (unsigned)(b1 >> 32); } }
    __syncthreads();
    if (C.tid < 4) { unsigned o = 0u; for (int t = 0; t < 32; ++t) o |= SEL[t * 4 + C.tid]; UNI[C.tid] = o; }
    __syncthreads();
    const unsigned sw0 = SEL[tok * 4 + 0], sw1 = SEL[tok * 4 + 1], sw2 = SEL[tok * 4 + 2], sw3 = SEL[tok * 4 + 3];
    const unsigned un0 = UNI[0], un1 = UNI[1], un2 = UNI[2], un3 = UNI[3];
    NP_INIT();
    { const unsigned un[4] = {un0, un1, un2, un3};
#define FETCH_S(b_) nsa_fetch(C, A.KSL + (size_t)(64 * (b_)) * 128 + n * 64, A.VSL + (size_t)(64 * (b_)) * 128 + n * 64, 128, 64, kr, vr)
      int blk = prev_bit(un, 128);
      if (blk >= 0) FETCH_S(blk);
      while (blk >= 0) {
        __syncthreads(); nsa_put(C, kr, vr); __syncthreads();
        const int nb = prev_bit(un, blk); if (nb >= 0) FETCH_S(nb);
        const unsigned mw = blk < 32 ? sw0 : (blk < 64 ? sw1 : (blk < 96 ? sw2 : sw3));
        int khi = ((mw >> (blk & 31)) & 1u) ? qpos - 64 * blk : -1; if (khi > 63) khi = 63;
        nsa_block(C, qf, 0, khi, -slope2 * (float)(qpos - 64 * blk), slope2, m, l, O);
        blk = nb; } }
    NP_FIN(1);
    NP_INIT();
    { int kb0 = q0 - (WIN - 1); if (kb0 < 0) kb0 = 0; kb0 >>= 6;
#define FETCH_W(b_) nsa_fetch(C, A.KWN + (size_t)(64 * (b_)) * 128 + n * 64, A.VWN + (size_t)(64 * (b_)) * 128 + n * 64, 128, 64, kr, vr)
      FETCH_W((q0 + 31) >> 6);
      for (int kb = (q0 + 31) >> 6; kb >= kb0; --kb) {
        __syncthreads(); nsa_put(C, kr, vr); __syncthreads();
        if (kb > kb0) FETCH_W(kb - 1);
        int klo = qpos - (WIN - 1) - 64 * kb; if (klo < 0) klo = 0; int khi = qpos - 64 * kb; if (khi > 63) khi = 63;
        nsa_block(C, qf, klo, khi, -slope2 * (float)(qpos - 64 * kb), slope2, m, l, O); } }
    NP_FIN(2);
    bf16* orow = A.ONSA + (size_t)qpos * 1024 + head * 64;
#pragma unroll
    for (int dt = 0; dt < 2; ++dt)
#pragma unroll
        for (int a = 0; a < 4; ++a) { const int rb = (dt * 16 + 4 * a) * 64; u2 wv; wv.x = cvtpk(OA[rb], OA[rb + 64]); wv.y = cvtpk(OA[rb + 128], OA[rb + 192]); *(u2*)(orow + 32 * dt + 8 * a + 4 * hi) = wv; }
    __syncthreads();
#undef NP_INIT
#undef NP_FIN
#undef FETCH_C
#undef FETCH_S
#undef FETCH_W
}

struct NsaS { const bf16* QN; const float* KVO; const float* WINF; const float* NG; const float* cache; const float* cwin; const int* pt; const float* kcs; const float* vcs; bf16* ONSA; };
constexpr int SL_MW = 0, SL_LW = 2048, SL_GS = 4096, SL_LS = 6144, SL_SEL = 8192, SL_LIST = 8256, SL_CNT = 8416, SL_ROW = 8448, SL_KT = 12544, SL_VT = SL_KT + 8 * 4608, SL_END = SL_VT + 8 * 5120, SL_OW = SL_KT;
static_assert(SL_END <= RING_BYTES && SL_OW + 8 * 8192 <= SL_END, "nsa sample lds");
__device__ __forceinline__ bool ns_rows(const Ctx& C, const NsaS& A, int mode, int j, int b, int n, int slot, const float*& kp, const float*& vp) {
    if (mode == 0) { if (slot >= NCS) return false; kp = A.kcs + ((size_t)(b * 2 + n) * NCS + slot) * 64; vp = A.vcs + ((size_t)(b * 2 + n) * NCS + slot) * 64; return true; }
    if (mode == 1) { const LAS int* LIST = (const LAS int*)(C.lds + SL_LIST); const int cnt = *(const LAS int*)(C.lds + SL_CNT); const int e = 4 * j + (slot >> 6), kk = slot & 63;
        if (e >= cnt) return false; const int blk = LIST[e];
        if (blk < 32) { const float* base = A.cache + ((size_t)(A.pt[b * 16 + (blk >> 1)] * 128 + (blk & 1) * 64 + kk) * 4) * 128 + n * 64; kp = base + 256; vp = base + 384; return true; }
        if (kk >= DS) return false; const float* base = A.KVO + (size_t)(TP + b * 4 + kk) * 512 + n * 64; kp = base + 256; vp = base + 384; return true; }
    const int wi = 256 * j + slot;
    if (wi < 512) { const float* base = A.cwin + ((size_t)b * 512 + wi) * 256 + n * 64; kp = base; vp = base + 128; return true; }
    if (wi < 512 + DS) { const float* base = A.WINF + (size_t)(TP + b * 4 + wi - 512) * 256 + n * 64; kp = base; vp = base + 128; return true; }
    return false;
}
__device__ __forceinline__ void ns_stage(const Ctx& C, const NsaS& A, int mode, int j, int b, int n) {
    LAS unsigned long long* RK = (LAS unsigned long long*)(C.lds + SL_ROW); LAS unsigned long long* RV = RK + 256;
    if (C.tid < 256) { const float* kp = nullptr; const float* vp = nullptr; const bool ok = ns_rows(C, A, mode, j, b, n, C.tid, kp, vp); RK[C.tid] = ok ? (unsigned long long)kp : 0ull; RV[C.tid] = ok ? (unsigned long long)vp : 0ull; }
    __syncthreads();
    { const int slot = C.tid >> 1, half = C.tid & 1; const float* kp = (const float*)RK[slot];
      LAS bf16* dst = (LAS bf16*)(C.lds + SL_KT + (slot >> 5) * 4608) + (slot & 31) * 72 + 32 * half;
      f4 x[8];
#pragma unroll
      for (int i = 0; i < 8; ++i) x[i] = kp ? *(const f4*)(kp + 32 * half + 4 * i) : (f4){0.f, 0.f, 0.f, 0.f};
#pragma unroll
      for (int i = 0; i < 4; ++i) { v4u o; o.x = cvtpk(x[2 * i].x, x[2 * i].y); o.y = cvtpk(x[2 * i].z, x[2 * i].w); o.z = cvtpk(x[2 * i + 1].x, x[2 * i + 1].y); o.w = cvtpk(x[2 * i + 1].z, x[2 * i + 1].w); *(LAS v4u*)(dst + 8 * i) = o; } }
    { const int slot = C.tid & 255, dq = C.tid >> 8; const float* vp = (const float*)RV[slot];
      LAS bf16* dst = (LAS bf16*)(C.lds + SL_VT + (slot >> 5) * 5120) + (32 * dq) * 40 + (slot & 31);
      f4 x[8];
#pragma unroll
      for (int i = 0; i < 8; ++i) x[i] = vp ? *(const f4*)(vp + 32 * dq + 4 * i) : (f4){0.f, 0.f, 0.f, 0.f};
#pragma unroll
      for (int i = 0; i < 8; ++i) { dst[(4 * i) * 40] = (bf16)f2bf(x[i].x); dst[(4 * i + 1) * 40] = (bf16)f2bf(x[i].y); dst[(4 * i + 2) * 40] = (bf16)f2bf(x[i].z); dst[(4 * i + 3) * 40] = (bf16)f2bf(x[i].w); } }
}
__device__ __forceinline__ void nsa_sample_unit(const Ctx& C, const NsaS& A, int b, int n) {
    int lane = C.lane; asm volatile("" : "+v"(lane));
    const int w = C.wave, q = lane & 31, hi = lane >> 5, tl = q >> 3, g = q & 7, head = n * 8 + g, qpos = PASTL + tl, mrow = TP + 4 * b + tl;
    const LAS bf16* KTw = (const LAS bf16*)(C.lds + SL_KT + w * 4608); const LAS bf16* VTw = (const LAS bf16*)(C.lds + SL_VT + w * 5120);
    LAS float* MW = (LAS float*)(C.lds + SL_MW); LAS float* LW = (LAS float*)(C.lds + SL_LW); LAS float* GS = (LAS float*)(C.lds + SL_GS); LAS float* LS = (LAS float*)(C.lds + SL_LS);
    LAS unsigned* SEL = (LAS unsigned*)(C.lds + SL_SEL); LAS int* LIST = (LAS int*)(C.lds + SL_LIST); LAS int* CNT = (LAS int*)(C.lds + SL_CNT); LAS float* OW = (LAS float*)(C.lds + SL_OW);
    const float slope2 = exp2f(-0.5f * (float)(head + 1)) * LOG2E;
    bfx8 qf[4];
#pragma unroll
    for (int ks = 0; ks < 4; ++ks) qf[ks] = *(const bfx8*)(A.QN + (size_t)mrow * 1024 + head * 64 + 16 * ks + 8 * hi);
    const float* gates = A.NG + (size_t)mrow * 48 + head * 3;
    float acc4[4] = {0.f, 0.f, 0.f, 0.f}; f16v O[2]; float m, l;
#define NS_INIT() do { m = -1e30f; l = 0.f; O[0] = (f16v){0.f, 0.f, 0.f, 0.f, 0.f, 0.f, 0.f, 0.f, 0.f, 0.f, 0.f, 0.f, 0.f, 0.f, 0.f, 0.f}; O[1] = O[0]; } while (0)
#define NS_MERGE(br) do { MW[w * 64 + lane] = m; LW[w * 64 + lane] = l; _Pragma("unroll") for (int dt = 0; dt < 2; ++dt) _Pragma("unroll") for (int r = 0; r < 16; ++r) OW[(w * 32 + dt * 16 + r) * 64 + lane] = O[dt][r]; \
        __syncthreads(); float M_ = -1e30f; _Pragma("unroll") for (int w2 = 0; w2 < 8; ++w2) M_ = fmaxf(M_, MW[w2 * 64 + lane]); float L_ = 0.f, o_[4] = {0.f, 0.f, 0.f, 0.f}; \
        _Pragma("unroll") for (int w2 = 0; w2 < 8; ++w2) { const float sc_ = ex2(MW[w2 * 64 + lane] - M_); L_ += (LW[w2 * 64 + lane] + LW[w2 * 64 + (lane ^ 32)]) * sc_; \
            _Pragma("unroll") for (int r = 0; r < 4; ++r) o_[r] += OW[(w2 * 32 + 4 * w + r) * 64 + lane] * sc_; } \
        const float gs_ = gates[br] / fmaxf(L_, 1e-30f); _Pragma("unroll") for (int r = 0; r < 4; ++r) acc4[r] += o_[r] * gs_; __syncthreads(); } while (0)
    __syncthreads();
    for (int i = C.tid; i < 1024; i += NTHR) GS[i] = 0.f;
    ns_stage(C, A, 0, 0, b, n);
    __syncthreads();
    { int khi = (NCS - 1) - 32 * w; if (khi > 31) khi = 31; const float base = -slope2 * (float)(qpos - 31 - 512 * w), inc = 16.f * slope2;
      NS_INIT(); nsa_block_t<1, 40>(KTw, VTw, lane, qf, 0, khi, base, inc, m, l, O);
      MW[w * 64 + lane] = m; LW[w * 64 + lane] = l;
      __syncthreads();
      float M_ = -1e30f;
#pragma unroll
      for (int w2 = 0; w2 < 8; ++w2) M_ = fmaxf(M_, MW[w2 * 64 + lane]);
      float L_ = 0.f;
#pragma unroll
      for (int w2 = 0; w2 < 8; ++w2) L_ += (LW[w2 * 64 + lane] + LW[w2 * 64 + (lane ^ 32)]) * ex2(MW[w2 * 64 + lane] - M_);
      const float invl = 1.f / fmaxf(L_, 1e-30f);
      f16v s[1]; nsa_scores_t<1>(KTw, lane, qf, 0, khi, base, inc, s);
#pragma unroll
      for (int a = 0; a < 4; ++a) { float p[4];
#pragma unroll
          for (int jj = 0; jj < 4; ++jj) { float x = ex2(s[0][4 * a + jj] - M_) * invl; x += __shfl_xor(x, 1); x += __shfl_xor(x, 2); x += __shfl_xor(x, 4); p[jj] = x; }
          if (g == 0) { const int grp = 8 * w + 2 * a + hi; GS[tl * 128 + grp] = ((p[0] + p[1]) + p[2]) + p[3]; LS[tl * 128 + grp] = p[3]; } }
      __syncthreads();
      NS_MERGE(0); }
    if (w == 0) {
        unsigned long long uni = 0ull;
#pragma unroll 1
        for (int t4 = 0; t4 < 4; ++t4) { const int blk = lane; const bool valid = blk < NSS, fz = blk == 0 || blk == NSS - 1 || blk == NSS - 2; const bool cand = valid && !fz, forced = valid && fz;
            const float scv = valid ? GS[t4 * 128 + blk] + (blk > 0 ? LS[t4 * 128 + blk - 1] : 0.f) : 0.f; const unsigned u = cand ? __float_as_uint(scv) : 0u;
            const int need = SLCT - 3; unsigned T = 0u;
            for (int bit = 30; bit >= 0; --bit) { const unsigned c = T | (1u << bit); if (__popcll(__ballot(cand && u >= c)) >= need) T = c; }
            const bool gt = cand && u > T, eq = cand && u == T; const int rem = need - __popcll(__ballot(gt)); const unsigned long long be = __ballot(eq), lt = (1ull << lane) - 1ull;
            const bool sel = forced || gt || (eq && __popcll(be & lt) < rem); const unsigned long long bs = __ballot(sel);
            if (lane == 0) { SEL[t4 * 2] = (unsigned)bs; SEL[t4 * 2 + 1] = (unsigned)(bs >> 32); } uni |= bs; }
        const bool on = (uni >> lane) & 1ull; const int pos = __popcll(uni & ((1ull << lane) - 1ull)); if (on) LIST[pos] = lane; if (lane == 0) CNT[0] = __popcll(uni);
    }
    __syncthreads();
    { const int cnt = CNT[0]; const unsigned long long mysel = (unsigned long long)SEL[tl * 2] | ((unsigned long long)SEL[tl * 2 + 1] << 32);
      NS_INIT();
#pragma unroll 1
      for (int j = 0; 4 * j < cnt; ++j) { ns_stage(C, A, 1, j, b, n); __syncthreads();
          const int e = 4 * j + (w >> 1), sub = w & 1; int khi = -1, blk = 0;
          if (e < cnt) { blk = LIST[e]; if ((mysel >> blk) & 1ull) khi = blk < 32 ? 31 : (sub == 0 ? (tl < DS - 1 ? tl : DS - 1) : -1); }
          nsa_block_t<1, 40>(KTw, VTw, lane, qf, 0, khi, -slope2 * (float)(qpos - 64 * blk - 32 * sub), slope2, m, l, O);
          __syncthreads(); }
      NS_MERGE(1); }
    { NS_INIT();
#pragma unroll 1
      for (int j = 0; j < 3; ++j) { ns_stage(C, A, 2, j, b, n); __syncthreads();
          const int w0 = 256 * j + 32 * w; int klo = tl + 1 - w0; if (klo < 0) klo = 0; int khi = 512 + tl - w0; if (khi > 31) khi = 31;
          nsa_block_t<1, 40>(KTw, VTw, lane, qf, klo, khi, -slope2 * (float)(qpos - (PASTL - 512) - w0), slope2, m, l, O);
          __syncthreads(); }
      NS_MERGE(2); }
    { u2 wv; wv.x = cvtpk(acc4[0], acc4[1]); wv.y = cvtpk(acc4[2], acc4[3]); *(u2*)(A.ONSA + (size_t)mrow * 1024 + head * 64 + 32 * (w >> 2) + 8 * (w & 3) + 4 * hi) = wv; }
#undef NS_INIT
#undef NS_MERGE
}

__device__ __forceinline__ void cmp_convert_cache(const Ctx& C, const float* cache, const int* pt, bf16* CA) {
    const size_t NIT = (size_t)DB * 2048 * 32, stride = (size_t)C.G * NTHR;
    for (size_t i0 = (size_t)C.bid * NTHR + C.tid; i0 < NIT; i0 += 4 * stride) {
        f4 a[4], c[4]; size_t dsto[4]; bool ok[4];
#pragma unroll
        for (int k = 0; k < 4; ++k) { const size_t i = i0 + k * stride; ok[k] = i < NIT; const size_t ii = ok[k] ? i : 0;
            const int d8 = (int)(ii & 7), n = (int)(ii >> 3) & 1, type = (int)(ii >> 4) & 1; const size_t bp = ii >> 5; const int pos = (int)(bp & 2047), b = (int)(bp >> 11);
            const float* src = cache + ((size_t)(pt[b * 16 + (pos >> 7)] * 128 + (pos & 127)) * 4 + type) * 128 + n * 64 + 8 * d8;
            a[k] = *(const f4*)src; c[k] = *(const f4*)(src + 4); dsto[k] = ((size_t)((type * 128 + b) * 2 + n) * 2048 + pos) * 64 + 8 * d8; }
#pragma unroll
        for (int k = 0; k < 4; ++k) if (ok[k]) { v4u o; o.x = pk2(a[k].x, a[k].y); o.y = pk2(a[k].z, a[k].w); o.z = pk2(c[k].x, c[k].y); o.w = pk2(c[k].z, c[k].w); *(v4u*)(CA + dsto[k]) = o; }
    }
}
__device__ __forceinline__ void cmp_stage2(int widx, int nw, int lane, const bf16* HID, const bf16* W2T, float* KCS_, float* VCS_, bf16* KC16_, bf16* VC16_) {
    const int fr = lane & 15, kg = lane >> 4;
    for (int it = widx; it < CMP_ROWS / 16; it += nw) { const int r0 = 16 * it; const bool smp = r0 < CMP_ROWS_S;
        const int type = smp ? (r0 >= CMP_ROWS_S / 2) : ((r0 - CMP_ROWS_S) >= CMP_ROWS_P / 2);
        pg8::f32x4 acc[4];
#pragma unroll
        for (int nt = 0; nt < 4; ++nt) acc[nt] = (pg8::f32x4){0.f, 0.f, 0.f, 0.f};
#pragma unroll
        for (int ks = 0; ks < 8; ++ks) { const bfx8 a = *(const bfx8*)(HID + (size_t)(r0 + fr) * 256 + 32 * ks + 8 * kg);
#pragma unroll
            for (int nt = 0; nt < 4; ++nt) { const bfx8 b = *(const bfx8*)(W2T + ((size_t)type * 64 + 16 * nt + fr) * 256 + 32 * ks + 8 * kg); acc[nt] = __builtin_amdgcn_mfma_f32_16x16x32_bf16(a, b, acc[nt], 0, 0, 0); } }
#pragma unroll
        for (int rr = 0; rr < 4; ++rr) { const int r = r0 + 4 * kg + rr;
            if (smp) { const int c = r & 127, bn = (r >> 7) & 255; if (c < NCS) { float* dst = (type ? VCS_ : KCS_) + ((size_t)bn * NCS + c) * 64;
#pragma unroll
                    for (int nt = 0; nt < 4; ++nt) dst[16 * nt + fr] = acc[nt][rr]; } }
            else { const int rp = r - CMP_ROWS_S, c = rp & 511, n = (rp >> 9) & 1; if (c < NCP) { bf16* dst = (type ? VC16_ : KC16_) + ((size_t)n * 512 + c) * 64;
#pragma unroll
                    for (int nt = 0; nt < 4; ++nt) dst[16 * nt + fr] = (bf16)f2bf(acc[nt][rr]); } } }
    }
}

__device__ __forceinline__ float sgm(float x) { return __builtin_amdgcn_rcpf(1.f + __expf(-x)); }
__device__ __forceinline__ void mix_sample_row(const bf16* ga, const bf16* gb, const float* slab, bf16* mix, int lane) {
#pragma unroll 2
    for (int j = 0; j < 8; ++j) { const int idx = lane + 64 * j; f4 pacc = ((const f4*)slab)[idx], qacc = ((const f4*)slab)[idx + 4 * (SLABSZ / 4)];
#pragma unroll
        for (int k = 1; k < 4; ++k) { pacc += ((const f4*)slab)[idx + (size_t)k * (SLABSZ / 4)]; qacc += ((const f4*)slab)[idx + (size_t)(4 + k) * (SLABSZ / 4)]; }
        const f4 a = ld4bf(ga + 4 * idx), b = ld4bf(gb + 4 * idx);
        const f4 r = (f4){sgm(a.x) * pacc.x + sgm(b.x) * qacc.x, sgm(a.y) * pacc.y + sgm(b.y) * qacc.y, sgm(a.z) * pacc.z + sgm(b.z) * qacc.z, sgm(a.w) * pacc.w + sgm(b.w) * qacc.w};
        ((unsigned long long*)mix)[idx] = (unsigned long long)pk2(r.x, r.y) | ((unsigned long long)pk2(r.z, r.w) << 32); }
}

__device__ __forceinline__ void win_copy(const float* cache_win, float* wins, size_t tix, size_t nthr) {
    const size_t NF = (size_t)DB * 508 * 64;
    for (size_t i0 = tix; i0 < NF; i0 += 4 * nthr) { f4 v[4];
#pragma unroll
        for (int k = 0; k < 4; ++k) { const size_t i = i0 + k * nthr; if (i < NF) { const size_t b = i / (508 * 64), r = i % (508 * 64); v[k] = ((const f4*)cache_win)[b * 512 * 64 + 4 * 64 + r]; } }
#pragma unroll
        for (int k = 0; k < 4; ++k) { const size_t i = i0 + k * nthr; if (i < NF) { const size_t b = i / (508 * 64), r = i % (508 * 64); ((f4*)wins)[b * 512 * 64 + r] = v[k]; } } }
}
constexpr int NPHASE = 15;
#if PROBE_MASK
#define PSUB(id, ...) do { __syncthreads(); const unsigned long long ts_ = __builtin_amdgcn_s_memrealtime(); __VA_ARGS__ __syncthreads(); if (PROBE_SUB == (id)) pr_acc += __builtin_amdgcn_s_memrealtime() - ts_; } while (0)
#else
#define PSUB(id, ...) do { __VA_ARGS__ } while (0)
#endif
struct Args { const void* in[30]; float* out; unsigned char* ws; int ph_lo, ph_hi; };
__global__ void __launch_bounds__(NTHR, 2) mk_fwd(Args args) {
    extern __shared__ __attribute__((aligned(16))) unsigned char lds_raw[];
#define MKCTX() Ctx C; C.lds = (LAS unsigned char*)lds_raw; C.tid = threadIdx.x; asm volatile("" : "+v"(C.tid)); C.lane = C.tid & 63; C.wave = __builtin_amdgcn_readfirstlane(C.tid >> 6); \
    C.G = gridDim.x; C.bid = blockIdx.x; C.gw = C.bid * NWAVES + C.wave; C.NGW = C.G * NWAVES;
    LAS unsigned char* const lds0 = (LAS unsigned char*)lds_raw;
    unsigned char* ws = args.ws; float* out = args.out;
    gu32* ctl = (gu32*)(ws + WS_CTL);
    volatile LAS unsigned* MISC = (volatile LAS unsigned*)(lds0 + MISC_OFF);
    for (int u = threadIdx.x; u < (LDS_BYTES - LDSCTL_OFF) / 4; u += NTHR) ((LAS unsigned*)(lds0 + LDSCTL_OFF))[u] = 0u;
    __syncthreads();
    const int lo = args.ph_lo, hi = args.ph_hi;
    XcdBarrier bar; bar.bar = (unsigned*)(ctl + CW_BAR); bar.x = 0; bar.st = nullptr;
    if (hi - lo > 1) bar = xcd_barrier_post((unsigned*)(ctl + CW_BAR), MISC + 8);
#define IN(k) (lo <= (k) && (k) < hi)
#if PROBE_MASK
    unsigned long long pr_t = __builtin_amdgcn_s_memrealtime(), pr_acc = 0ull;
#define SEAM(k) do { if (IN(k) && IN((k) + 1)) xcd_barrier(bar); { const unsigned long long t_ = __builtin_amdgcn_s_memrealtime(); if ((PROBE_MASK >> (k)) & 1) pr_acc += t_ - pr_t; pr_t = t_; } } while (0)
#else
#define SEAM(k) do { if (IN(k) && IN((k) + 1)) xcd_barrier(bar); } while (0)
#endif
#define x_p ((const float*)args.in[0])
#define x_s ((const float*)args.in[1])
#define cache_kv ((const float*)args.in[2])
#define cache_win ((const float*)args.in[3])
#define state_hgrn ((const float*)args.in[4])
#define page_table ((const int*)args.in[5])
#define n_pre1 ((const float*)args.in[6])
#define n_post1 ((const float*)args.in[7])
#define n_pre2 ((const float*)args.in[11])
#define n_post2 ((const float*)args.in[12])
#define n_pre3 ((const float*)args.in[25])
#define n_post3 ((const float*)args.in[26])
#define hg_lb ((const float*)args.in[14])
#define hg_gnorm ((const float*)args.in[15])
#define W1GU ((bf16*)(ws + WS_W1GU))
#define W1D ((bf16*)(ws + WS_W1D))
#define W2GU ((bf16*)(ws + WS_W2GU))
#define W2D ((bf16*)(ws + WS_W2D))
#define WINt ((bf16*)(ws + WS_WIN))
#define WPH ((bf16*)(ws + WS_WPH))
#define WPN ((bf16*)(ws + WS_WPN))
#define WOt ((bf16*)(ws + WS_WO))
#define XN ((bf16*)(ws + WS_XN))
#define HB ((bf16*)(ws + WS_HB))
#define Y ((bf16*)(ws + WS_Y))
#define LOGF ((float*)(ws + WS_LOGF))
#define WINF ((float*)(ws + WS_WINF))
#define NG ((float*)(ws + WS_NG))
#define GA ((bf16*)(ws + WS_GA))
#define GB ((bf16*)(ws + WS_GB))
#define KCS ((float*)(ws + WS_KCS))
#define VCS ((float*)(ws + WS_VCS))
#define CB ((float*)(ws + WS_CB))
#define OHR ((float*)(ws + WS_OHR))
#define OHG ((bf16*)(ws + WS_OHG))
#define ONSA ((bf16*)(ws + WS_ONSA))
#define T1 ((bf16*)(ws + WS_T1))
#define MIX ((bf16*)(ws + WS_MIX))
#define UT ((float*)(ws + WS_UT))
#define DD ((float*)(ws + WS_DD))
#define SP ((bf16*)(ws + WS_SP))
#define CA ((bf16*)(ws + WS_CA))
#define HID ((bf16*)(ws + WS_HID))
#define W1C ((bf16*)(ws + WS_W1C))
#define W2C ((bf16*)(ws + WS_W2C))
#define SLAB ((float*)(ws + WS_SLAB))
#define RS ((float*)(ws + WS_RS))
#define QH16 ((bf16*)(ws + WS_QH16))
#define KH16 ((bf16*)(ws + WS_KH16))
#define VH16 ((bf16*)(ws + WS_VH16))
#define GH16 ((bf16*)(ws + WS_GH16))
#define QN16 ((bf16*)(ws + WS_QN16))
#define KSL ((bf16*)(ws + WS_KSL))
#define VSL ((bf16*)(ws + WS_VSL))
#define KWN ((bf16*)(ws + WS_KWN))
#define VWN ((bf16*)(ws + WS_VWN))
#define KC16 ((bf16*)(ws + WS_KC16))
#define VC16 ((bf16*)(ws + WS_VC16))
#define KVO ((float*)(out + O_KV))
#define WINP ((float*)(out + O_WINP))
#define WINS ((float*)(out + O_WINS))
    if (IN(0)) { MKCTX();
        if ((C.gw & 15) == 0 && (C.gw >> 4) < 128) { const int task = C.gw >> 4, type = task >> 6, j4 = task & 63;   const float* pos = (const float*)args.in[type ? 19 : 16]; const float* w1 = (const float*)args.in[type ? 20 : 17];
            f4 s = (f4){0.f, 0.f, 0.f, 0.f};
#pragma unroll 8
            for (int k = 0; k < 32; ++k) { const int i = C.lane + 64 * k; s += *(const f4*)(w1 + (size_t)i * 256 + 4 * j4) * pos[i]; }
            s.x = wsum(s.x); s.y = wsum(s.y); s.z = wsum(s.z); s.w = wsum(s.w);
            if (C.lane == 0) *(f4*)(CB + type * 256 + 4 * j4) = s; }
        PSUB(11, tr_run(args.in, ws, (LAS unsigned*)(C.lds + C.wave * 16384), 0, 7, C.gw, C.NGW, C.lane); );
        for (int i = C.bid * NTHR + C.tid; i < (DINP - DIN) * DM / 8; i += C.G * NTHR) ((v4u*)(WINt + (size_t)DIN * DM))[i] = (v4u){0u, 0u, 0u, 0u};
        PSUB(12, cmp_convert_cache(C, cache_kv, page_table, CA); );
        PSUB(13, for (int m = C.gw; m < M; m += C.NGW) rms_row_to_bf16(m < TP ? x_p + (size_t)m * DM : x_s + (size_t)(m - TP) * DM, n_pre1, XN + (size_t)m * DM, C.lane); );
    }
    SEAM(0);
    if (IN(1)) { MKCTX(); pg8::Gemm g{XN, W1GU, M, 2 * FF, DM, DM, DM}; pg8::StaticOrder S; S.init(M, 2 * FF, C.G, C.bid); pg8::EpiSwiglu E{HB, FF};
        pg8::gemm_phase<pg8::EpiSwiglu, pg8::StaticOrder, true>(C.lds + RING_OFF, g, S, E);
        { constexpr int rem = ((M / 256) * (2 * FF / 256)) % 256;
          if (C.G == 256 && C.bid >= rem) tr_run(args.in, ws, (LAS unsigned*)(C.lds + C.wave * 16384), 7, 8, (C.bid - rem) * NWAVES + C.wave, (256 - rem) * NWAVES, C.lane);
          else if (C.G != 256) tr_run(args.in, ws, (LAS unsigned*)(C.lds + C.wave * 16384), 7, 8, C.gw, C.NGW, C.lane); } }
    SEAM(1);
    if (IN(2)) { MKCTX(); pg8::SplitSched S; S.S.init(TP, DM, C.G, C.bid); S.A = (const char*)HB; S.B = (const char*)W1D; S.lda = FF; S.ldb = FF; S.K = FF; S.NS = 16; S.bid = C.bid;
        pg8::EpiDual<pg8::EpiY16> E{pg8::EpiY16{Y, DM}, SLAB}; pg8::gemm_phase_g<pg8::EpiDual<pg8::EpiY16>, pg8::SplitSched, true>(C.lds + RING_OFF, FF, FF, S, E); }
    SEAM(2);
    if (IN(3)) { MKCTX(); for (int m = C.gw; m < M; m += C.NGW) norm_mid_row(m < TP ? (const void*)(Y + (size_t)m * DM) : (const void*)(SLAB + (size_t)(m - TP) * DM), m < TP ? x_p + (size_t)m * DM : x_s + (size_t)(m - TP) * DM, nullptr, nullptr, 0.f,
            n_post1, 0.5f, nullptr, n_pre2, XN + (size_t)m * DM, RS + m, C.lane, m < TP ? 0 : 16); }
    SEAM(3);
    if (IN(4)) { MKCTX(); pg8::Gemm g{XN, WINt, M, DINP, DM, DM, DM}; pg8::StaticOrder S; S.init(M, DINP, C.G, C.bid);
        pg8::EpiInProj E{ws, out, hg_lb};
        pg8::gemm_phase<pg8::EpiInProj, pg8::StaticOrder, true>(C.lds + RING_OFF, g, S, E);
        { constexpr int rem = ((M / 256) * (DINP / 256)) % 256;
          if (C.G == 256 && C.bid >= rem) tr_run(args.in, ws, (LAS unsigned*)(C.lds + C.wave * 16384), 8, 10, (C.bid - rem) * NWAVES + C.wave, (256 - rem) * NWAVES, C.lane);
          else if (C.G != 256) tr_run(args.in, ws, (LAS unsigned*)(C.lds + C.wave * 16384), 8, 10, C.gw, C.NGW, C.lane); } }
    SEAM(4);
    if (IN(5)) { MKCTX();
        { pg8::Gemm g{CA, W1C, CMP_ROWS, 512, 2048, 1024, 2048}; pg8::CmpOrder S{C.G, C.bid}; pg8::EpiCmp E{CB, HID};
          pg8::gemm_phase<pg8::EpiCmp, pg8::CmpOrder, true>(C.lds + RING_OFF, g, S, E); }
        if (C.bid >= 8) for (int u = C.bid - 8; u < 8 * HG_NCH; u += C.G - 8) hgrn_A_unit(C, u & 7, u >> 3, LOGF, KH16, VH16, UT, DD);
    }
    SEAM(5);
    if (IN(6)) { MKCTX();
        if (C.wave < 4) { const int widx = C.bid * 4 + C.wave, nw = C.G * 4;
            cmp_stage2(widx, nw, C.lane, HID, W2C, KCS, VCS, KC16, VC16);
            for (int v = widx; v < DB * 64; v += nw) { const int b = v >> 6, h = (v >> 3) & 7, vg2 = v & 7;
                hgrn_seq_pair(TP + b * 4, h, vg2, state_hgrn + (size_t)b * 131072 + (size_t)h * 16384, out + O_HGS + (size_t)b * 131072 + (size_t)h * 16384, QH16, LOGF, KH16, VH16, OHR, C.lane); }
            hgrn_scan(C.bid * 256 + C.tid, C.G * 256, UT, DD, SP, out + O_HGP);
        } else tr_run(args.in, ws, (LAS unsigned*)(C.lds + C.wave * 16384), 10, 14, C.bid * 4 + (C.wave - 4), C.G * 4, C.lane);
    }
    SEAM(6);
    if (IN(7)) { MKCTX();
        for (int m = TP + C.gw; m < M; m += C.NGW) hgrn_finish_row(OHR + (size_t)m * 1024, GH16 + (size_t)m * 1024, hg_gnorm, OHG + (size_t)m * 1024, C.lane);
        NsaP AP{QN16, KSL, VSL, KWN, VWN, KC16, VC16, NG, ONSA};
        NsaS AS{QN16, KVO, WINF, NG, cache_kv, cache_win, page_table, KCS, VCS, ONSA};
        LAS int* qslot = (LAS int*)(C.lds + MISC_OFF + 128);
#define QUEUE_LOOP(word, count, ...) for (;;) { __syncthreads(); if (C.tid == 0) qslot[0] = (int)__hip_atomic_fetch_add(ctl + (word), 1u, __ATOMIC_RELAXED, __HIP_MEMORY_SCOPE_AGENT); __syncthreads(); \
            const int it = qslot[0]; if (it >= (count)) break; __VA_ARGS__ }
        QUEUE_LOOP(CW_Q7, 512, nsa_prompt_unit(C, AP, 255 - (it >> 1), it & 1); )
        QUEUE_LOOP(CW_Q7 + 64, 2 * DB, nsa_sample_unit(C, AS, it >> 1, it & 1); )
        QUEUE_LOOP(CW_Q7 + 128, 8 * HG_NCH, hgrn_B_unit(C, it & 7, it >> 3, QH16, LOGF, KH16, VH16, GH16, hg_gnorm, SP, OHG); )
    }
    SEAM(7);
    if (IN(8)) { MKCTX(); pg8::ProjSched S; S.S.init(TP, DM, C.G, C.bid); S.Ah = (const char*)OHG; S.An = (const char*)ONSA; S.Bh = (const char*)WPH; S.Bn = (const char*)WPN; S.bid = C.bid;
        pg8::EpiProj E{pg8::EpiGate1{GA, T1, DM}, pg8::EpiGate2{GB, T1, MIX, DM}, SLAB}; pg8::gemm_phase_g<pg8::EpiProj, pg8::ProjSched, true>(C.lds + RING_OFF, 1024, 1024, S, E); }
    SEAM(8);
    if (IN(9)) { MKCTX(); for (int m = TP + C.gw; m < M; m += C.NGW) mix_sample_row(GA + (size_t)m * DM, GB + (size_t)m * DM, SLAB + (size_t)(m - TP) * DM, MIX + (size_t)m * DM, C.lane); }
    SEAM(9);
    if (IN(10)) { MKCTX(); pg8::SplitSched S; S.S.init(TP, DM, C.G, C.bid); S.A = (const char*)MIX; S.B = (const char*)WOt; S.lda = DM; S.ldb = DM; S.K = DM; S.NS = 8; S.bid = C.bid;
        pg8::EpiDual<pg8::EpiY16> E{pg8::EpiY16{Y, DM}, SLAB}; pg8::gemm_phase_g<pg8::EpiDual<pg8::EpiY16>, pg8::SplitSched, true>(C.lds + RING_OFF, DM, DM, S, E); }
    SEAM(10);
    if (IN(11)) { MKCTX(); for (int m = C.gw; m < M; m += C.NGW) norm_mid_row(m < TP ? (const void*)(Y + (size_t)m * DM) : (const void*)(SLAB + (size_t)(m - TP) * DM), nullptr, XN + (size_t)m * DM, n_pre2, RS[m],
            n_post2, 1.0f, nullptr, n_pre3, XN + (size_t)m * DM, RS + m, C.lane, m < TP ? 0 : 8); }
    SEAM(11);
    if (IN(12)) { MKCTX(); pg8::Gemm g{XN, W2GU, M, 2 * FF, DM, DM, DM}; pg8::StaticOrder S; S.init(M, 2 * FF, C.G, C.bid); pg8::EpiSwiglu E{HB, FF};
        pg8::gemm_phase<pg8::EpiSwiglu, pg8::StaticOrder, true>(C.lds + RING_OFF, g, S, E);
        { constexpr int rem = ((M / 256) * (2 * FF / 256)) % 256;
          if (C.G == 256 && C.bid >= rem) win_copy(cache_win, WINS, (size_t)(C.bid - rem) * NTHR + C.tid, (size_t)(256 - rem) * NTHR);
          else if (C.G != 256) win_copy(cache_win, WINS, (size_t)C.bid * NTHR + C.tid, (size_t)C.G * NTHR); } }
    SEAM(12);
    if (IN(13)) { MKCTX(); pg8::SplitSched S; S.S.init(TP, DM, C.G, C.bid); S.A = (const char*)HB; S.B = (const char*)W2D; S.lda = FF; S.ldb = FF; S.K = FF; S.NS = 16; S.bid = C.bid;
        pg8::EpiDual<pg8::EpiY16> E{pg8::EpiY16{Y, DM}, SLAB}; pg8::gemm_phase_g<pg8::EpiDual<pg8::EpiY16>, pg8::SplitSched, true>(C.lds + RING_OFF, FF, FF, S, E); }
    SEAM(13);
    if (IN(14)) { MKCTX(); for (int m = C.gw; m < M; m += C.NGW) norm_mid_row(m < TP ? (const void*)(Y + (size_t)m * DM) : (const void*)(SLAB + (size_t)(m - TP) * DM), nullptr, XN + (size_t)m * DM, n_pre3, RS[m],
            n_post3, 0.5f, out + O_Y + (size_t)m * DM, nullptr, nullptr, nullptr, C.lane, m < TP ? 0 : 16); }
#if PROBE_MASK
    { const unsigned long long t_ = __builtin_amdgcn_s_memrealtime(); if ((PROBE_MASK >> 14) & 1) pr_acc += t_ - pr_t;
      if (PROBE_SUB >= 32) pr_acc += ((volatile LAS unsigned long long*)(lds0 + MISC_OFF + 256))[PROBE_SUB - 32];
      if (blockIdx.x == 0) { const unsigned long long t0_ = __builtin_amdgcn_s_memrealtime(); while (__builtin_amdgcn_s_memrealtime() - t0_ < PROBE_K * pr_acc) __builtin_amdgcn_s_sleep(8); } }
#endif
#undef IN
#undef SEAM
#undef MKCTX
#undef QUEUE_LOOP
#undef x_p
#undef x_s
#undef cache_kv
#undef cache_win
#undef state_hgrn
#undef page_table
#undef n_pre1
#undef n_post1
#undef n_pre2
#undef n_post2
#undef n_pre3
#undef n_post3
#undef hg_lb
#undef hg_gnorm
#undef W1GU
#undef W1D
#undef W2GU
#undef W2D
#undef WINt
#undef WPH
#undef WPN
#undef WOt
#undef XN
#undef HB
#undef Y
#undef LOGF
#undef WINF
#undef NG
#undef GA
#undef GB
#undef KCS
#undef VCS
#undef CB
#undef OHR
#undef OHG
#undef ONSA
#undef T1
#undef MIX
#undef UT
#undef DD
#undef SP
#undef CA
#undef HID
#undef W1C
#undef W2C
#undef SLAB
#undef RS
#undef QH16
#undef KH16
#undef VH16
#undef GH16
#undef QN16
#undef KSL
#undef VSL
#undef KWN
#undef VWN
#undef KC16
#undef VC16
#undef KVO
#undef WINP
#undef WINS
}

#ifndef MK_ONE_LAUNCH
#define MK_ONE_LAUNCH 1
#endif
extern "C" void kernel_launch(void* const* d_in, const int* in_sizes, int n_in, void* d_out, int out_size, void* d_ws, size_t ws_size, hipStream_t stream) {
    static int grid = 0;
    if (grid == 0) {
        if (n_in != 30 || out_size != (int)O_END || ws_size < WS_END) { fprintf(stderr, "kernel_launch: unexpected sizes (n_in %d out %d ws %zu)\n", n_in, out_size, ws_size); grid = -1; return; }
        int dev = 0, cus = 0, per_cu = 0;
        if (hipGetDevice(&dev) != hipSuccess || hipDeviceGetAttribute(&cus, hipDeviceAttributeMultiprocessorCount, dev) != hipSuccess) { grid = -1; return; }
        if (hipFuncSetAttribute((const void*)mk_fwd, hipFuncAttributeMaxDynamicSharedMemorySize, LDS_BYTES) != hipSuccess) { fprintf(stderr, "kernel_launch: hipFuncSetAttribute failed\n"); grid = -1; return; }
        if (hipOccupancyMaxActiveBlocksPerMultiprocessor(&per_cu, (const void*)mk_fwd, NTHR, LDS_BYTES) != hipSuccess || per_cu < 1) { fprintf(stderr, "kernel_launch: occupancy query says %d\n", per_cu); }
        (void)hipGetLastError();
        grid = cus;
    }
    if (grid < 0) return;
    (void)hipMemsetAsync((char*)d_ws + WS_CTL, 0, CTL_ZERO_BYTES, stream);
    Args a{};
    for (int i = 0; i < 30; ++i) a.in[i] = d_in[i];
    a.out = (float*)d_out; a.ws = (unsigned char*)d_ws;
#if MK_ONE_LAUNCH
    a.ph_lo = 0; a.ph_hi = NPHASE;
    hipLaunchKernelGGL(mk_fwd, dim3(grid), dim3(NTHR), LDS_BYTES, stream, a);
#else
    for (int p = 0; p < NPHASE; ++p) { a.ph_lo = p; a.ph_hi = p + 1; hipLaunchKernelGGL(mk_fwd, dim3(grid), dim3(NTHR), LDS_BYTES, stream, a); }
#endif
}
```

```cpp
#include <hip/hip_runtime.h>
#include <cstdio>
#include <cstdint>
#ifndef PROBE_MASK
#define PROBE_MASK 0
#endif
#ifndef PROBE_K
#define PROBE_K 1
#endif
#ifndef PROBE_SUB
#define PROBE_SUB 0
#endif
#if PROBE_MASK
#define STAMP(C, id) do { __syncthreads(); if ((C).tid == 0) { volatile __attribute__((address_space(3))) unsigned long long* P_ = (volatile __attribute__((address_space(3))) unsigned long long*)((C).lds + 131072 + 320 + 256); \
    const unsigned long long t_ = __builtin_amdgcn_s_memrealtime(); P_[id] += t_ - P_[0]; P_[0] = t_; } } while (0)
#else
#define STAMP(C, id) do {} while (0)
#endif
namespace pg8 {
#define PG8_LAS __attribute__((address_space(3)))
typedef unsigned short bf16_t;
typedef short bf16x8 __attribute__((ext_vector_type(8)));
typedef float f32x4 __attribute__((ext_vector_type(4)));
typedef unsigned u32x4 __attribute__((ext_vector_type(4)));
constexpr int BM = 256, BK = 64, HALF = 128, HTB = HALF * BK * 2  , STAGE_BYTES = 8 * HTB, NXCD = 8, WGM = 8;

__host__ __device__ __forceinline__ int lds_byte(int r, int c) { const int st = (r >> 4) * 2 + (c >> 5), rr = r & 15, cc = c & 31, ob = rr * 64 + cc * 2; return st * 1024 + (ob ^ (((ob >> 9) & 1) << 5)); }
__host__ __device__ __forceinline__ void stage_rc(int b, int& R, int& C) { const int st = b / 1024, sb = b % 1024, swz = sb ^ (((sb >> 9) & 1) << 5); R = (st >> 1) * 16 + swz / 64; C = (st & 1) * 32 + (swz % 64) / 2; }
__host__ __device__ __forceinline__ int perm32(int rho) { const int n = rho >> 4, i = rho & 15; return 8 * (i >> 2) + 4 * n + (i & 3); }

struct Unit { int pm, pn; };
struct Gemm { const bf16_t* A; const bf16_t* Bt; int M, N, K, lda, ldb; };

struct StaticOrder {
    int nM, nN, nwg, G, c;
    __host__ __device__ void init(int M, int N, int G_, int c_) { nM = M / BM; nN = N / BM; nwg = nM * nN; G = G_; c = c_; }
    __host__ __device__ bool next(int i, Unit& u) const {
        const long L = (long)i * G + c; if (L >= nwg) return false;
        int wgid = (int)L; { const int q = nwg / NXCD, r = nwg % NXCD, xcd = wgid % NXCD, off = wgid / NXCD; wgid = (xcd < r ? xcd * (q + 1) : r * (q + 1) + (xcd - r) * q) + off; }
        const int nig = WGM * nN, gid = wgid / nig, fm = gid * WGM, gsz = (nM - fm) < WGM ? (nM - fm) : WGM;
        u.pm = fm + ((wgid % nig) % gsz); u.pn = (wgid % nig) / gsz; return true;
    }
    __device__ __forceinline__ void a_ready(const Unit&) const {}
    __device__ __forceinline__ void done(const Unit&) const {}
};

typedef float cvt_f32x2 __attribute__((ext_vector_type(2))); typedef __bf16 cvt_bf16x2 __attribute__((ext_vector_type(2)));
__device__ __forceinline__ unsigned cvt_pk_bf16(float lo, float hi) { const cvt_f32x2 v = {lo, hi}; const cvt_bf16x2 b = __builtin_convertvector(v, cvt_bf16x2); return __builtin_bit_cast(unsigned, b); }
typedef float f32x2 __attribute__((ext_vector_type(2)));
template <class Epi, class Sched, bool ALIGN_EPI = false>
__device__ __forceinline__ void gemm_phase(PG8_LAS unsigned char* lds, const Gemm g, const Sched& S, const Epi& E) {
    int tid = threadIdx.x; asm volatile("" : "+v"(tid));
    const int wid = __builtin_amdgcn_readfirstlane(tid >> 6), lane = tid & 63, wr = wid >> 2, wc = wid & 3, fr = lane & 15, fq = lane >> 4;
    const int K = g.K, nt = K / BK;
    unsigned voffA, voffB;
    { int R, C; stage_rc(tid * 16, R, C); const int Rb = Epi::PERM ? ((R & ~31) + perm32(R & 31)) : R; voffA = (unsigned)(R * g.lda + C) * 2u; voffB = (unsigned)(Rb * g.ldb + C) * 2u; }
    const size_t r64A = (size_t)64 * g.lda * 2, r64B = (size_t)64 * g.ldb * 2;
    const size_t kstep = (size_t)(BK * 2);
    const size_t hstepA = (size_t)HALF * g.lda * 2, hstepB = (size_t)HALF * g.ldb * 2;
    const size_t tstepA = 2 * hstepA, tstepB = 2 * hstepB;
    const unsigned ldsw = (unsigned)wid * 1024u;
    const int aoff = lds_byte(wr * 64 + fr, fq * 8), boff = lds_byte(wc * 32 + fr, fq * 8);
#define PG8_SA(b, h) (((b) * 2 + (h)) * HTB)
#define PG8_SB(b, h) ((4 + (b) * 2 + (h)) * HTB)
#define PG8_STAGE(bufoff, gbase, sfx) do { _Pragma("unroll") for (int _i = 0; _i < 2; ++_i) \
        __builtin_amdgcn_global_load_lds((const unsigned*)((const char*)(gbase) + (size_t)_i * r64##sfx + voff##sfx), (PG8_LAS unsigned*)(lds + (bufoff) + ldsw + _i * 8192), 16, 0, 0); } while (0)
#define PG8_LDA(dst, b, h) do { _Pragma("unroll") for (int m = 0; m < 4; ++m) _Pragma("unroll") for (int k = 0; k < 2; ++k) dst[m][k] = *(const PG8_LAS bf16x8*)(lds + PG8_SA(b, h) + aoff + m * 2048 + k * 1024); } while (0)
#define PG8_LDB(dst, b, h) do { _Pragma("unroll") for (int n = 0; n < 2; ++n) _Pragma("unroll") for (int k = 0; k < 2; ++k) dst[n][k] = *(const PG8_LAS bf16x8*)(lds + PG8_SB(b, h) + boff + n * 2048 + k * 1024); } while (0)
#define PG8_MMA(ai, bj, At, Bt) do { __builtin_amdgcn_s_setprio(1); _Pragma("unroll") for (int m = 0; m < 4; ++m) _Pragma("unroll") for (int n = 0; n < 2; ++n) _Pragma("unroll") for (int k = 0; k < 2; ++k) \
        acc[ai][bj][m][n] = __builtin_amdgcn_mfma_f32_16x16x32_bf16(Bt[n][k], At[m][k], acc[ai][bj][m][n], 0, 0, 0); __builtin_amdgcn_s_setprio(0); } while (0)
#define PG8_WAIT_V(n) asm volatile("s_waitcnt vmcnt(" #n ")" ::: "memory")
#define PG8_WAIT_L(n) asm volatile("s_waitcnt lgkmcnt(" #n ")" ::: "memory")
#define PG8_BAR __builtin_amdgcn_s_barrier()
#define PG8_SCHED __builtin_amdgcn_sched_barrier(0)
    Unit cur, nxt; int ui = 0;
    if (!S.next(0, cur)) return;
    f32x4 acc[2][2][4][2];
#pragma unroll
    for (int a = 0; a < 2; ++a)
#pragma unroll
        for (int b = 0; b < 2; ++b)
#pragma unroll
            for (int m = 0; m < 4; ++m)
#pragma unroll
                for (int n = 0; n < 2; ++n) acc[a][b][m][n] = (f32x4){0.f, 0.f, 0.f, 0.f};
    bf16x8 At[4][2], B0[2][2], B1[2][2];
    const char* cA = (const char*)g.A + (size_t)cur.pm * tstepA; const char* cB = (const char*)g.Bt + (size_t)cur.pn * tstepB;
    S.a_ready(cur);
    PG8_STAGE(PG8_SB(0, 0), cB, B); PG8_STAGE(PG8_SB(0, 1), cB + hstepB, B); PG8_STAGE(PG8_SA(0, 0), cA, A); PG8_STAGE(PG8_SA(0, 1), cA + hstepA, A);
    if (wr == 1) PG8_BAR;
    PG8_WAIT_V(2); PG8_BAR;
    PG8_STAGE(PG8_SB(1, 0), cB + kstep, B); PG8_STAGE(PG8_SA(1, 0), cA + kstep, A); PG8_STAGE(PG8_SB(1, 1), cB + hstepB + kstep, B);
    PG8_WAIT_V(6); PG8_BAR;
    for (;;) {
        const bool has_next = S.next(ui + 1, nxt);
        const char* nA = has_next ? (const char*)g.A + (size_t)nxt.pm * tstepA : cA; const char* nB = has_next ? (const char*)g.Bt + (size_t)nxt.pn * tstepB : cB;
        for (int t = 0; t < nt; t += 2) {
            const bool last = (t == nt - 2);
            const char* a1 = cA + (size_t)(t + 1) * kstep;
            const char* a2 = last ? nA : cA + (size_t)(t + 2) * kstep; const char* b2 = last ? nB : cB + (size_t)(t + 2) * kstep;
            const char* a3 = a2 + kstep; const char* b3 = b2 + kstep;
            if (last && has_next) S.a_ready(nxt);
            PG8_LDB(B0, 0, 0); PG8_LDB(B1, 0, 1); PG8_SCHED; PG8_LDA(At, 0, 0); PG8_STAGE(PG8_SA(1, 1), a1 + hstepA, A);
            PG8_WAIT_V(8); PG8_WAIT_L(0); PG8_BAR; PG8_MMA(0, 0, At, B0); PG8_MMA(0, 1, At, B1); PG8_BAR; PG8_SCHED;
            PG8_LDA(At, 0, 1); PG8_STAGE(PG8_SB(0, 0), b2, B); PG8_STAGE(PG8_SB(0, 1), b2 + hstepB, B); PG8_STAGE(PG8_SA(0, 0), a2, A);
            PG8_WAIT_V(8); PG8_WAIT_L(0); PG8_BAR; PG8_MMA(1, 0, At, B0); PG8_MMA(1, 1, At, B1); PG8_BAR; PG8_SCHED;
            PG8_LDB(B0, 1, 0); PG8_LDB(B1, 1, 1); PG8_SCHED; PG8_LDA(At, 1, 0); PG8_STAGE(PG8_SA(0, 1), a2 + hstepA, A);
            PG8_WAIT_V(8); PG8_WAIT_L(0); PG8_BAR; PG8_MMA(0, 0, At, B0); PG8_MMA(0, 1, At, B1); PG8_BAR; PG8_SCHED;
            PG8_LDA(At, 1, 1); PG8_STAGE(PG8_SB(1, 0), b3, B); PG8_STAGE(PG8_SB(1, 1), b3 + hstepB, B); PG8_STAGE(PG8_SA(1, 0), a3, A);
            PG8_WAIT_V(8); PG8_WAIT_L(0); PG8_BAR; PG8_MMA(1, 0, At, B0); PG8_MMA(1, 1, At, B1); PG8_BAR; PG8_SCHED;
        }
        if constexpr (ALIGN_EPI) { if (wr == 0) PG8_BAR; }
        E(acc, cur, wr, wc, fr, fq); S.done(cur);
        if (!has_next) break;
#pragma unroll
        for (int a = 0; a < 2; ++a)
#pragma unroll
            for (int b = 0; b < 2; ++b)
#pragma unroll
                for (int m = 0; m < 4; ++m)
#pragma unroll
                    for (int n = 0; n < 2; ++n) acc[a][b][m][n] = (f32x4){0.f, 0.f, 0.f, 0.f};
        cur = nxt; cA = nA; cB = nB; ++ui;
        if constexpr (ALIGN_EPI) { if (wr == 1) PG8_BAR; }
    }
    PG8_WAIT_V(0);
    if constexpr (!ALIGN_EPI) { if (wr == 0) PG8_BAR; }
    PG8_BAR;
#undef PG8_SA
#undef PG8_SB
#undef PG8_STAGE
#undef PG8_LDA
#undef PG8_LDB
#undef PG8_MMA
#undef PG8_WAIT_V
#undef PG8_WAIT_L
#undef PG8_BAR
#undef PG8_SCHED
}

struct UnitG : Unit { const char* A; const char* B; int nt, kind, aux; };
template <class Epi, class Sched, bool ALIGN_EPI = false>
__device__ __forceinline__ void gemm_phase_g(PG8_LAS unsigned char* lds, int lda, int ldb, const Sched& S, const Epi& E) {
    int tid = threadIdx.x; asm volatile("" : "+v"(tid));
    const int wid = __builtin_amdgcn_readfirstlane(tid >> 6), lane = tid & 63, wr = wid >> 2, wc = wid & 3, fr = lane & 15, fq = lane >> 4;
    unsigned voffA, voffB;
    { int R, C; stage_rc(tid * 16, R, C); const int Rb = Epi::PERM ? ((R & ~31) + perm32(R & 31)) : R; voffA = (unsigned)(R * lda + C) * 2u; voffB = (unsigned)(Rb * ldb + C) * 2u; }
    const size_t r64A = (size_t)64 * lda * 2, r64B = (size_t)64 * ldb * 2;
    const size_t kstep = (size_t)(BK * 2);
    const size_t hstepA = (size_t)HALF * lda * 2, hstepB = (size_t)HALF * ldb * 2;
    const size_t tstepA = 2 * hstepA, tstepB = 2 * hstepB;
    const unsigned ldsw = (unsigned)wid * 1024u;
    const int aoff = lds_byte(wr * 64 + fr, fq * 8), boff = lds_byte(wc * 32 + fr, fq * 8);
#define PG8_SA(b, h) (((b) * 2 + (h)) * HTB)
#define PG8_SB(b, h) ((4 + (b) * 2 + (h)) * HTB)
#define PG8_STAGE(bufoff, gbase, sfx) do { _Pragma("unroll") for (int _i = 0; _i < 2; ++_i) \
        __builtin_amdgcn_global_load_lds((const unsigned*)((const char*)(gbase) + (size_t)_i * r64##sfx + voff##sfx), (PG8_LAS unsigned*)(lds + (bufoff) + ldsw + _i * 8192), 16, 0, 0); } while (0)
#define PG8_LDA(dst, b, h) do { _Pragma("unroll") for (int m = 0; m < 4; ++m) _Pragma("unroll") for (int k = 0; k < 2; ++k) dst[m][k] = *(const PG8_LAS bf16x8*)(lds + PG8_SA(b, h) + aoff + m * 2048 + k * 1024); } while (0)
#define PG8_LDB(dst, b, h) do { _Pragma("unroll") for (int n = 0; n < 2; ++n) _Pragma("unroll") for (int k = 0; k < 2; ++k) dst[n][k] = *(const PG8_LAS bf16x8*)(lds + PG8_SB(b, h) + boff + n * 2048 + k * 1024); } while (0)
#define PG8_MMA(ai, bj, At, Bt) do { __builtin_amdgcn_s_setprio(1); _Pragma("unroll") for (int m = 0; m < 4; ++m) _Pragma("unroll") for (int n = 0; n < 2; ++n) _Pragma("unroll") for (int k = 0; k < 2; ++k) \
        acc[ai][bj][m][n] = __builtin_amdgcn_mfma_f32_16x16x32_bf16(Bt[n][k], At[m][k], acc[ai][bj][m][n], 0, 0, 0); __builtin_amdgcn_s_setprio(0); } while (0)
#define PG8_WAIT_V(n) asm volatile("s_waitcnt vmcnt(" #n ")" ::: "memory")
#define PG8_WAIT_L(n) asm volatile("s_waitcnt lgkmcnt(" #n ")" ::: "memory")
#define PG8_BAR __builtin_amdgcn_s_barrier()
#define PG8_SCHED __builtin_amdgcn_sched_barrier(0)
    UnitG cur, nxt; int ui = 0;
    if (!S.next(0, cur)) return;
    f32x4 acc[2][2][4][2];
#pragma unroll
    for (int a = 0; a < 2; ++a)
#pragma unroll
        for (int b = 0; b < 2; ++b)
#pragma unroll
            for (int m = 0; m < 4; ++m)
#pragma unroll
                for (int n = 0; n < 2; ++n) acc[a][b][m][n] = (f32x4){0.f, 0.f, 0.f, 0.f};
    bf16x8 At[4][2], B0[2][2], B1[2][2];
    const char* cA = cur.A; const char* cB = cur.B;
    S.a_ready(cur);
    PG8_STAGE(PG8_SB(0, 0), cB, B); PG8_STAGE(PG8_SB(0, 1), cB + hstepB, B); PG8_STAGE(PG8_SA(0, 0), cA, A); PG8_STAGE(PG8_SA(0, 1), cA + hstepA, A);
    if (wr == 1) PG8_BAR;
    PG8_WAIT_V(2); PG8_BAR;
    PG8_STAGE(PG8_SB(1, 0), cB + kstep, B); PG8_STAGE(PG8_SA(1, 0), cA + kstep, A); PG8_STAGE(PG8_SB(1, 1), cB + hstepB + kstep, B);
    PG8_WAIT_V(6); PG8_BAR;
    for (;;) {
        const bool has_next = S.next(ui + 1, nxt);
        const char* nA = has_next ? nxt.A : cA; const char* nB = has_next ? nxt.B : cB; const int nt = cur.nt;
        for (int t = 0; t < nt; t += 2) {
            const bool last = (t == nt - 2);
            const char* a1 = cA + (size_t)(t + 1) * kstep;
            const char* a2 = last ? nA : cA + (size_t)(t + 2) * kstep; const char* b2 = last ? nB : cB + (size_t)(t + 2) * kstep;
            const char* a3 = a2 + kstep; const char* b3 = b2 + kstep;
            if (last && has_next) S.a_ready(nxt);
            PG8_LDB(B0, 0, 0); PG8_LDB(B1, 0, 1); PG8_SCHED; PG8_LDA(At, 0, 0); PG8_STAGE(PG8_SA(1, 1), a1 + hstepA, A);
            PG8_WAIT_V(8); PG8_WAIT_L(0); PG8_BAR; PG8_MMA(0, 0, At, B0); PG8_MMA(0, 1, At, B1); PG8_BAR; PG8_SCHED;
            PG8_LDA(At, 0, 1); PG8_STAGE(PG8_SB(0, 0), b2, B); PG8_STAGE(PG8_SB(0, 1), b2 + hstepB, B); PG8_STAGE(PG8_SA(0, 0), a2, A);
            PG8_WAIT_V(8); PG8_WAIT_L(0); PG8_BAR; PG8_MMA(1, 0, At, B0); PG8_MMA(1, 1, At, B1); PG8_BAR; PG8_SCHED;
            PG8_LDB(B0, 1, 0); PG8_LDB(B1, 1, 1); PG8_SCHED; PG8_LDA(At, 1, 0); PG8_STAGE(PG8_SA(0, 1), a2 + hstepA, A);
            PG8_WAIT_V(8); PG8_WAIT_L(0); PG8_BAR; PG8_MMA(0, 0, At, B0); PG8_MMA(0, 1, At, B1); PG8_BAR; PG8_SCHED;
            PG8_LDA(At, 1, 1); PG8_STAGE(PG8_SB(1, 0), b3, B); PG8_STAGE(PG8_SB(1, 1), b3 + hstepB, B); PG8_STAGE(PG8_SA(1, 0), a3, A);
            PG8_WAIT_V(8); PG8_WAIT_L(0); PG8_BAR; PG8_MMA(1, 0, At, B0); PG8_MMA(1, 1, At, B1); PG8_BAR; PG8_SCHED;
        }
        if constexpr (ALIGN_EPI) { if (wr == 0) PG8_BAR; }
        E(acc, cur, wr, wc, fr, fq); S.done(cur);
        if (!has_next) break;
#pragma unroll
        for (int a = 0; a < 2; ++a)
#pragma unroll
            for (int b = 0; b < 2; ++b)
#pragma unroll
                for (int m = 0; m < 4; ++m)
#pragma unroll
                    for (int n = 0; n < 2; ++n) acc[a][b][m][n] = (f32x4){0.f, 0.f, 0.f, 0.f};
        cur = nxt; cA = nA; cB = nB; ++ui;
        if constexpr (ALIGN_EPI) { if (wr == 1) PG8_BAR; }
    }
    PG8_WAIT_V(0);
    if constexpr (!ALIGN_EPI) { if (wr == 0) PG8_BAR; }
    PG8_BAR;
#undef PG8_SA
#undef PG8_SB
#undef PG8_STAGE
#undef PG8_LDA
#undef PG8_LDB
#undef PG8_MMA
#undef PG8_WAIT_V
#undef PG8_WAIT_L
#undef PG8_BAR
#undef PG8_SCHED
}
}
#define GAS __attribute__((address_space(1)))
#define LAS __attribute__((address_space(3)))
typedef unsigned short bf16;
typedef unsigned v4u __attribute__((ext_vector_type(4)));
typedef float f32x4 __attribute__((ext_vector_type(4)));
typedef short bf16x8 __attribute__((ext_vector_type(8)));
typedef GAS unsigned gu32;
typedef GAS unsigned long long gu64;
#define RLX_AGENT __ATOMIC_RELAXED, __HIP_MEMORY_SCOPE_AGENT
#define LDS_WAIT() asm volatile("s_waitcnt lgkmcnt(0)" ::: "memory")
#define VM_WAIT() asm volatile("s_waitcnt vmcnt(0)" ::: "memory")
__device__ __forceinline__ unsigned long long rt() { return __builtin_amdgcn_s_memrealtime(); }
__device__ __forceinline__ unsigned f2bf(float f) { unsigned u = __builtin_bit_cast(unsigned, f); return (u + 0x7fffu + ((u >> 16) & 1u)) >> 16; }
__device__ __forceinline__ unsigned pk2(float lo, float hi) { return f2bf(lo) | (f2bf(hi) << 16); }

#define XB_TMO      128
#define XB_XCNT(j)  (256  + 64 * (j))
#define XB_XSUB(j)  (1280 + 64 * (j))
#define XB_XGEN(j)  (2304 + 64 * (j))
#define XB_TOP      3328
#define XB_TOPGEN   3392
#define XCD_BAR_WORDS 3456
#define XB_SPIN_CAP (1u << 18)

__device__ __forceinline__ unsigned xb_ld(unsigned* p)              { return __hip_atomic_load(p, __ATOMIC_RELAXED, __HIP_MEMORY_SCOPE_AGENT); }
__device__ __forceinline__ unsigned xb_add(unsigned* p, unsigned v) { return __hip_atomic_fetch_add(p, v, __ATOMIC_RELAXED, __HIP_MEMORY_SCOPE_AGENT); }
__device__ __forceinline__ unsigned xb_xcc_id() { return (unsigned)__builtin_amdgcn_s_getreg((3 << 11) | 20) & 0xFu; }
#define XB_SPIN(cond, bar) do { unsigned _sp = 0; while (cond) { __builtin_amdgcn_s_sleep(1); \
    if ((++_sp & 255u) == 0u) { if (xb_ld(&(bar)[XB_TMO])) break; if (_sp > XB_SPIN_CAP) { atomicAdd(&(bar)[XB_TMO], 1u); break; } } } } while (0)

struct XcdBarrier {
    unsigned* bar; unsigned x;
    volatile LAS unsigned* st;
};

__device__ __forceinline__ XcdBarrier xcd_barrier_post(unsigned* bar, volatile LAS unsigned* st) {
    XcdBarrier b; b.bar = bar; b.x = xb_xcc_id(); b.st = st;
    if (threadIdx.x == 0) (void)xb_add(&bar[XB_XCNT(b.x)], 1u);
    return b;
}
__device__ __forceinline__ void xcd_barrier_complete(unsigned* bar, unsigned x, unsigned& nloc, unsigned& nx) {
    const unsigned G = gridDim.x * gridDim.y * gridDim.z;
    unsigned sum, cnt, mine, sp = 0u;
    for (;;) {
        sum = 0u; cnt = 0u; mine = 0u;
#pragma unroll
        for (unsigned j = 0; j < 16; ++j) { const unsigned c = xb_ld(&bar[XB_XCNT(j)]); sum += c; cnt += (c > 0u) ? 1u : 0u; mine = (j == x) ? c : mine; }
        if (sum == G) break;
        __builtin_amdgcn_s_sleep(1);
        if ((++sp & 255u) == 0u) { if (xb_ld(&bar[XB_TMO])) break; if (sp > XB_SPIN_CAP) { atomicAdd(&bar[XB_TMO], 1u); break; } }
    }
    nloc = mine > 0u ? mine : 1u; nx = cnt > 0u ? cnt : 1u;
}

__device__ __forceinline__ void xcd_barrier(const XcdBarrier& b) {
    asm volatile("s_waitcnt vmcnt(0)" ::: "memory");
    __syncthreads();
    if (threadIdx.x == 0) {
        unsigned* bar = b.bar;
        __builtin_amdgcn_s_waitcnt(0);
        unsigned nloc = b.st[0], nx = b.st[1];
        if (nloc == 0u) { xcd_barrier_complete(bar, b.x, nloc, nx); b.st[0] = nloc; b.st[1] = nx; }
        const unsigned old = xb_add(&bar[XB_XSUB(b.x)], 1u);
        const unsigned gen = old / nloc;
        if (old + 1u == (gen + 1u) * nloc) {
            __builtin_amdgcn_fence(__ATOMIC_RELEASE, "agent");
            asm volatile("s_waitcnt vmcnt(0)" ::: "memory");
            const unsigned og = xb_add(&bar[XB_TOP], 1u);
            const unsigned tg = og / nx;
            if (og + 1u == (tg + 1u) * nx) xb_add(&bar[XB_TOPGEN], 1u);
            else XB_SPIN(xb_ld(&bar[XB_TOPGEN]) == tg, bar);
            __builtin_amdgcn_fence(__ATOMIC_ACQUIRE, "agent");
            xb_add(&bar[XB_XGEN(b.x)], 1u);
            asm volatile("s_waitcnt vmcnt(0)" ::: "memory");
        } else {
            XB_SPIN(xb_ld(&bar[XB_XGEN(b.x)]) == gen, bar);
            __builtin_amdgcn_fence(__ATOMIC_ACQUIRE, "agent");
            asm volatile("s_waitcnt vmcnt(0)" ::: "memory");
        }
    }
    __syncthreads();
}
constexpr int NWAVES = 8, NTHR = 512;
constexpr int DM = 2048, TP = 8192, DB = 128, DS = 4, NSAMP = DB * DS, M = TP + NSAMP;
constexpr int FF = 5504, PASTL = 2048, PAGE = 128, NPAGES = 16;
constexpr int HGH = 8, HGD = 128, HGW = 1024;
constexpr int NH = 16, NKV = 2, GRP = 8, HD = 64, NSAW = 1024, KVW = 128;
constexpr int CMPB = 32, CMPS = 16, CMPH = 256, SLCB = 64, SLCT = 16, WIN = 512;
constexpr int NCP = (TP - CMPB) / CMPS + 1;
constexpr int NCS = (PASTL + DS - CMPB) / CMPS + 1;
constexpr int NSP = TP / SLCB;
constexpr int NSS = (PASTL + DS + SLCB - 1) / SLCB;
constexpr int DIN = 10032, DINP = 10240;
constexpr float EPS = 1e-6f;
constexpr int C_HQ = 0, C_HF = 1024, C_HI = 2048, C_HG = 3072, C_NQ = 4096, C_KV = 5120, C_WN = 5632, C_GA = 5888, C_GB = 7936, C_NG = 9984;
constexpr size_t O_Y = 0, O_KV = (size_t)M * DM, O_WINP = O_KV + (size_t)M * 512, O_WINS = O_WINP + 512 * 256, O_HGP = O_WINS + (size_t)DB * 512 * 256, O_HGS = O_HGP + 131072, O_END = O_HGS + (size_t)DB * 131072;
static_assert(O_END == 56098816, "d_out size");
constexpr size_t MiB = 1u << 20;
constexpr size_t alignup(size_t x) { return (x + MiB - 1) / MiB * MiB; }
constexpr size_t WS_CTL = 0, CTL_ZERO_BYTES = 1 * MiB;
constexpr size_t WS_W1GU = 1 * MiB;
constexpr size_t WS_W1D  = WS_W1GU + alignup((size_t)2 * FF * DM * 2);
constexpr size_t WS_W2GU = WS_W1D + alignup((size_t)DM * FF * 2);
constexpr size_t WS_W2D  = WS_W2GU + alignup((size_t)2 * FF * DM * 2);
constexpr size_t WS_WIN  = WS_W2D + alignup((size_t)DM * FF * 2);
constexpr size_t WS_WPH  = WS_WIN + alignup((size_t)DINP * DM * 2);
constexpr size_t WS_WPN  = WS_WPH + alignup((size_t)DM * 1024 * 2);
constexpr size_t WS_WO   = WS_WPN + alignup((size_t)DM * 1024 * 2);
constexpr size_t WS_XN   = WS_WO + alignup((size_t)DM * DM * 2);
constexpr size_t WS_HB   = WS_XN + alignup((size_t)M * DM * 2);
constexpr size_t WS_Y    = WS_HB + alignup((size_t)M * FF * 2);
constexpr size_t WS_X1   = WS_Y + alignup((size_t)M * DM * 4);
constexpr size_t WS_X2   = WS_X1 + alignup((size_t)M * DM * 4);
constexpr size_t WS_QH   = WS_X2 + alignup((size_t)M * DM * 4);
constexpr size_t WS_LOGF = WS_QH + alignup((size_t)M * 1024 * 4);
constexpr size_t WS_KH   = WS_LOGF + alignup((size_t)M * 1024 * 4);
constexpr size_t WS_VH   = WS_KH + alignup((size_t)M * 1024 * 4);
constexpr size_t WS_GH   = WS_VH + alignup((size_t)M * 1024 * 4);
constexpr size_t WS_QN   = WS_GH + alignup((size_t)M * 1024 * 4);
constexpr size_t WS_WINF = WS_QN + alignup((size_t)M * 1024 * 4);
constexpr size_t WS_NG   = WS_WINF + alignup((size_t)M * 256 * 4);
constexpr size_t WS_GA   = WS_NG + alignup((size_t)M * 48 * 4);
constexpr size_t WS_GB   = WS_GA + alignup((size_t)M * DM * 4);
constexpr size_t WS_KCP  = WS_GB + alignup((size_t)M * DM * 4);
constexpr size_t WS_VCP  = WS_KCP + 1 * MiB;
constexpr size_t WS_KCS  = WS_VCP + 1 * MiB;
constexpr size_t WS_VCS  = WS_KCS + alignup((size_t)DB * 2 * NCS * 64 * 4);
constexpr size_t WS_CB   = WS_VCS + alignup((size_t)DB * 2 * NCS * 64 * 4);
constexpr size_t WS_OHR  = WS_CB + 1 * MiB;
constexpr size_t WS_OHG  = WS_OHR + alignup((size_t)M * 1024 * 4);
constexpr size_t WS_ONSA = WS_OHG + alignup((size_t)M * 1024 * 2);
constexpr size_t WS_T1   = WS_ONSA + alignup((size_t)M * 1024 * 2);
constexpr size_t WS_MIX  = WS_T1 + alignup((size_t)M * DM * 4);
constexpr size_t WS_UT   = WS_MIX + alignup((size_t)M * DM * 2);
constexpr size_t WS_DD   = WS_UT + alignup((size_t)128 * 8 * 16384 * 4);
constexpr size_t WS_SP   = WS_DD + 1 * MiB;
constexpr size_t WS_QN16 = WS_SP + alignup((size_t)128 * 8 * 16384 * 2);
constexpr size_t WS_KSL  = WS_QN16 + alignup((size_t)M * 1024 * 2);
constexpr size_t WS_VSL  = WS_KSL + 2 * MiB;
constexpr size_t WS_KWN  = WS_VSL + 2 * MiB;
constexpr size_t WS_VWN  = WS_KWN + 2 * MiB;
constexpr size_t WS_KC16 = WS_VWN + 2 * MiB;
constexpr size_t WS_VC16 = WS_KC16 + 1 * MiB;
constexpr int CMP_ROWS_S = DB * 2 * 2 * 128, CMP_ROWS_P = 2 * 2 * 512, CMP_ROWS = CMP_ROWS_S + CMP_ROWS_P;
constexpr size_t WS_CA   = WS_VC16 + 1 * MiB;
constexpr size_t WS_HID  = WS_CA + alignup((size_t)CMP_ROWS * 1024 * 2) + 1 * MiB;
constexpr size_t WS_W1C  = WS_HID + alignup((size_t)CMP_ROWS * 256 * 2);
constexpr size_t WS_W2C  = WS_W1C + 2 * MiB;
constexpr size_t WS_SLAB = WS_W2C + 1 * MiB;
constexpr size_t SLABSZ = (size_t)NSAMP * DM;
constexpr size_t WS_QH16 = WS_SLAB + alignup(16 * SLABSZ * 4);
constexpr size_t WS_KH16 = WS_QH16 + 18 * MiB;
constexpr size_t WS_VH16 = WS_KH16 + 18 * MiB;
constexpr size_t WS_GH16 = WS_VH16 + 18 * MiB;
constexpr size_t WS_RS   = WS_GH16 + 18 * MiB;
constexpr size_t WS_END  = WS_RS + 1 * MiB;
static_assert(WS_END < (size_t)2600 * MiB, "workspace");
constexpr int CW_TMO = 0, CW_CODE = 1, CW_BAR = 4096, CW_Q7 = 8192, CW_Q5 = 8192 + 256;
constexpr int RING_OFF = 0, RING_BYTES = 131072;
constexpr int LDSCTL_OFF = RING_BYTES, MISC_OFF = LDSCTL_OFF + 320;
constexpr int LDS_BYTES = 147456;
namespace pg8 {
__device__ __forceinline__ float sigm(float x) { return __builtin_amdgcn_rcpf(1.f + __expf(-x)); }
#define EPI_FOR(...) _Pragma("unroll") for (int ai = 0; ai < 2; ++ai) _Pragma("unroll") for (int m = 0; m < 4; ++m) { const int row = row0 + ai * 128 + m * 16; \
    _Pragma("unroll") for (int bj = 0; bj < 2; ++bj) _Pragma("unroll") for (int n = 0; n < 2; ++n) { const int cl = cl0 + bj * 128 + 4 * n; f32x4 v = acc[ai][bj][m][n]; __VA_ARGS__ } }
#define EPI_BFSILU(dst, ld, col) _Pragma("unroll") for (int ai = 0; ai < 2; ++ai) _Pragma("unroll") for (int m = 0; m < 4; ++m) { const int row = row0 + ai * 128 + m * 16; \
    _Pragma("unroll") for (int bj = 0; bj < 2; ++bj) { const f32x4 a = acc[ai][bj][m][0], b = acc[ai][bj][m][1]; u32x4 w; \
        w.x = cvt_pk_bf16(a[0] * sigm(a[0]), a[1] * sigm(a[1])); w.y = cvt_pk_bf16(a[2] * sigm(a[2]), a[3] * sigm(a[3])); w.z = cvt_pk_bf16(b[0] * sigm(b[0]), b[1] * sigm(b[1])); w.w = cvt_pk_bf16(b[2] * sigm(b[2]), b[3] * sigm(b[3])); \
        *(u32x4*)((dst) + (size_t)row * (ld) + (col)) = w; } }
#define EPI_BFS(dst, ld, col) _Pragma("unroll") for (int ai = 0; ai < 2; ++ai) _Pragma("unroll") for (int m = 0; m < 4; ++m) { const int row = row0 + ai * 128 + m * 16; \
    _Pragma("unroll") for (int bj = 0; bj < 2; ++bj) { f32x4 a = acc[ai][bj][m][0], b = acc[ai][bj][m][1]; for (int j = 0; j < 4; ++j) { a[j] = sigm(a[j]); b[j] = sigm(b[j]); } u32x4 w; \
        w.x = cvt_pk_bf16(a[0], a[1]); w.y = cvt_pk_bf16(a[2], a[3]); w.z = cvt_pk_bf16(b[0], b[1]); w.w = cvt_pk_bf16(b[2], b[3]); *(u32x4*)((dst) + (size_t)row * (ld) + (col)) = w; } }
#define EPI_BF(dst, ld, col, scale) _Pragma("unroll") for (int ai = 0; ai < 2; ++ai) _Pragma("unroll") for (int m = 0; m < 4; ++m) { const int row = row0 + ai * 128 + m * 16; \
    _Pragma("unroll") for (int bj = 0; bj < 2; ++bj) { const f32x4 a = acc[ai][bj][m][0] * (scale), b = acc[ai][bj][m][1] * (scale); u32x4 w; \
        w.x = cvt_pk_bf16(a[0], a[1]); w.y = cvt_pk_bf16(a[2], a[3]); w.z = cvt_pk_bf16(b[0], b[1]); w.w = cvt_pk_bf16(b[2], b[3]); *(u32x4*)((dst) + (size_t)row * (ld) + (col)) = w; } }
__device__ __forceinline__ void unpack8(const u32x4 w, f32x4& a, f32x4& b) {
    a[0] = __uint_as_float(w.x << 16); a[1] = __uint_as_float(w.x & 0xffff0000u); a[2] = __uint_as_float(w.y << 16); a[3] = __uint_as_float(w.y & 0xffff0000u);
    b[0] = __uint_as_float(w.z << 16); b[1] = __uint_as_float(w.z & 0xffff0000u); b[2] = __uint_as_float(w.w << 16); b[3] = __uint_as_float(w.w & 0xffff0000u); }
struct EpiSwiglu {
    static constexpr bool PERM = true;
    bf16_t* H; int ldh;
    __device__ __forceinline__ void operator()(const f32x4 (&acc)[2][2][4][2], const Unit& u, int wr, int wc, int fr, int fq) const {
        const int row0 = u.pm * BM + wr * 64 + fr, col = u.pn * 128 + wc * 32 + 8 * fq;
#pragma unroll
        for (int ai = 0; ai < 2; ++ai)
#pragma unroll
            for (int m = 0; m < 4; ++m) { const int row = row0 + ai * 128 + m * 16; float h[8];
#pragma unroll
                for (int n = 0; n < 2; ++n)
#pragma unroll
                    for (int j = 0; j < 4; ++j) { const float g = acc[ai][0][m][n][j], up = acc[ai][1][m][n][j]; h[4 * n + j] = g * sigm(g) * up; }
                u32x4 w; w.x = cvt_pk_bf16(h[0], h[1]); w.y = cvt_pk_bf16(h[2], h[3]); w.z = cvt_pk_bf16(h[4], h[5]); w.w = cvt_pk_bf16(h[6], h[7]);
                *(u32x4*)(H + (size_t)row * ldh + col) = w; }
    }
};
struct EpiY16 {
    static constexpr bool PERM = true;
    bf16_t* Y; int ldc;
    __device__ __forceinline__ void operator()(const f32x4 (&acc)[2][2][4][2], const Unit& u, int wr, int wc, int fr, int fq) const {
        const int row0 = u.pm * BM + wr * 64 + fr, cl0 = u.pn * BM + wc * 32 + 8 * fq;
        EPI_BF(Y, ldc, cl0 + bj * 128, 1.f)
    }
};
struct EpiSlab {
    static constexpr bool PERM = true;
    float* S;
    __device__ __forceinline__ void operator()(const f32x4 (&acc)[2][2][4][2], const Unit& u, int wr, int wc, int fr, int fq) const {
        const int row0 = (u.pm - 32) * BM + wr * 64 + fr, cl0 = u.pn * BM + wc * 32 + 8 * fq;
        EPI_FOR( *(f32x4*)(S + (size_t)row * 2048 + cl) = v; )
    }
};
struct OneUnit {
    int su;
    __device__ bool next(int i, Unit& u) const { if (i > 0 || su >= 16) return false; u.pm = 32 + (su >> 3); u.pn = su & 7; return true; }
    __device__ __forceinline__ void a_ready(const Unit&) const {}
    __device__ __forceinline__ void done(const Unit&) const {}
};
struct SplitSched {
    StaticOrder S; const char* A; const char* B; int lda, ldb, K, NS, bid;
    __device__ __forceinline__ void piece(int ks, int& koff, int& klen) const { if (K == FF) { koff = 128 * (ks < 11 ? 3 * ks : 33 + 2 * (ks - 11)); klen = ks < 11 ? 384 : 256; } else { klen = K / NS; koff = ks * klen; } }
    __device__ bool next(int i, UnitG& u) const {
        const int nmain = S.c < S.nwg ? (S.nwg - S.c + S.G - 1) / S.G : 0;
        if (i < nmain) { Unit m; S.next(i, m); u.pm = m.pm; u.pn = m.pn; u.A = A + (size_t)m.pm * 256 * lda * 2; u.B = B + (size_t)m.pn * 256 * ldb * 2; u.nt = K / 64; u.kind = 0; u.aux = 0; return true; }
        const int p = bid + (i - nmain) * S.G; if (p >= 16 * NS) return false;
        const int ks = p % NS, su = p / NS;
        int koff, klen; piece(ks, koff, klen);
        u.pm = 32 + (su >> 3); u.pn = su & 7; u.A = A + ((size_t)u.pm * 256 * lda + koff) * 2; u.B = B + ((size_t)u.pn * 256 * ldb + koff) * 2; u.nt = klen / 64; u.kind = 1; u.aux = ks; return true;
    }
    __device__ __forceinline__ void a_ready(const UnitG&) const {}
    __device__ __forceinline__ void done(const UnitG&) const {}
};
struct ProjSched {
    StaticOrder S; const char* Ah; const char* An; const char* Bh; const char* Bn; int bid;
    __device__ bool next(int i, UnitG& u) const {
        const int nmain = S.c < S.nwg ? (S.nwg - S.c + S.G - 1) / S.G : 0;
        if (i < 2 * nmain) { Unit m; S.next(i >> 1, m); const bool n = i & 1; u.pm = m.pm; u.pn = m.pn; u.A = (n ? An : Ah) + (size_t)m.pm * 256 * 1024 * 2; u.B = (n ? Bn : Bh) + (size_t)m.pn * 256 * 1024 * 2; u.nt = 16; u.kind = n ? 2 : 0; u.aux = 0; return true; }
        const int p = bid + (i - 2 * nmain) * S.G; if (p >= 128) return false;
        const int j = p >> 6, ks = p & 3, su = (p >> 2) & 15;
        u.pm = 32 + (su >> 3); u.pn = su & 7; u.A = (j ? An : Ah) + ((size_t)u.pm * 256 * 1024 + ks * 256) * 2; u.B = (j ? Bn : Bh) + ((size_t)u.pn * 256 * 1024 + ks * 256) * 2; u.nt = 4; u.kind = 1; u.aux = 4 * j + ks; return true;
    }
    __device__ __forceinline__ void a_ready(const UnitG&) const {}
    __device__ __forceinline__ void done(const UnitG&) const {}
};
__device__ __forceinline__ f32x4 sig4(f32x4 x) { return (f32x4){sigm(x[0]), sigm(x[1]), sigm(x[2]), sigm(x[3])}; }
struct EpiGate1 {
    static constexpr bool PERM = true;
    const bf16_t* GA; bf16_t* T1; int ldc;
    __device__ __forceinline__ void operator()(const f32x4 (&acc)[2][2][4][2], const Unit& u, int wr, int wc, int fr, int fq) const {
        const int row0 = u.pm * BM + wr * 64 + fr, cl0 = u.pn * BM + wc * 32 + 8 * fq;
#pragma unroll
        for (int ai = 0; ai < 2; ++ai)
#pragma unroll
            for (int m = 0; m < 4; ++m) { const int row = row0 + ai * 128 + m * 16;
#pragma unroll
                for (int bj = 0; bj < 2; ++bj) { const size_t off = (size_t)row * ldc + cl0 + bj * 128; f32x4 g0, g1; unpack8(*(const u32x4*)(GA + off), g0, g1);
                    const f32x4 a = sig4(g0) * acc[ai][bj][m][0], b = sig4(g1) * acc[ai][bj][m][1];
                    u32x4 w; w.x = cvt_pk_bf16(a[0], a[1]); w.y = cvt_pk_bf16(a[2], a[3]); w.z = cvt_pk_bf16(b[0], b[1]); w.w = cvt_pk_bf16(b[2], b[3]);
                    *(u32x4*)(T1 + off) = w; } }
    }
};
struct EpiGate2 {
    static constexpr bool PERM = true;
    const bf16_t* GB; const bf16_t* T1; bf16_t* MIX; int ldc;
    __device__ __forceinline__ void operator()(const f32x4 (&acc)[2][2][4][2], const Unit& u, int wr, int wc, int fr, int fq) const {
        const int row0 = u.pm * BM + wr * 64 + fr, cl0 = u.pn * BM + wc * 32 + 8 * fq;
#pragma unroll
        for (int ai = 0; ai < 2; ++ai)
#pragma unroll
            for (int m = 0; m < 4; ++m) { const int row = row0 + ai * 128 + m * 16;
#pragma unroll
                for (int bj = 0; bj < 2; ++bj) { const size_t off = (size_t)row * ldc + cl0 + bj * 128; f32x4 t0, t1, g0, g1; unpack8(*(const u32x4*)(T1 + off), t0, t1); unpack8(*(const u32x4*)(GB + off), g0, g1);
                    const f32x4 a = t0 + sig4(g0) * acc[ai][bj][m][0], b = t1 + sig4(g1) * acc[ai][bj][m][1];
                    u32x4 w; w.x = cvt_pk_bf16(a[0], a[1]); w.y = cvt_pk_bf16(a[2], a[3]); w.z = cvt_pk_bf16(b[0], b[1]); w.w = cvt_pk_bf16(b[2], b[3]);
                    *(u32x4*)(MIX + off) = w; } }
    }
};
template <class Main> struct EpiDual {
    static constexpr bool PERM = true;
    Main main; float* slab;
    __device__ __forceinline__ void operator()(const f32x4 (&acc)[2][2][4][2], const UnitG& u, int wr, int wc, int fr, int fq) const {
        if (u.kind == 0) main(acc, u, wr, wc, fr, fq); else { EpiSlab e{slab + (size_t)u.aux * SLABSZ}; e(acc, u, wr, wc, fr, fq); }
    }
};
struct EpiProj {
    static constexpr bool PERM = true;
    EpiGate1 g1; EpiGate2 g2; float* slab;
    __device__ __forceinline__ void operator()(const f32x4 (&acc)[2][2][4][2], const UnitG& u, int wr, int wc, int fr, int fq) const {
        if (u.kind == 0) g1(acc, u, wr, wc, fr, fq); else if (u.kind == 2) g2(acc, u, wr, wc, fr, fq); else { EpiSlab e{slab + (size_t)u.aux * SLABSZ}; e(acc, u, wr, wc, fr, fq); }
    }
};
struct EpiCmp {
    static constexpr bool PERM = true;
    const float* CB; bf16_t* HID;
    __device__ __forceinline__ void operator()(const f32x4 (&acc)[2][2][4][2], const Unit& u, int wr, int wc, int fr, int fq) const {
        const int row0 = u.pm * BM + wr * 64 + fr, cl0 = wc * 32 + 8 * fq;
#pragma unroll
        for (int bj = 0; bj < 2; ++bj) { const f32x4 b0 = *(const f32x4*)(CB + u.pn * 256 + cl0 + bj * 128), b1 = *(const f32x4*)(CB + u.pn * 256 + cl0 + bj * 128 + 4);
#pragma unroll
            for (int ai = 0; ai < 2; ++ai)
#pragma unroll
                for (int m = 0; m < 4; ++m) { const int row = row0 + ai * 128 + m * 16; f32x4 a = acc[ai][bj][m][0] + b0, b = acc[ai][bj][m][1] + b1;
                    for (int j = 0; j < 4; ++j) { a[j] = a[j] * sigm(1.5957691216057308f * (a[j] + 0.044715f * a[j] * a[j] * a[j])); b[j] = b[j] * sigm(1.5957691216057308f * (b[j] + 0.044715f * b[j] * b[j] * b[j])); }
                    u32x4 w; w.x = cvt_pk_bf16(a[0], a[1]); w.y = cvt_pk_bf16(a[2], a[3]); w.z = cvt_pk_bf16(b[0], b[1]); w.w = cvt_pk_bf16(b[2], b[3]);
                    *(u32x4*)(HID + (size_t)row * 256 + cl0 + bj * 128) = w; } }
    }
};
struct CmpOrder {
    int G, c;
    __device__ bool next(int i, Unit& u) const { const int L = i * G + c; if (L >= CMP_ROWS / 256) return false; u.pm = L; u.pn = L < CMP_ROWS_S / 256 ? (L >= CMP_ROWS_S / 512 ? 1 : 0) : (L - CMP_ROWS_S / 256 >= 4 ? 1 : 0); return true; }
    __device__ __forceinline__ void a_ready(const Unit&) const {}
    __device__ __forceinline__ void done(const Unit&) const {}
};
struct EpiInProj {
    static constexpr bool PERM = true;
    unsigned char* ws; float* out; const float* hg_lb;
    __device__ __forceinline__ void operator()(const f32x4 (&acc)[2][2][4][2], const Unit& u, int wr, int wc, int fr, int fq) const {
        const int row0 = u.pm * BM + wr * 64 + fr, cl0 = wc * 32 + 8 * fq, pn = u.pn;
        float* const LOGF = (float*)(ws + WS_LOGF);
        float* const WINF = (float*)(ws + WS_WINF); float* const NG = (float*)(ws + WS_NG); bf16_t* const GA = (bf16_t*)(ws + WS_GA); bf16_t* const GB = (bf16_t*)(ws + WS_GB);
        float* const KVO = out + O_KV; float* const WINP = out + O_WINP; float* const WINS = out + O_WINS;
        bf16_t* const QN16 = (bf16_t*)(ws + WS_QN16); bf16_t* const KSL = (bf16_t*)(ws + WS_KSL); bf16_t* const VSL = (bf16_t*)(ws + WS_VSL); bf16_t* const KWN = (bf16_t*)(ws + WS_KWN); bf16_t* const VWN = (bf16_t*)(ws + WS_VWN);
        bf16_t* const CP16 = (bf16_t*)(ws + WS_CA) + (size_t)CMP_ROWS_S * 1024;
        bf16_t* const QH16 = (bf16_t*)(ws + WS_QH16); bf16_t* const KH16 = (bf16_t*)(ws + WS_KH16); bf16_t* const VH16 = (bf16_t*)(ws + WS_VH16); bf16_t* const GH16 = (bf16_t*)(ws + WS_GH16);
        if (pn < 4) { const int cb = pn * 256;
            EPI_BFSILU(QH16, 1024, cb + cl0 + bj * 128)
        } else if (pn < 8) { const int cb = (pn - 4) * 256;
#pragma unroll
            for (int bj = 0; bj < 2; ++bj) { const int c = cb + cl0 + bj * 128; f32x4 lb[2];
#pragma unroll
                for (int n = 0; n < 2; ++n) { const f32x4 a0 = *(const f32x4*)(hg_lb + c + 4 * n), a1 = *(const f32x4*)(hg_lb + 1024 + c + 4 * n); for (int j = 0; j < 4; ++j) lb[n][j] = 1.f / (1.f + expf(a1[j] - a0[j])); }
#pragma unroll
                for (int ai = 0; ai < 2; ++ai)
#pragma unroll
                    for (int m = 0; m < 4; ++m) { const int row = row0 + ai * 128 + m * 16; f32x4 kk[2];
#pragma unroll
                        for (int n = 0; n < 2; ++n) { const f32x4 v = acc[ai][bj][m][n]; f32x4 lf;
                            for (int j = 0; j < 4; ++j) { const float sg = 1.f / (1.f + expf(-v[j])), sn = 1.f / (1.f + expf(v[j])); const float f = lb[n][j] + (1.f - lb[n][j]) * sg; lf[j] = logf(f); kk[n][j] = (1.f - lb[n][j]) * sn; }
                            *(f32x4*)(LOGF + (size_t)row * 1024 + c + 4 * n) = lf; }
                        { u32x4 w; w.x = cvt_pk_bf16(kk[0][0], kk[0][1]); w.y = cvt_pk_bf16(kk[0][2], kk[0][3]); w.z = cvt_pk_bf16(kk[1][0], kk[1][1]); w.w = cvt_pk_bf16(kk[1][2], kk[1][3]); *(u32x4*)(KH16 + (size_t)row * 1024 + c) = w; } } }
        } else if (pn < 12) { const int cb = (pn - 8) * 256;
            EPI_BF(VH16, 1024, cb + cl0 + bj * 128, 1.f)
        } else if (pn < 16) { const int cb = (pn - 12) * 256;
            EPI_BFSILU(GH16, 1024, cb + cl0 + bj * 128)
        } else if (pn < 20) { const int cb = (pn - 16) * 256;
            EPI_BF(QN16, 1024, cb + cl0 + bj * 128, 0.125f * 1.4426950408889634f)
        } else if (pn < 22) { const int cb = (pn - 20) * 256;
            EPI_FOR( *(f32x4*)(KVO + (size_t)row * 512 + cb + cl) = v; )
            if (pn == 21 && u.pm < 32) { EPI_BF((bj ? VSL : KSL), 128, cl0, 1.f) }
            if (pn == 20 && u.pm < 32) { EPI_BF(CP16 + (size_t)(bj * 2 + (cl0 >> 6)) * 8192 * 64, 64, cl0 & 63, 1.f) }
        } else if (pn == 22) {
            EPI_FOR( *(f32x4*)(WINF + (size_t)row * 256 + cl) = v;
                     if (row >= 7680 && row < 8192) *(f32x4*)(WINP + (size_t)(row - 7680) * 256 + cl) = v;
                     if (row >= 8192) { const int b = (row - 8192) >> 2, tt = (row - 8192) & 3; *(f32x4*)(WINS + ((size_t)b * 512 + 508 + tt) * 256 + cl) = v; } )
            if (u.pm < 32) { EPI_BF((bj ? VWN : KWN), 128, cl0, 1.f) }
        } else if (pn < 31) { const int cb = (pn - 23) * 256;
            EPI_BF(GA, 2048, cb + cl0 + bj * 128, 1.f)
        } else if (pn < 39) { const int cb = (pn - 31) * 256;
            EPI_BF(GB, 2048, cb + cl0 + bj * 128, 1.f)
        } else {
            EPI_FOR( if (cl < 48) { f32x4 o; for (int j = 0; j < 4; ++j) o[j] = sigm(v[j]); *(f32x4*)(NG + (size_t)row * 48 + cl) = o; } )
        }
    }
};
#undef EPI_FOR
#undef EPI_BF
#undef EPI_BFS
#undef EPI_BFSILU
}
typedef float f4 __attribute__((ext_vector_type(4)));
typedef float f2 __attribute__((ext_vector_type(2)));
typedef unsigned u2 __attribute__((ext_vector_type(2)));
__device__ __forceinline__ float wsum(float v) {
#pragma unroll
    for (int o = 32; o > 0; o >>= 1) v += __shfl_xor(v, o);
    return v;
}
__device__ __forceinline__ float wmax(float v) {
#pragma unroll
    for (int o = 32; o > 0; o >>= 1) v = fmaxf(v, __shfl_xor(v, o));
    return v;
}
__device__ __forceinline__ f4 ld4bf(const bf16* p) { const u2 w = *(const u2*)p; return (f4){__uint_as_float(w.x << 16), __uint_as_float(w.x & 0xffff0000u), __uint_as_float(w.y << 16), __uint_as_float(w.y & 0xffff0000u)}; }
struct Ctx { int tid, lane, wave, gw, NGW, G, bid; LAS unsigned char* lds; };

struct TrMat { int in_idx, K, N, map; size_t dst; };
__device__ __forceinline__ TrMat tr_mat(int m) {
    switch (m) {
        case 0: return TrMat{8, DM, FF, 1, WS_W1GU};              case 1: return TrMat{9, DM, FF, 2, WS_W1GU};
        case 2: return TrMat{13, DM, DIN, 3, WS_WIN};
        case 3: return TrMat{17, 2048, 256, 0, WS_W1C};           case 4: return TrMat{20, 2048, 256, 0, WS_W1C + (size_t)256 * 2048 * 2};
        case 5: return TrMat{18, 256, 64, 0, WS_W2C};             case 6: return TrMat{21, 256, 64, 0, WS_W2C + (size_t)64 * 256 * 2};
        case 7: return TrMat{10, FF, DM, 0, WS_W1D};
        case 8: return TrMat{27, DM, FF, 1, WS_W2GU};             case 9: return TrMat{28, DM, FF, 2, WS_W2GU};
        case 10: return TrMat{22, 1024, DM, 0, WS_WPH};           case 11: return TrMat{23, 1024, DM, 0, WS_WPN};
        case 12: return TrMat{24, DM, DM, 0, WS_WO};
        default: return TrMat{29, FF, DM, 0, WS_W2D};
    }
}
__device__ __forceinline__ int tr_items(const TrMat& t) { return (t.K / 64) * ((t.N + 63) / 64); }
__device__ __forceinline__ int dest_row_rt(int map, int n) {
    if (map == 1) return (n >> 7) * 256 + (n & 127);
    if (map == 2) return (n >> 7) * 256 + 128 + (n & 127);
    if (map == 3) return n < 5888 ? n : (n < 5936 ? C_NG + (n - 5888) : C_GA + (n - 5936));
    return n;
}
__device__ __forceinline__ void tr_item64(const float* W, int K, int N, bf16* WT, int map, LAS unsigned* scr, int item, int lane) {
    const int nblk = (N + 63) / 64, kb = item / nblk, nb = item % nblk, k0 = 64 * kb, n0 = 64 * nb, nn = n0 + lane; const bool ok = nn < N;
    const float* src = W + (size_t)k0 * N + (ok ? nn : 0);
    float v[64];
#pragma unroll
    for (int i = 0; i < 64; ++i) v[i] = src[(size_t)i * N];
#pragma unroll
    for (int i = 0; i < 32; ++i) scr[lane * 33 + i] = pk2(v[2 * i], v[2 * i + 1]);
    LDS_WAIT(); asm volatile("" ::: "memory");
    const int c = lane & 7;
#pragma unroll
    for (int j = 0; j < 8; ++j) { const int n = (lane >> 3) + 8 * j; v4u o; o.x = scr[n * 33 + 4 * c]; o.y = scr[n * 33 + 4 * c + 1]; o.z = scr[n * 33 + 4 * c + 2]; o.w = scr[n * 33 + 4 * c + 3];
        if (n0 + n < N) *(GAS v4u*)(WT + (size_t)dest_row_rt(map, n0 + n) * K + k0 + 8 * c) = o; }
    LDS_WAIT(); asm volatile("" ::: "memory");
}
__device__ __forceinline__ void tr_run(const void* const* in, unsigned char* ws, LAS unsigned* scr, int mlo, int mhi, int widx, int nw, int lane) {
    int total = 0;
    for (int m = mlo; m < mhi; ++m) total += tr_items(tr_mat(m));
    for (int it = widx; it < total; it += nw) { int r = it, m = mlo; TrMat t = tr_mat(m);
        while (r >= tr_items(t)) { r -= tr_items(t); ++m; t = tr_mat(m); }
        tr_item64((const float*)in[t.in_idx], t.K, t.N, (bf16*)(ws + t.dst), t.map, scr, r, lane); }
}
__device__ __forceinline__ void rms_row_to_bf16(const float* xrow, const float* g, bf16* orow, int lane) {
    const f4* xr = (const f4*)xrow + lane; const f4* gr = (const f4*)g + lane;
    f4 v[8]; float s = 0.f;
#pragma unroll
    for (int j = 0; j < 8; ++j) { v[j] = xr[64 * j]; s += (v[j].x * v[j].x + v[j].y * v[j].y) + (v[j].z * v[j].z + v[j].w * v[j].w); }
    const float r = rsqrtf(wsum(s) * (1.f / DM) + EPS);
    unsigned long long* o8 = (unsigned long long*)orow + lane;
#pragma unroll
    for (int j = 0; j < 8; ++j) { const f4 gg = gr[64 * j]; o8[64 * j] = (unsigned long long)pk2(v[j].x * r * gg.x, v[j].y * r * gg.y) | ((unsigned long long)pk2(v[j].z * r * gg.z, v[j].w * r * gg.w) << 32); }
}
__device__ __forceinline__ void norm_mid_row(const void* yrow_, const float* xin, const bf16* xin16, const float* gin, float rs_in, const float* gpost, float scale, float* xout, const float* gpre, bf16* xn, float* rs_out, int lane, int nslab = 0) {
    const f4* yr = (const f4*)yrow_ + lane; const f4* xr = (const f4*)xin + lane; const f4* gp = (const f4*)gpost + lane;
    f4 v[8]; float s = 0.f;
    if (nslab == 0) {
        const unsigned long long* y8 = (const unsigned long long*)yrow_ + lane;
#pragma unroll
        for (int j = 0; j < 8; ++j) { const unsigned long long w = y8[64 * j]; const unsigned lo = (unsigned)w, hi = (unsigned)(w >> 32);
            v[j] = (f4){__uint_as_float(lo << 16), __uint_as_float(lo & 0xffff0000u), __uint_as_float(hi << 16), __uint_as_float(hi & 0xffff0000u)}; }
    } else {
#pragma unroll
        for (int j = 0; j < 8; ++j) v[j] = yr[64 * j];
    }
    for (int k = 1; k + 3 < nslab; k += 4) {
        f4 t[4][8];
#pragma unroll
        for (int kk = 0; kk < 4; ++kk)
#pragma unroll
            for (int j = 0; j < 8; ++j) t[kk][j] = yr[64 * j + (size_t)(k + kk) * (SLABSZ / 4)];
#pragma unroll
        for (int kk = 0; kk < 4; ++kk)
#pragma unroll
            for (int j = 0; j < 8; ++j) v[j] += t[kk][j];
    }
    if (nslab > 0) { const int k0 = 1 + ((nslab - 1) / 4) * 4;
#pragma unroll
        for (int kk = 0; kk < 3; ++kk)
#pragma unroll
            for (int j = 0; j < 8; ++j) v[j] += yr[64 * j + (size_t)(k0 + kk) * (SLABSZ / 4)]; }
#pragma unroll
    for (int j = 0; j < 8; ++j) s += (v[j].x * v[j].x + v[j].y * v[j].y) + (v[j].z * v[j].z + v[j].w * v[j].w);
    const float r = rsqrtf(wsum(s) * (1.f / DM) + EPS) * scale;
    float s2 = 0.f;
#pragma unroll
    for (int j = 0; j < 8; ++j) { f4 xi;
        if (xin) xi = xr[64 * j];
        else { const f4 xb = ld4bf(xin16 + 4 * (lane + 64 * j)), gi = ((const f4*)gin + lane)[64 * j];
            xi = (f4){xb.x * rs_in * __builtin_amdgcn_rcpf(gi.x), xb.y * rs_in * __builtin_amdgcn_rcpf(gi.y), xb.z * rs_in * __builtin_amdgcn_rcpf(gi.z), xb.w * rs_in * __builtin_amdgcn_rcpf(gi.w)}; }
        const f4 gg = gp[64 * j]; v[j] = xi + v[j] * gg * r; if (xout) ((f4*)xout + lane)[64 * j] = v[j];
        s2 += (v[j].x * v[j].x + v[j].y * v[j].y) + (v[j].z * v[j].z + v[j].w * v[j].w); }
    if (xn) {
        const float ms = wsum(s2) * (1.f / DM) + EPS; const float r2 = rsqrtf(ms); const f4* gr = (const f4*)gpre + lane;
        if (rs_out && lane == 0) *rs_out = sqrtf(ms);
        unsigned long long* o8 = (unsigned long long*)xn + lane;
#pragma unroll
        for (int j = 0; j < 8; ++j) { const f4 gg = gr[64 * j]; o8[64 * j] = (unsigned long long)pk2(v[j].x * r2 * gg.x, v[j].y * r2 * gg.y) | ((unsigned long long)pk2(v[j].z * r2 * gg.z, v[j].w * r2 * gg.w) << 32); }
    }
}

__device__ __forceinline__ void hgrn_seq_pair(int rowbase, int h, int vg2, const float* S0, float* Sout, const bf16* QH, const float* LOGF, const bf16* KH, const bf16* VH, float* OHR, int lane) {
    const int kq = lane >> 1, vh = lane & 1, kc = h * 128 + 4 * kq, vc = h * 128 + 16 * vg2 + 4 * vh;
    f4 s[2][4], q4[4], lf[4], k4[4], v4[2][4];
#pragma unroll
    for (int u = 0; u < 2; ++u)
#pragma unroll
        for (int i = 0; i < 4; ++i) s[u][i] = *(const f4*)(S0 + (size_t)(4 * kq + i) * 128 + 16 * vg2 + 8 * u + 4 * vh);
#pragma unroll
    for (int t = 0; t < 4; ++t) { const size_t base = (size_t)(rowbase + t) * 1024; q4[t] = ld4bf(QH + base + kc); lf[t] = *(const f4*)(LOGF + base + kc); k4[t] = ld4bf(KH + base + kc);
        v4[0][t] = ld4bf(VH + base + vc); v4[1][t] = ld4bf(VH + base + vc + 8); }
#pragma unroll
    for (int t = 0; t < 4; ++t) {
        const size_t base = (size_t)(rowbase + t) * 1024;
        f4 o[2] = {(f4){0.f, 0.f, 0.f, 0.f}, (f4){0.f, 0.f, 0.f, 0.f}};
#pragma unroll
        for (int i = 0; i < 4; ++i) { const float f = __expf(lf[t][i]);
#pragma unroll
            for (int u = 0; u < 2; ++u) { s[u][i] = s[u][i] * f + v4[u][t] * k4[t][i]; o[u] += s[u][i] * q4[t][i]; } }
#pragma unroll
        for (int off = 2; off < 64; off <<= 1)
#pragma unroll
            for (int u = 0; u < 2; ++u) { o[u].x += __shfl_xor(o[u].x, off); o[u].y += __shfl_xor(o[u].y, off); o[u].z += __shfl_xor(o[u].z, off); o[u].w += __shfl_xor(o[u].w, off); }
        if (kq == 0) { *(f4*)(OHR + base + vc) = o[0]; *(f4*)(OHR + base + vc + 8) = o[1]; }
    }
#pragma unroll
    for (int u = 0; u < 2; ++u)
#pragma unroll
        for (int i = 0; i < 4; ++i) *(f4*)(Sout + (size_t)(4 * kq + i) * 128 + 16 * vg2 + 8 * u + 4 * vh) = s[u][i];
}
__device__ __forceinline__ void hgrn_finish_row(const float* orow, const bf16* grow, const float* gn, bf16* out, int lane) {
#pragma unroll
    for (int j = 0; j < 4; ++j) { const int idx = lane + 64 * j; const f4 o = ((const f4*)orow)[idx], g = ld4bf(grow + 4 * idx), w = ((const f4*)gn)[idx & 31];
        float s = (o.x * o.x + o.y * o.y) + (o.z * o.z + o.w * o.w);
#pragma unroll
        for (int off = 1; off < 32; off <<= 1) s += __shfl_xor(s, off);
        const float r = rsqrtf(s * (1.f / 128.f) + EPS);
        ((unsigned long long*)out)[idx] = (unsigned long long)pk2(o.x * r * w.x * g.x, o.y * r * w.y * g.y) | ((unsigned long long)pk2(o.z * r * w.z * g.z, o.w * r * w.w * g.w) << 32); }
}

typedef short bfx8 __attribute__((ext_vector_type(8)));
typedef short bfx4 __attribute__((ext_vector_type(4)));
__device__ __forceinline__ unsigned cvtpk(float lo, float hi) { return pg8::cvt_pk_bf16(lo, hi); }
__device__ __forceinline__ bfx8 lds_frag16(const LAS bf16* p) { return *(const LAS bfx8*)p; }
__device__ __forceinline__ bfx8 lds_frag8(const LAS bf16* p) { const bfx4 a = *(const LAS bfx4*)p, b = *(const LAS bfx4*)(p + 4); return (bfx8){a[0], a[1], a[2], a[3], b[0], b[1], b[2], b[3]}; }
__device__ __forceinline__ float bflo(unsigned w) { return __uint_as_float(w << 16); }
__device__ __forceinline__ float bfhi(unsigned w) { return __uint_as_float(w & 0xffff0000u); }
constexpr int HG_NCH = TP / 64;
constexpr int L_BF = 0, L_Q0 = 33792, L_QR = L_Q0 + 17408, L_KI = L_QR + 17408, L_VT = L_KI + 17408, L_AB = L_VT + 17408, L_TOT = L_AB + 9216, L_HEND = L_TOT + 2048;
static_assert(L_HEND <= RING_BYTES, "hgrn lds");
__device__ __forceinline__ void chunk_cumsum(const Ctx& C, const f4 (&lf)[4]) {
    LAS float* Bf = (LAS float*)(C.lds + L_BF); LAS float* tot = (LAS float*)(C.lds + L_TOT);
    __syncthreads();
#pragma unroll
    for (int j = 0; j < 4; ++j) ((LAS f4*)Bf)[C.tid + 512 * j] = lf[j];
    __syncthreads();
    const int k = C.tid & 127, qr = C.tid >> 7; float s = 0.f;
#pragma unroll
    for (int r = 0; r < 16; ++r) { s += Bf[(16 * qr + r) * 128 + k]; Bf[(16 * qr + r) * 128 + k] = s; }
    tot[qr * 128 + k] = s;
    __syncthreads();
    float off = 0.f;
    for (int q2 = 0; q2 < qr; ++q2) off += tot[q2 * 128 + k];
#pragma unroll
    for (int r = 0; r < 16; ++r) Bf[(16 * qr + r) * 128 + k] += off;
    __syncthreads();
}
__device__ __forceinline__ void hgrn_A_unit(const Ctx& C, int h, int c, const float* LOGF, const bf16* KH, const bf16* VH, float* UT, float* DD) {
    const int t0 = 64 * c, cb = h * 128;
    LAS float* Bf = (LAS float*)(C.lds + L_BF); LAS bf16* KT = (LAS bf16*)(C.lds + L_KI); LAS bf16* VT = (LAS bf16*)(C.lds + L_VT);
    f4 lf[4]; v4u kv[2], vv[2];
#pragma unroll
    for (int j = 0; j < 4; ++j) { const int idx = C.tid + 512 * j; lf[j] = *(const f4*)(LOGF + (size_t)(t0 + (idx >> 5)) * 1024 + cb + 4 * (idx & 31)); }
#pragma unroll
    for (int j = 0; j < 2; ++j) { const int idx = C.tid + 512 * j; const size_t g = (size_t)(t0 + (idx >> 4)) * 1024 + cb + 8 * (idx & 15); kv[j] = *(const v4u*)(KH + g); vv[j] = *(const v4u*)(VH + g); }
    chunk_cumsum(C, lf);
#pragma unroll
    for (int j = 0; j < 2; ++j) { const int idx = C.tid + 512 * j, s = idx >> 4, ch = 8 * (idx & 15);
        const f4 bl0 = ((const LAS f4*)Bf)[63 * 32 + (ch >> 2)], bl1 = ((const LAS f4*)Bf)[63 * 32 + (ch >> 2) + 1], bs0 = ((const LAS f4*)Bf)[s * 32 + (ch >> 2)], bs1 = ((const LAS f4*)Bf)[s * 32 + (ch >> 2) + 1];
        const unsigned kw[4] = {kv[j].x, kv[j].y, kv[j].z, kv[j].w}, vw[4] = {vv[j].x, vv[j].y, vv[j].z, vv[j].w};
        const float dl[8] = {bl0.x - bs0.x, bl0.y - bs0.y, bl0.z - bs0.z, bl0.w - bs0.w, bl1.x - bs1.x, bl1.y - bs1.y, bl1.z - bs1.z, bl1.w - bs1.w};
#pragma unroll
        for (int e = 0; e < 8; ++e) { const float kf = (e & 1) ? bfhi(kw[e >> 1]) : bflo(kw[e >> 1]);
            KT[(ch + e) * 68 + s] = (bf16)f2bf(kf * __expf(dl[e])); VT[(ch + e) * 68 + s] = (bf16)((e & 1) ? (vw[e >> 1] >> 16) : (vw[e >> 1] & 0xffffu)); } }
    if (C.tid < 128) DD[(size_t)(c * 8 + h) * 128 + C.tid] = __expf(Bf[63 * 128 + C.tid]);
    __syncthreads();
    const int w = C.wave, lane = C.lane, fr = lane & 15, kg = lane >> 4;
    pg8::f32x4 acc[8];
#pragma unroll
    for (int nt = 0; nt < 8; ++nt) acc[nt] = (pg8::f32x4){0.f, 0.f, 0.f, 0.f};
#pragma unroll
    for (int ks = 0; ks < 2; ++ks) { const bfx8 a = lds_frag8(VT + (16 * w + fr) * 68 + 32 * ks + 8 * kg);
#pragma unroll
        for (int nt = 0; nt < 8; ++nt) { const bfx8 b = lds_frag8(KT + (16 * nt + fr) * 68 + 32 * ks + 8 * kg); acc[nt] = __builtin_amdgcn_mfma_f32_16x16x32_bf16(a, b, acc[nt], 0, 0, 0); } }
    float* ut = UT + (size_t)(c * 8 + h) * 16384;
#pragma unroll
    for (int nt = 0; nt < 8; ++nt)
#pragma unroll
        for (int r = 0; r < 4; ++r) ut[(size_t)(16 * w + 4 * kg + r) * 128 + 16 * nt + fr] = acc[nt][r];
    __syncthreads();
}
__device__ __forceinline__ void hgrn_scan(int tix, int nthr, const float* UT, const float* DD, bf16* SP, float* hgp) {
    for (int e = tix; e < 8 * 16384; e += nthr) { const int h = e >> 14, vk = e & 16383, k = e & 127, v = vk >> 7;
        float S = 0.f;
        for (int c = 0; c < HG_NCH; c += 16) { float u[16], d[16];
#pragma unroll
            for (int i = 0; i < 16; ++i) { u[i] = UT[(size_t)((c + i) * 8 + h) * 16384 + vk]; d[i] = DD[(size_t)((c + i) * 8 + h) * 128 + k]; }
#pragma unroll
            for (int i = 0; i < 16; ++i) { SP[(size_t)((c + i) * 8 + h) * 16384 + vk] = (bf16)f2bf(S); S = S * d[i] + u[i]; } }
        hgp[(size_t)h * 16384 + k * 128 + v] = S; }
}
__device__ __forceinline__ void hgrn_B_unit(const Ctx& C, int h, int c, const bf16* QH, const float* LOGF, const bf16* KH, const bf16* VH, const bf16* GH, const float* gn, const bf16* SP, bf16* OHG) {
    const int t0 = 64 * c, cb = h * 128, tid = C.tid;
    LAS float* Bf = (LAS float*)(C.lds + L_BF); LAS bf16* Q0 = (LAS bf16*)(C.lds + L_Q0); LAS bf16* QR = (LAS bf16*)(C.lds + L_QR); LAS bf16* KI = (LAS bf16*)(C.lds + L_KI);
    LAS bf16* VT = (LAS bf16*)(C.lds + L_VT); LAS bf16* AB = (LAS bf16*)(C.lds + L_AB); LAS float* Of = (LAS float*)(C.lds + L_BF);
    STAMP(C, 9);
    f4 lf[4], q4[4], k4[4], b4[4]; v4u vv[2]; float gh[16];
    const int w = C.wave, lane = C.lane, fr = lane & 15, kg = lane >> 4;
#pragma unroll
    for (int j = 0; j < 4; ++j) { const int idx = tid + 512 * j; const size_t g = (size_t)(t0 + (idx >> 5)) * 1024 + cb + 4 * (idx & 31); lf[j] = *(const f4*)(LOGF + g);
        const u2 qw = *(const u2*)(QH + g), kw = *(const u2*)(KH + g); q4[j] = (f4){bflo(qw.x), bfhi(qw.x), bflo(qw.y), bfhi(qw.y)}; k4[j] = (f4){bflo(kw.x), bfhi(kw.x), bflo(kw.y), bfhi(kw.y)}; }
#pragma unroll
    for (int j = 0; j < 2; ++j) { const int idx = tid + 512 * j; vv[j] = *(const v4u*)(VH + (size_t)(t0 + (idx >> 4)) * 1024 + cb + 8 * (idx & 15)); }
#pragma unroll
    for (int rr = 0; rr < 8; ++rr) { const size_t g = (size_t)(t0 + 8 * w + rr) * 1024 + cb; gh[2 * rr] = bflo((unsigned)GH[g + lane]); gh[2 * rr + 1] = bflo((unsigned)GH[g + lane + 64]); }
    const bf16* sp = SP + (size_t)(c * 8 + h) * 16384; bfx8 spf[4][4];
#pragma unroll
    for (int ks = 0; ks < 4; ++ks)
#pragma unroll
        for (int nt = 0; nt < 4; ++nt) spf[ks][nt] = *(const bfx8*)(sp + (size_t)(16 * (4 * (w >> 2) + nt) + fr) * 128 + 32 * ks + 8 * kg);
    chunk_cumsum(C, lf);
    STAMP(C, 1);
#pragma unroll
    for (int j = 0; j < 4; ++j) { const int idx = tid + 512 * j, t = idx >> 5, c4 = idx & 31, i = t >> 4;
        const f4 q = q4[j]; b4[j] = ((const LAS f4*)Bf)[idx];
        const f4 r = i > 0 ? ((const LAS f4*)Bf)[(16 * i - 1) * 32 + c4] : (f4){0.f, 0.f, 0.f, 0.f};
        u2 w0, w1;
        w0.x = cvtpk(q.x * __expf(b4[j].x), q.y * __expf(b4[j].y)); w0.y = cvtpk(q.z * __expf(b4[j].z), q.w * __expf(b4[j].w));
        w1.x = cvtpk(q.x * __expf(b4[j].x - r.x), q.y * __expf(b4[j].y - r.y)); w1.y = cvtpk(q.z * __expf(b4[j].z - r.z), q.w * __expf(b4[j].w - r.w));
        *(LAS u2*)(Q0 + t * 136 + 4 * c4) = w0; *(LAS u2*)(QR + t * 136 + 4 * c4) = w1; }
#pragma unroll
    for (int j = 0; j < 2; ++j) { const int idx = tid + 512 * j, s = idx >> 4, ch = 8 * (idx & 15); const unsigned vw[4] = {vv[j].x, vv[j].y, vv[j].z, vv[j].w};
#pragma unroll
        for (int e = 0; e < 8; ++e) VT[(ch + e) * 68 + s] = (bf16)((e & 1) ? (vw[e >> 1] >> 16) : (vw[e >> 1] & 0xffffu)); }
    for (int e = tid; e < 64 * 72 / 2; e += 512) ((LAS unsigned*)AB)[e] = 0u;
    STAMP(C, 2);
    for (int i = 0; i < 4; ++i) {
        const f4 r = i > 0 ? ((const LAS f4*)Bf)[(16 * i - 1) * 32 + (tid & 31)] : (f4){0.f, 0.f, 0.f, 0.f};
#pragma unroll
        for (int j = 0; j < 4; ++j) if (j <= i) { const int t = (tid >> 5) + 16 * j; u2 wv;
            wv.x = cvtpk(k4[j].x * __expf(r.x - b4[j].x), k4[j].y * __expf(r.y - b4[j].y)); wv.y = cvtpk(k4[j].z * __expf(r.z - b4[j].z), k4[j].w * __expf(r.w - b4[j].w));
            *(LAS u2*)(KI + t * 136 + 4 * (tid & 31)) = wv; }
        __syncthreads();
        if (w <= i) { pg8::f32x4 a4 = (pg8::f32x4){0.f, 0.f, 0.f, 0.f};
#pragma unroll
            for (int ks = 0; ks < 4; ++ks) { const bfx8 a = lds_frag16(QR + (16 * i + fr) * 136 + 32 * ks + 8 * kg), b = lds_frag16(KI + (16 * w + fr) * 136 + 32 * ks + 8 * kg);
                a4 = __builtin_amdgcn_mfma_f32_16x16x32_bf16(a, b, a4, 0, 0, 0); }
#pragma unroll
            for (int rr = 0; rr < 4; ++rr) { const int tl = 4 * kg + rr; const float val = (w < i || fr <= tl) ? a4[rr] : 0.f; AB[(16 * i + tl) * 72 + 16 * w + fr] = (bf16)f2bf(val); } }
        __syncthreads();
    }
    STAMP(C, 3);
    const int rt = w & 3, chf = w >> 2;
    pg8::f32x4 acc[4];
#pragma unroll
    for (int nt = 0; nt < 4; ++nt) acc[nt] = (pg8::f32x4){0.f, 0.f, 0.f, 0.f};
#pragma unroll
    for (int ks = 0; ks < 4; ++ks) { const bfx8 a = lds_frag16(Q0 + (16 * rt + fr) * 136 + 32 * ks + 8 * kg);
#pragma unroll
        for (int nt = 0; nt < 4; ++nt) acc[nt] = __builtin_amdgcn_mfma_f32_16x16x32_bf16(a, spf[ks][nt], acc[nt], 0, 0, 0); }
#pragma unroll
    for (int ks = 0; ks < 2; ++ks) if (2 * ks <= rt) { const bfx8 a = lds_frag16(AB + (16 * rt + fr) * 72 + 32 * ks + 8 * kg);
#pragma unroll
        for (int nt = 0; nt < 4; ++nt) { const bfx8 b = lds_frag8(VT + (16 * (4 * chf + nt) + fr) * 68 + 32 * ks + 8 * kg); acc[nt] = __builtin_amdgcn_mfma_f32_16x16x32_bf16(a, b, acc[nt], 0, 0, 0); } }
#pragma unroll
    for (int nt = 0; nt < 4; ++nt)
#pragma unroll
        for (int rr = 0; rr < 4; ++rr) Of[(16 * rt + 4 * kg + rr) * 132 + 16 * (4 * chf + nt) + fr] = acc[nt][rr];
    __syncthreads();
#pragma unroll
    for (int rr = 0; rr < 8; ++rr) { const int row = 8 * w + rr; const float o0 = Of[row * 132 + lane], o1 = Of[row * 132 + lane + 64];
        const float rs = rsqrtf(wsum(o0 * o0 + o1 * o1) * (1.f / 128.f) + EPS); const size_t g = (size_t)(t0 + row) * 1024 + cb;
        OHG[g + lane] = (bf16)f2bf(o0 * rs * gn[lane] * gh[2 * rr]); OHG[g + lane + 64] = (bf16)f2bf(o1 * rs * gn[lane + 64] * gh[2 * rr + 1]); }
    __syncthreads();
    STAMP(C, 4);
}
typedef float f16v __attribute__((ext_vector_type(16)));
constexpr float LOG2E = 1.4426950408889634f;
constexpr int NL_KT = 0, NL_VT = 9216, NL_GS = 18432, NL_LS = NL_GS + 16384, NL_SEL = NL_LS + 16384, NL_UNI = NL_SEL + 512, NL_OACC = NL_UNI + 64, NL_END = NL_OACC + 8 * 8192;
static_assert(NL_END <= RING_BYTES, "nsa lds");
struct NsaP { const bf16* QN16; const bf16* KSL; const bf16* VSL; const bf16* KWN; const bf16* VWN; const bf16* KC16; const bf16* VC16; const float* NG; bf16* ONSA; };
__device__ __forceinline__ float ex2(float x) { return __builtin_amdgcn_exp2f(x); }
__device__ __forceinline__ void nsa_fetch(const Ctx& C, const bf16* ksrc, const bf16* vsrc, int pitch, int nvalid, v4u& kr, v4u& vr) {
    { const int key = C.tid >> 3, d8 = C.tid & 7; kr = (v4u){0u, 0u, 0u, 0u}; if (key < nvalid) kr = *(const v4u*)(ksrc + (size_t)key * pitch + 8 * d8); }
    { const int key = C.tid & 63, d8 = C.tid >> 6; vr = (v4u){0u, 0u, 0u, 0u}; if (key < nvalid) vr = *(const v4u*)(vsrc + (size_t)key * pitch + 8 * d8); }
}
__device__ __forceinline__ void nsa_put(const Ctx& C, const v4u& kr, const v4u& vr) {
    LAS bf16* KT = (LAS bf16*)(C.lds + NL_KT); LAS bf16* VT = (LAS bf16*)(C.lds + NL_VT);
    { const int key = C.tid >> 3, d8 = C.tid & 7; *(LAS v4u*)(KT + key * 72 + 8 * d8) = kr; }
    { const int key = C.tid & 63, d8 = C.tid >> 6; const v4u v = vr; LAS bf16* p = VT + (8 * d8) * 72 + key;
        p[0] = (bf16)(v.x & 0xffffu); p[72] = (bf16)(v.x >> 16); p[144] = (bf16)(v.y & 0xffffu); p[216] = (bf16)(v.y >> 16);
        p[288] = (bf16)(v.z & 0xffffu); p[360] = (bf16)(v.z >> 16); p[432] = (bf16)(v.w & 0xffffu); p[504] = (bf16)(v.w >> 16); }
}
__device__ __forceinline__ int prev_bit(const unsigned (&u)[4], int below) {
#pragma unroll
    for (int wi = 3; wi >= 0; --wi) { const int lim = below - 32 * wi; if (lim <= 0) continue; const unsigned m = lim >= 32 ? u[wi] : (u[wi] & ((1u << lim) - 1u)); if (m) return 32 * wi + 31 - __clz(m); }
    return -1;
}
template <int NT> __device__ __forceinline__ void nsa_scores_t(const LAS bf16* KT, int lane, const bfx8 (&qf)[4], int klo, int khi, float base, float inc, f16v (&s)[NT]) {
    const int q = lane & 31, hi = lane >> 5;
    int kl = klo - 4 * hi, kh = khi - 4 * hi; float bh = fmaf(inc, (float)(4 * hi), base);
    asm volatile("" : "+v"(inc), "+v"(bh), "+v"(kl), "+v"(kh));
#pragma unroll
    for (int t = 0; t < NT; ++t) { s[t] = (f16v){0.f, 0.f, 0.f, 0.f, 0.f, 0.f, 0.f, 0.f, 0.f, 0.f, 0.f, 0.f, 0.f, 0.f, 0.f, 0.f};
#pragma unroll
        for (int ks = 0; ks < 4; ++ks) { const bfx8 a = *(const LAS bfx8*)(KT + (32 * t + q) * 72 + 16 * ks + 8 * hi); s[t] = __builtin_amdgcn_mfma_f32_32x32x16_bf16(a, qf[ks], s[t], 0, 0, 0); } }
    if (__builtin_amdgcn_readfirstlane(__all(klo <= 0 && khi >= 32 * NT - 1))) {
#pragma unroll
        for (int t = 0; t < NT; ++t)
#pragma unroll
            for (int r = 0; r < 16; ++r) { const int cr = 32 * t + (r & 3) + 8 * (r >> 2); s[t][r] = s[t][r] + fmaf(inc, (float)cr, bh); }
    } else {
#pragma unroll
        for (int t = 0; t < NT; ++t)
#pragma unroll
            for (int r = 0; r < 16; ++r) { const int cr = 32 * t + (r & 3) + 8 * (r >> 2); const float v = s[t][r] + fmaf(inc, (float)cr, bh); s[t][r] = (cr >= kl && cr <= kh) ? v : -INFINITY; }
    }
}
__device__ __forceinline__ void nsa_scores(const Ctx& C, const bfx8 (&qf)[4], int klo, int khi, float base, float inc, f16v (&s)[2]) { nsa_scores_t<2>((const LAS bf16*)(C.lds + NL_KT), C.lane, qf, klo, khi, base, inc, s); }
template <int NT, int VP> __device__ __forceinline__ void nsa_block_t(const LAS bf16* KT, const LAS bf16* VT, int lane, const bfx8 (&qf)[4], int klo, int khi, float base, float inc, float& m, float& l, f16v (&O)[2]) {
    const int q = lane & 31, hi = lane >> 5;
    if (!__builtin_amdgcn_readfirstlane(__any(khi >= klo))) return;
    f16v s[NT];
    nsa_scores_t<NT>(KT, lane, qf, klo, khi, base, inc, s);
    float mx = -INFINITY;
#pragma unroll
    for (int t = 0; t < NT; ++t)
#pragma unroll
        for (int r = 0; r < 16; ++r) mx = fmaxf(mx, s[t][r]);
    mx = fmaxf(mx, __shfl_xor(mx, 32));
    const float mn = fmaxf(m, mx), alpha = ex2(m - mn); m = mn;
    float rs = 0.f;
#pragma unroll
    for (int t = 0; t < NT; ++t)
#pragma unroll
        for (int r = 0; r < 16; ++r) { const float p = ex2(s[t][r] - mn); s[t][r] = p; rs += p; }
    l = l * alpha + rs;
    if (__builtin_amdgcn_readfirstlane(__any(alpha != 1.0f))) {
#pragma unroll
        for (int dt = 0; dt < 2; ++dt) O[dt] = O[dt] * alpha; }
#pragma unroll
    for (int t = 0; t < NT; ++t)
#pragma unroll
        for (int s2 = 0; s2 < 2; ++s2) {
            union { unsigned u[4]; bfx8 v; } pb;
#pragma unroll
            for (int j = 0; j < 4; ++j) pb.u[j] = cvtpk(s[t][8 * s2 + 2 * j], s[t][8 * s2 + 2 * j + 1]);
#pragma unroll
            for (int dt = 0; dt < 2; ++dt) { const LAS bf16* vp = VT + (32 * dt + q) * VP + 32 * t + 16 * s2 + 4 * hi; const bfx4 va = *(const LAS bfx4*)vp, vb = *(const LAS bfx4*)(vp + 8); const bfx8 a = (bfx8){va[0], va[1], va[2], va[3], vb[0], vb[1], vb[2], vb[3]}; O[dt] = __builtin_amdgcn_mfma_f32_32x32x16_bf16(a, pb.v, O[dt], 0, 0, 0); }
        }
}
__device__ __forceinline__ void nsa_block(const Ctx& C, const bfx8 (&qf)[4], int klo, int khi, float base, float inc, float& m, float& l, f16v (&O)[2]) {
    nsa_block_t<2, 72>((const LAS bf16*)(C.lds + NL_KT), (const LAS bf16*)(C.lds + NL_VT), C.lane, qf, klo, khi, base, inc, m, l, O); }
__device__ __forceinline__ void nsa_prompt_unit(const Ctx& C, const NsaP& A, int qt, int n) {
    int lane = C.lane; asm volatile("" : "+v"(lane));
    const int w = C.wave, q = lane & 31, hi = lane >> 5, tl = q >> 3, g = q & 7, tok = 4 * w + tl, q0 = 32 * qt, qpos = q0 + tok, head = n * 8 + g;
    LAS float* GS = (LAS float*)(C.lds + NL_GS); LAS float* LS = (LAS float*)(C.lds + NL_LS); LAS unsigned* SEL = (LAS unsigned*)(C.lds + NL_SEL); LAS unsigned* UNI = (LAS unsigned*)(C.lds + NL_UNI);
    const float slope2 = exp2f(-0.5f * (float)(head + 1)) * LOG2E;
    bfx8 qf[4];
#pragma unroll
    for (int ks = 0; ks < 4; ++ks) qf[ks] = *(const bfx8*)(A.QN16 + (size_t)qpos * 1024 + head * 64 + 16 * ks + 8 * hi);
    const float* gates = A.NG + (size_t)qpos * 48 + head * 3;
    f16v O[2]; float m, l;
    LAS float* OA = (LAS float*)(C.lds + NL_OACC + w * 8192) + lane;
#define NP_INIT() do { m = -1e30f; l = 0.f; O[0] = (f16v){0.f, 0.f, 0.f, 0.f, 0.f, 0.f, 0.f, 0.f, 0.f, 0.f, 0.f, 0.f, 0.f, 0.f, 0.f, 0.f}; O[1] = O[0]; } while (0)
#define NP_FIN(br) do { const float lt = l + __shfl_xor(l, 32); const float sc = gates[br] / fmaxf(lt, 1e-30f); _Pragma("unroll") for (int dt = 0; dt < 2; ++dt) _Pragma("unroll") for (int r = 0; r < 16; ++r) { \
        const float pv = (br) == 0 ? 0.f : OA[(dt * 16 + r) * 64]; OA[(dt * 16 + r) * 64] = pv + O[dt][r] * sc; } l = lt; } while (0)
    __syncthreads();
    for (int i = C.tid; i < 8192; i += NTHR) GS[i] = 0.f;
    const int cmax = qpos >= 31 ? (qpos - 31) >> 4 : -1;
    const int ncb = ((q0 + 31 - 31) >> 4) / 64 + 1;
    const bf16* kc = A.KC16 + (size_t)n * 512 * 64; const bf16* vc = A.VC16 + (size_t)n * 512 * 64;
    NP_INIT();
    v4u kr, vr;
#define FETCH_C(cb_) nsa_fetch(C, kc + (size_t)(cb_) * 4096, vc + (size_t)(cb_) * 4096, 64, (NCP - 64 * (cb_)) < 64 ? (NCP - 64 * (cb_)) : 64, kr, vr)
    FETCH_C(ncb - 1);
    for (int cb = ncb - 1; cb >= 0; --cb) { const int nk = (NCP - 64 * cb) < 64 ? (NCP - 64 * cb) : 64;
        __syncthreads(); nsa_put(C, kr, vr); __syncthreads();
        if (cb > 0) FETCH_C(cb - 1);
        int khi = cmax - 64 * cb; if (khi > nk - 1) khi = nk - 1;
        nsa_block(C, qf, 0, khi, -slope2 * (float)(qpos - 31 - 1024 * cb), 16.f * slope2, m, l, O); }
    NP_FIN(0);
    { const float invl = 1.f / fmaxf(l, 1e-30f);
      FETCH_C(ncb - 1);
      for (int cb = ncb - 1; cb >= 0; --cb) { const int nk = (NCP - 64 * cb) < 64 ? (NCP - 64 * cb) : 64;
        __syncthreads(); nsa_put(C, kr, vr); __syncthreads();
        if (cb > 0) FETCH_C(cb - 1);
        int khi = cmax - 64 * cb; if (khi > nk - 1) khi = nk - 1;
        f16v s[2]; nsa_scores(C, qf, 0, khi, -slope2 * (float)(qpos - 31 - 1024 * cb), 16.f * slope2, s);
#pragma unroll
        for (int t = 0; t < 2; ++t)
#pragma unroll
            for (int a = 0; a < 4; ++a) { float p[4];
#pragma unroll
                for (int j = 0; j < 4; ++j) { float x = ex2(s[t][4 * a + j] - m) * invl; x += __shfl_xor(x, 1); x += __shfl_xor(x, 2); x += __shfl_xor(x, 4); p[j] = x; }
                if (g == 0) { const int grp = 16 * cb + 8 * t + 2 * a + hi; GS[tok * 128 + grp] = ((p[0] + p[1]) + p[2]) + p[3]; LS[tok * 128 + grp] = p[3]; } } } }
    __syncthreads();
    for (int t4 = 0; t4 < 4; ++t4) { const int tk = 4 * w + t4, qp = q0 + tk, qblk = qp >> 6;
        bool cand[2], forced[2]; unsigned u[2];
#pragma unroll
        for (int r = 0; r < 2; ++r) { const int blk = lane + 64 * r; const bool valid = blk <= qblk; const bool fz = blk == 0 || blk == qblk || blk == qblk - 1;
            const float scv = GS[tk * 128 + blk] + (blk > 0 ? LS[tk * 128 + blk - 1] : 0.f);
            forced[r] = valid && fz; cand[r] = valid && !fz; u[r] = cand[r] ? __float_as_uint(scv) : 0u; }
        const int nforced = qblk == 0 ? 1 : (qblk == 1 ? 2 : 3), need = SLCT - nforced;
        const int ncand = __popcll(__ballot(cand[0])) + __popcll(__ballot(cand[1]));
        bool sel[2];
        if (ncand <= need) { sel[0] = forced[0] || cand[0]; sel[1] = forced[1] || cand[1]; }
        else { unsigned T = 0u;
            for (int bit = 30; bit >= 0; --bit) { const unsigned c = T | (1u << bit); const int cnt = __popcll(__ballot(cand[0] && u[0] >= c)) + __popcll(__ballot(cand[1] && u[1] >= c)); if (cnt >= need) T = c; }
            const bool gt0 = cand[0] && u[0] > T, gt1 = cand[1] && u[1] > T, eq0 = cand[0] && u[0] == T, eq1 = cand[1] && u[1] == T;
            const int rem = need - (__popcll(__ballot(gt0)) + __popcll(__ballot(gt1)));
            const unsigned long long be0 = __ballot(eq0), be1 = __ballot(eq1), lt = (1ull << lane) - 1ull;
            const int i0 = __popcll(be0 & lt), i1 = __popcll(be0) + __popcll(be1 & lt);
            sel[0] = forced[0] || gt0 || (eq0 && i0 < rem); sel[1] = forced[1] || gt1 || (eq1 && i1 < rem); }
        const unsigned long long b0 = __ballot(sel[0]), b1 = __ballot(sel[1]);
        if (lane == 0) { SEL[tk * 4 + 0] = (unsigned)b0; SEL[tk * 4 + 1] = (unsigned)(b0 >> 32); SEL[tk * 4 + 2] = (unsigned)b1; SEL[tk * 4 + 3] = (unsigned)(b1 >> 32); } }
    __syncthreads();
    if (C.tid < 4) { unsigned o = 0u; for (int t = 0; t < 32; ++t) o |= SEL[t * 4 + C.tid]; UNI[C.tid] = o; }
    __syncthreads();
    const unsigned sw0 = SEL[tok * 4 + 0], sw1 = SEL[tok * 4 + 1], sw2 = SEL[tok * 4 + 2], sw3 = SEL[tok * 4 + 3];
    const unsigned un0 = UNI[0], un1 = UNI[1], un2 = UNI[2], un3 = UNI[3];
    NP_INIT();
    { const unsigned un[4] = {un0, un1, un2, un3};
#define FETCH_S(b_) nsa_fetch(C, A.KSL + (size_t)(64 * (b_)) * 128 + n * 64, A.VSL + (size_t)(64 * (b_)) * 128 + n * 64, 128, 64, kr, vr)
      int blk = prev_bit(un, 128);
      if (blk >= 0) FETCH_S(blk);
      while (blk >= 0) {
        __syncthreads(); nsa_put(C, kr, vr); __syncthreads();
        const int nb = prev_bit(un, blk); if (nb >= 0) FETCH_S(nb);
        const unsigned mw = blk < 32 ? sw0 : (blk < 64 ? sw1 : (blk < 96 ? sw2 : sw3));
        int khi = ((mw >> (blk & 31)) & 1u) ? qpos - 64 * blk : -1; if (khi > 63) khi = 63;
        nsa_block(C, qf, 0, khi, -slope2 * (float)(qpos - 64 * blk), slope2, m, l, O);
        blk = nb; } }
    NP_FIN(1);
    NP_INIT();
    { int kb0 = q0 - (WIN - 1); if (kb0 < 0) kb0 = 0; kb0 >>= 6;
#define FETCH_W(b_) nsa_fetch(C, A.KWN + (size_t)(64 * (b_)) * 128 + n * 64, A.VWN + (size_t)(64 * (b_)) * 128 + n * 64, 128, 64, kr, vr)
      FETCH_W((q0 + 31) >> 6);
      for (int kb = (q0 + 31) >> 6; kb >= kb0; --kb) {
        __syncthreads(); nsa_put(C, kr, vr); __syncthreads();
        if (kb > kb0) FETCH_W(kb - 1);
        int klo = qpos - (WIN - 1) - 64 * kb; if (klo < 0) klo = 0; int khi = qpos - 64 * kb; if (khi > 63) khi = 63;
        nsa_block(C, qf, klo, khi, -slope2 * (float)(qpos - 64 * kb), slope2, m, l, O); } }
    NP_FIN(2);
    bf16* orow = A.ONSA + (size_t)qpos * 1024 + head * 64;
#pragma unroll
    for (int dt = 0; dt < 2; ++dt)
#pragma unroll
        for (int a = 0; a < 4; ++a) { const int rb = (dt * 16 + 4 * a) * 64; u2 wv; wv.x = cvtpk(OA[rb], OA[rb + 64]); wv.y = cvtpk(OA[rb + 128], OA[rb + 192]); *(u2*)(orow + 32 * dt + 8 * a + 4 * hi) = wv; }
    __syncthreads();
#undef NP_INIT
#undef NP_FIN
#undef FETCH_C
#undef FETCH_S
#undef FETCH_W
}

struct NsaS { const bf16* QN; const float* KVO; const float* WINF; const float* NG; const float* cache; const float* cwin; const int* pt; const float* kcs; const float* vcs; bf16* ONSA; };
constexpr int SL_MW = 0, SL_LW = 2048, SL_GS = 4096, SL_LS = 6144, SL_SEL = 8192, SL_LIST = 8256, SL_CNT = 8416, SL_ROW = 8448, SL_KT = 12544, SL_VT = SL_KT + 8 * 4608, SL_END = SL_VT + 8 * 5120, SL_OW = SL_KT;
static_assert(SL_END <= RING_BYTES && SL_OW + 8 * 8192 <= SL_END, "nsa sample lds");
__device__ __forceinline__ bool ns_rows(const Ctx& C, const NsaS& A, int mode, int j, int b, int n, int slot, const float*& kp, const float*& vp) {
    if (mode == 0) { if (slot >= NCS) return false; kp = A.kcs + ((size_t)(b * 2 + n) * NCS + slot) * 64; vp = A.vcs + ((size_t)(b * 2 + n) * NCS + slot) * 64; return true; }
    if (mode == 1) { const LAS int* LIST = (const LAS int*)(C.lds + SL_LIST); const int cnt = *(const LAS int*)(C.lds + SL_CNT); const int e = 4 * j + (slot >> 6), kk = slot & 63;
        if (e >= cnt) return false; const int blk = LIST[e];
        if (blk < 32) { const float* base = A.cache + ((size_t)(A.pt[b * 16 + (blk >> 1)] * 128 + (blk & 1) * 64 + kk) * 4) * 128 + n * 64; kp = base + 256; vp = base + 384; return true; }
        if (kk >= DS) return false; const float* base = A.KVO + (size_t)(TP + b * 4 + kk) * 512 + n * 64; kp = base + 256; vp = base + 384; return true; }
    const int wi = 256 * j + slot;
    if (wi < 512) { const float* base = A.cwin + ((size_t)b * 512 + wi) * 256 + n * 64; kp = base; vp = base + 128; return true; }
    if (wi < 512 + DS) { const float* base = A.WINF + (size_t)(TP + b * 4 + wi - 512) * 256 + n * 64; kp = base; vp = base + 128; return true; }
    return false;
}
__device__ __forceinline__ void ns_stage(const Ctx& C, const NsaS& A, int mode, int j, int b, int n) {
    LAS unsigned long long* RK = (LAS unsigned long long*)(C.lds + SL_ROW); LAS unsigned long long* RV = RK + 256;
    if (C.tid < 256) { const float* kp = nullptr; const float* vp = nullptr; const bool ok = ns_rows(C, A, mode, j, b, n, C.tid, kp, vp); RK[C.tid] = ok ? (unsigned long long)kp : 0ull; RV[C.tid] = ok ? (unsigned long long)vp : 0ull; }
    __syncthreads();
    { const int slot = C.tid >> 1, half = C.tid & 1; const float* kp = (const float*)RK[slot];
      LAS bf16* dst = (LAS bf16*)(C.lds + SL_KT + (slot >> 5) * 4608) + (slot & 31) * 72 + 32 * half;
      f4 x[8];
#pragma unroll
      for (int i = 0; i < 8; ++i) x[i] = kp ? *(const f4*)(kp + 32 * half + 4 * i) : (f4){0.f, 0.f, 0.f, 0.f};
#pragma unroll
      for (int i = 0; i < 4; ++i) { v4u o; o.x = cvtpk(x[2 * i].x, x[2 * i].y); o.y = cvtpk(x[2 * i].z, x[2 * i].w); o.z = cvtpk(x[2 * i + 1].x, x[2 * i + 1].y); o.w = cvtpk(x[2 * i + 1].z, x[2 * i + 1].w); *(LAS v4u*)(dst + 8 * i) = o; } }
    { const int slot = C.tid & 255, dq = C.tid >> 8; const float* vp = (const float*)RV[slot];
      LAS bf16* dst = (LAS bf16*)(C.lds + SL_VT + (slot >> 5) * 5120) + (32 * dq) * 40 + (slot & 31);
      f4 x[8];
#pragma unroll
      for (int i = 0; i < 8; ++i) x[i] = vp ? *(const f4*)(vp + 32 * dq + 4 * i) : (f4){0.f, 0.f, 0.f, 0.f};
#pragma unroll
      for (int i = 0; i < 8; ++i) { dst[(4 * i) * 40] = (bf16)f2bf(x[i].x); dst[(4 * i + 1) * 40] = (bf16)f2bf(x[i].y); dst[(4 * i + 2) * 40] = (bf16)f2bf(x[i].z); dst[(4 * i + 3) * 40] = (bf16)f2bf(x[i].w); } }
}
__device__ __forceinline__ void nsa_sample_unit(const Ctx& C, const NsaS& A, int b, int n) {
    int lane = C.lane; asm volatile("" : "+v"(lane));
    const int w = C.wave, q = lane & 31, hi = lane >> 5, tl = q >> 3, g = q & 7, head = n * 8 + g, qpos = PASTL + tl, mrow = TP + 4 * b + tl;
    const LAS bf16* KTw = (const LAS bf16*)(C.lds + SL_KT + w * 4608); const LAS bf16* VTw = (const LAS bf16*)(C.lds + SL_VT + w * 5120);
    LAS float* MW = (LAS float*)(C.lds + SL_MW); LAS float* LW = (LAS float*)(C.lds + SL_LW); LAS float* GS = (LAS float*)(C.lds + SL_GS); LAS float* LS = (LAS float*)(C.lds + SL_LS);
    LAS unsigned* SEL = (LAS unsigned*)(C.lds + SL_SEL); LAS int* LIST = (LAS int*)(C.lds + SL_LIST); LAS int* CNT = (LAS int*)(C.lds + SL_CNT); LAS float* OW = (LAS float*)(C.lds + SL_OW);
    const float slope2 = exp2f(-0.5f * (float)(head + 1)) * LOG2E;
    bfx8 qf[4];
#pragma unroll
    for (int ks = 0; ks < 4; ++ks) qf[ks] = *(const bfx8*)(A.QN + (size_t)mrow * 1024 + head * 64 + 16 * ks + 8 * hi);
    const float* gates = A.NG + (size_t)mrow * 48 + head * 3;
    float acc4[4] = {0.f, 0.f, 0.f, 0.f}; f16v O[2]; float m, l;
#define NS_INIT() do { m = -1e30f; l = 0.f; O[0] = (f16v){0.f, 0.f, 0.f, 0.f, 0.f, 0.f, 0.f, 0.f, 0.f, 0.f, 0.f, 0.f, 0.f, 0.f, 0.f, 0.f}; O[1] = O[0]; } while (0)
#define NS_MERGE(br) do { MW[w * 64 + lane] = m; LW[w * 64 + lane] = l; _Pragma("unroll") for (int dt = 0; dt < 2; ++dt) _Pragma("unroll") for (int r = 0; r < 16; ++r) OW[(w * 32 + dt * 16 + r) * 64 + lane] = O[dt][r]; \
        __syncthreads(); float M_ = -1e30f; _Pragma("unroll") for (int w2 = 0; w2 < 8; ++w2) M_ = fmaxf(M_, MW[w2 * 64 + lane]); float L_ = 0.f, o_[4] = {0.f, 0.f, 0.f, 0.f}; \
        _Pragma("unroll") for (int w2 = 0; w2 < 8; ++w2) { const float sc_ = ex2(MW[w2 * 64 + lane] - M_); L_ += (LW[w2 * 64 + lane] + LW[w2 * 64 + (lane ^ 32)]) * sc_; \
            _Pragma("unroll") for (int r = 0; r < 4; ++r) o_[r] += OW[(w2 * 32 + 4 * w + r) * 64 + lane] * sc_; } \
        const float gs_ = gates[br] / fmaxf(L_, 1e-30f); _Pragma("unroll") for (int r = 0; r < 4; ++r) acc4[r] += o_[r] * gs_; __syncthreads(); } while (0)
    __syncthreads();
    for (int i = C.tid; i < 1024; i += NTHR) GS[i] = 0.f;
    ns_stage(C, A, 0, 0, b, n);
    __syncthreads();
    { int khi = (NCS - 1) - 32 * w; if (khi > 31) khi = 31; const float base = -slope2 * (float)(qpos - 31 - 512 * w), inc = 16.f * slope2;
      NS_INIT(); nsa_block_t<1, 40>(KTw, VTw, lane, qf, 0, khi, base, inc, m, l, O);
      MW[w * 64 + lane] = m; LW[w * 64 + lane] = l;
      __syncthreads();
      float M_ = -1e30f;
#pragma unroll
      for (int w2 = 0; w2 < 8; ++w2) M_ = fmaxf(M_, MW[w2 * 64 + lane]);
      float L_ = 0.f;
#pragma unroll
      for (int w2 = 0; w2 < 8; ++w2) L_ += (LW[w2 * 64 + lane] + LW[w2 * 64 + (lane ^ 32)]) * ex2(MW[w2 * 64 + lane] - M_);
      const float invl = 1.f / fmaxf(L_, 1e-30f);
      f16v s[1]; nsa_scores_t<1>(KTw, lane, qf, 0, khi, base, inc, s);
#pragma unroll
      for (int a = 0; a < 4; ++a) { float p[4];
#pragma unroll
          for (int jj = 0; jj < 4; ++jj) { float x = ex2(s[0][4 * a + jj] - M_) * invl; x += __shfl_xor(x, 1); x += __shfl_xor(x, 2); x += __shfl_xor(x, 4); p[jj] = x; }
          if (g == 0) { const int grp = 8 * w + 2 * a + hi; GS[tl * 128 + grp] = ((p[0] + p[1]) + p[2]) + p[3]; LS[tl * 128 + grp] = p[3]; } }
      __syncthreads();
      NS_MERGE(0); }
    if (w == 0) {
        unsigned long long uni = 0ull;
#pragma unroll 1
        for (int t4 = 0; t4 < 4; ++t4) { const int blk = lane; const bool valid = blk < NSS, fz = blk == 0 || blk == NSS - 1 || blk == NSS - 2; const bool cand = valid && !fz, forced = valid && fz;
            const float scv = valid ? GS[t4 * 128 + blk] + (blk > 0 ? LS[t4 * 128 + blk - 1] : 0.f) : 0.f; const unsigned u = cand ? __float_as_uint(scv) : 0u;
            const int need = SLCT - 3; unsigned T = 0u;
            for (int bit = 30; bit >= 0; --bit) { const unsigned c = T | (1u << bit); if (__popcll(__ballot(cand && u >= c)) >= need) T = c; }
            const bool gt = cand && u > T, eq = cand && u == T; const int rem = need - __popcll(__ballot(gt)); const unsigned long long be = __ballot(eq), lt = (1ull << lane) - 1ull;
            const bool sel = forced || gt || (eq && __popcll(be & lt) < rem); const unsigned long long bs = __ballot(sel);
            if (lane == 0) { SEL[t4 * 2] = (unsigned)bs; SEL[t4 * 2 + 1] = (unsigned)(bs >> 32); } uni |= bs; }
        const bool on = (uni >> lane) & 1ull; const int pos = __popcll(uni & ((1ull << lane) - 1ull)); if (on) LIST[pos] = lane; if (lane == 0) CNT[0] = __popcll(uni);
    }
    __syncthreads();
    { const int cnt = CNT[0]; const unsigned long long mysel = (unsigned long long)SEL[tl * 2] | ((unsigned long long)SEL[tl * 2 + 1] << 32);
      NS_INIT();
#pragma unroll 1
      for (int j = 0; 4 * j < cnt; ++j) { ns_stage(C, A, 1, j, b, n); __syncthreads();
          const int e = 4 * j + (w >> 1), sub = w & 1; int khi = -1, blk = 0;
          if (e < cnt) { blk = LIST[e]; if ((mysel >> blk) & 1ull) khi = blk < 32 ? 31 : (sub == 0 ? (tl < DS - 1 ? tl : DS - 1) : -1); }
          nsa_block_t<1, 40>(KTw, VTw, lane, qf, 0, khi, -slope2 * (float)(qpos - 64 * blk - 32 * sub), slope2, m, l, O);
          __syncthreads(); }
      NS_MERGE(1); }
    { NS_INIT();
#pragma unroll 1
      for (int j = 0; j < 3; ++j) { ns_stage(C, A, 2, j, b, n); __syncthreads();
          const int w0 = 256 * j + 32 * w; int klo = tl + 1 - w0; if (klo < 0) klo = 0; int khi = 512 + tl - w0; if (khi > 31) khi = 31;
          nsa_block_t<1, 40>(KTw, VTw, lane, qf, klo, khi, -slope2 * (float)(qpos - (PASTL - 512) - w0), slope2, m, l, O);
          __syncthreads(); }
      NS_MERGE(2); }
    { u2 wv; wv.x = cvtpk(acc4[0], acc4[1]); wv.y = cvtpk(acc4[2], acc4[3]); *(u2*)(A.ONSA + (size_t)mrow * 1024 + head * 64 + 32 * (w >> 2) + 8 * (w & 3) + 4 * hi) = wv; }
#undef NS_INIT
#undef NS_MERGE
}

__device__ __forceinline__ void cmp_convert_cache(const Ctx& C, const float* cache, const int* pt, bf16* CA) {
    const size_t NIT = (size_t)DB * 2048 * 32, stride = (size_t)C.G * NTHR;
    for (size_t i0 = (size_t)C.bid * NTHR + C.tid; i0 < NIT; i0 += 4 * stride) {
        f4 a[4], c[4]; size_t dsto[4]; bool ok[4];
#pragma unroll
        for (int k = 0; k < 4; ++k) { const size_t i = i0 + k * stride; ok[k] = i < NIT; const size_t ii = ok[k] ? i : 0;
            const int d8 = (int)(ii & 7), n = (int)(ii >> 3) & 1, type = (int)(ii >> 4) & 1; const size_t bp = ii >> 5; const int pos = (int)(bp & 2047), b = (int)(bp >> 11);
            const float* src = cache + ((size_t)(pt[b * 16 + (pos >> 7)] * 128 + (pos & 127)) * 4 + type) * 128 + n * 64 + 8 * d8;
            a[k] = *(const f4*)src; c[k] = *(const f4*)(src + 4); dsto[k] = ((size_t)((type * 128 + b) * 2 + n) * 2048 + pos) * 64 + 8 * d8; }
#pragma unroll
        for (int k = 0; k < 4; ++k) if (ok[k]) { v4u o; o.x = pk2(a[k].x, a[k].y); o.y = pk2(a[k].z, a[k].w); o.z = pk2(c[k].x, c[k].y); o.w = pk2(c[k].z, c[k].w); *(v4u*)(CA + dsto[k]) = o; }
    }
}
__device__ __forceinline__ void cmp_stage2(int widx, int nw, int lane, const bf16* HID, const bf16* W2T, float* KCS_, float* VCS_, bf16* KC16_, bf16* VC16_) {
    const int fr = lane & 15, kg = lane >> 4;
    for (int it = widx; it < CMP_ROWS / 16; it += nw) { const int r0 = 16 * it; const bool smp = r0 < CMP_ROWS_S;
        const int type = smp ? (r0 >= CMP_ROWS_S / 2) : ((r0 - CMP_ROWS_S) >= CMP_ROWS_P / 2);
        pg8::f32x4 acc[4];
#pragma unroll
        for (int nt = 0; nt < 4; ++nt) acc[nt] = (pg8::f32x4){0.f, 0.f, 0.f, 0.f};
#pragma unroll
        for (int ks = 0; ks < 8; ++ks) { const bfx8 a = *(const bfx8*)(HID + (size_t)(r0 + fr) * 256 + 32 * ks + 8 * kg);
#pragma unroll
            for (int nt = 0; nt < 4; ++nt) { const bfx8 b = *(const bfx8*)(W2T + ((size_t)type * 64 + 16 * nt + fr) * 256 + 32 * ks + 8 * kg); acc[nt] = __builtin_amdgcn_mfma_f32_16x16x32_bf16(a, b, acc[nt], 0, 0, 0); } }
#pragma unroll
        for (int rr = 0; rr < 4; ++rr) { const int r = r0 + 4 * kg + rr;
            if (smp) { const int c = r & 127, bn = (r >> 7) & 255; if (c < NCS) { float* dst = (type ? VCS_ : KCS_) + ((size_t)bn * NCS + c) * 64;
#pragma unroll
                    for (int nt = 0; nt < 4; ++nt) dst[16 * nt + fr] = acc[nt][rr]; } }
            else { const int rp = r - CMP_ROWS_S, c = rp & 511, n = (rp >> 9) & 1; if (c < NCP) { bf16* dst = (type ? VC16_ : KC16_) + ((size_t)n * 512 + c) * 64;
#pragma unroll
                    for (int nt = 0; nt < 4; ++nt) dst[16 * nt + fr] = (bf16)f2bf(acc[nt][rr]); } } }
    }
}

__device__ __forceinline__ float sgm(float x) { return __builtin_amdgcn_rcpf(1.f + __expf(-x)); }
__device__ __forceinline__ void mix_sample_row(const bf16* ga, const bf16* gb, const float* slab, bf16* mix, int lane) {
#pragma unroll 2
    for (int j = 0; j < 8; ++j) { const int idx = lane + 64 * j; f4 pacc = ((const f4*)slab)[idx], qacc = ((const f4*)slab)[idx + 4 * (SLABSZ / 4)];
#pragma unroll
        for (int k = 1; k < 4; ++k) { pacc += ((const f4*)slab)[idx + (size_t)k * (SLABSZ / 4)]; qacc += ((const f4*)slab)[idx + (size_t)(4 + k) * (SLABSZ / 4)]; }
        const f4 a = ld4bf(ga + 4 * idx), b = ld4bf(gb + 4 * idx);
        const f4 r = (f4){sgm(a.x) * pacc.x + sgm(b.x) * qacc.x, sgm(a.y) * pacc.y + sgm(b.y) * qacc.y, sgm(a.z) * pacc.z + sgm(b.z) * qacc.z, sgm(a.w) * pacc.w + sgm(b.w) * qacc.w};
        ((unsigned long long*)mix)[idx] = (unsigned long long)pk2(r.x, r.y) | ((unsigned long long)pk2(r.z, r.w) << 32); }
}

__device__ __forceinline__ void win_copy(const float* cache_win, float* wins, size_t tix, size_t nthr) {
    const size_t NF = (size_t)DB * 508 * 64;
    for (size_t i0 = tix; i0 < NF; i0 += 4 * nthr) { f4 v[4];
#pragma unroll
        for (int k = 0; k < 4; ++k) { const size_t i = i0 + k * nthr; if (i < NF) { const size_t b = i / (508 * 64), r = i % (508 * 64); v[k] = ((const f4*)cache_win)[b * 512 * 64 + 4 * 64 + r]; } }
#pragma unroll
        for (int k = 0; k < 4; ++k) { const size_t i = i0 + k * nthr; if (i < NF) { const size_t b = i / (508 * 64), r = i % (508 * 64); ((f4*)wins)[b * 512 * 64 + r] = v[k]; } } }
}
constexpr int NPHASE = 15;
#if PROBE_MASK
#define PSUB(id, ...) do { __syncthreads(); const unsigned long long ts_ = __builtin_amdgcn_s_memrealtime(); __VA_ARGS__ __syncthreads(); if (PROBE_SUB == (id)) pr_acc += __builtin_amdgcn_s_memrealtime() - ts_; } while (0)
#else
#define PSUB(id, ...) do { __VA_ARGS__ } while (0)
#endif
struct Args { const void* in[30]; float* out; unsigned char* ws; int ph_lo, ph_hi; };
__global__ void __launch_bounds__(NTHR, 2) mk_fwd(Args args) {
    extern __shared__ __attribute__((aligned(16))) unsigned char lds_raw[];
#define MKCTX() Ctx C; C.lds = (LAS unsigned char*)lds_raw; C.tid = threadIdx.x; asm volatile("" : "+v"(C.tid)); C.lane = C.tid & 63; C.wave = __builtin_amdgcn_readfirstlane(C.tid >> 6); \
    C.G = gridDim.x; C.bid = blockIdx.x; C.gw = C.bid * NWAVES + C.wave; C.NGW = C.G * NWAVES;
    LAS unsigned char* const lds0 = (LAS unsigned char*)lds_raw;
    unsigned char* ws = args.ws; float* out = args.out;
    gu32* ctl = (gu32*)(ws + WS_CTL);
    volatile LAS unsigned* MISC = (volatile LAS unsigned*)(lds0 + MISC_OFF);
    for (int u = threadIdx.x; u < (LDS_BYTES - LDSCTL_OFF) / 4; u += NTHR) ((LAS unsigned*)(lds0 + LDSCTL_OFF))[u] = 0u;
    __syncthreads();
    const int lo = args.ph_lo, hi = args.ph_hi;
    XcdBarrier bar; bar.bar = (unsigned*)(ctl + CW_BAR); bar.x = 0; bar.st = nullptr;
    if (hi - lo > 1) bar = xcd_barrier_post((unsigned*)(ctl + CW_BAR), MISC + 8);
#define IN(k) (lo <= (k) && (k) < hi)
#if PROBE_MASK
    unsigned long long pr_t = __builtin_amdgcn_s_memrealtime(), pr_acc = 0ull;
#define SEAM(k) do { if (IN(k) && IN((k) + 1)) xcd_barrier(bar); { const unsigned long long t_ = __builtin_amdgcn_s_memrealtime(); if ((PROBE_MASK >> (k)) & 1) pr_acc += t_ - pr_t; pr_t = t_; } } while (0)
#else
#define SEAM(k) do { if (IN(k) && IN((k) + 1)) xcd_barrier(bar); } while (0)
#endif
#define x_p ((const float*)args.in[0])
#define x_s ((const float*)args.in[1])
#define cache_kv ((const float*)args.in[2])
#define cache_win ((const float*)args.in[3])
#define state_hgrn ((const float*)args.in[4])
#define page_table ((const int*)args.in[5])
#define n_pre1 ((const float*)args.in[6])
#define n_post1 ((const float*)args.in[7])
#define n_pre2 ((const float*)args.in[11])
#define n_post2 ((const float*)args.in[12])
#define n_pre3 ((const float*)args.in[25])
#define n_post3 ((const float*)args.in[26])
#define hg_lb ((const float*)args.in[14])
#define hg_gnorm ((const float*)args.in[15])
#define W1GU ((bf16*)(ws + WS_W1GU))
#define W1D ((bf16*)(ws + WS_W1D))
#define W2GU ((bf16*)(ws + WS_W2GU))
#define W2D ((bf16*)(ws + WS_W2D))
#define WINt ((bf16*)(ws + WS_WIN))
#define WPH ((bf16*)(ws + WS_WPH))
#define WPN ((bf16*)(ws + WS_WPN))
#define WOt ((bf16*)(ws + WS_WO))
#define XN ((bf16*)(ws + WS_XN))
#define HB ((bf16*)(ws + WS_HB))
#define Y ((bf16*)(ws + WS_Y))
#define LOGF ((float*)(ws + WS_LOGF))
#define WINF ((float*)(ws + WS_WINF))
#define NG ((float*)(ws + WS_NG))
#define GA ((bf16*)(ws + WS_GA))
#define GB ((bf16*)(ws + WS_GB))
#define KCS ((float*)(ws + WS_KCS))
#define VCS ((float*)(ws + WS_VCS))
#define CB ((float*)(ws + WS_CB))
#define OHR ((float*)(ws + WS_OHR))
#define OHG ((bf16*)(ws + WS_OHG))
#define ONSA ((bf16*)(ws + WS_ONSA))
#define T1 ((bf16*)(ws + WS_T1))
#define MIX ((bf16*)(ws + WS_MIX))
#define UT ((float*)(ws + WS_UT))
#define DD ((float*)(ws + WS_DD))
#define SP ((bf16*)(ws + WS_SP))
#define CA ((bf16*)(ws + WS_CA))
#define HID ((bf16*)(ws + WS_HID))
#define W1C ((bf16*)(ws + WS_W1C))
#define W2C ((bf16*)(ws + WS_W2C))
#define SLAB ((float*)(ws + WS_SLAB))
#define RS ((float*)(ws + WS_RS))
#define QH16 ((bf16*)(ws + WS_QH16))
#define KH16 ((bf16*)(ws + WS_KH16))
#define VH16 ((bf16*)(ws + WS_VH16))
#define GH16 ((bf16*)(ws + WS_GH16))
#define QN16 ((bf16*)(ws + WS_QN16))
#define KSL ((bf16*)(ws + WS_KSL))
#define VSL ((bf16*)(ws + WS_VSL))
#define KWN ((bf16*)(ws + WS_KWN))
#define VWN ((bf16*)(ws + WS_VWN))
#define KC16 ((bf16*)(ws + WS_KC16))
#define VC16 ((bf16*)(ws + WS_VC16))
#define KVO ((float*)(out + O_KV))
#define WINP ((float*)(out + O_WINP))
#define WINS ((float*)(out + O_WINS))
    if (IN(0)) { MKCTX();
        if ((C.gw & 15) == 0 && (C.gw >> 4) < 128) { const int task = C.gw >> 4, type = task >> 6, j4 = task & 63;   const float* pos = (const float*)args.in[type ? 19 : 16]; const float* w1 = (const float*)args.in[type ? 20 : 17];
            f4 s = (f4){0.f, 0.f, 0.f, 0.f};
#pragma unroll 8
            for (int k = 0; k < 32; ++k) { const int i = C.lane + 64 * k; s += *(const f4*)(w1 + (size_t)i * 256 + 4 * j4) * pos[i]; }
            s.x = wsum(s.x); s.y = wsum(s.y); s.z = wsum(s.z); s.w = wsum(s.w);
            if (C.lane == 0) *(f4*)(CB + type * 256 + 4 * j4) = s; }
        PSUB(11, tr_run(args.in, ws, (LAS unsigned*)(C.lds + C.wave * 16384), 0, 7, C.gw, C.NGW, C.lane); );
        for (int i = C.bid * NTHR + C.tid; i < (DINP - DIN) * DM / 8; i += C.G * NTHR) ((v4u*)(WINt + (size_t)DIN * DM))[i] = (v4u){0u, 0u, 0u, 0u};
        PSUB(12, cmp_convert_cache(C, cache_kv, page_table, CA); );
        PSUB(13, for (int m = C.gw; m < M; m += C.NGW) rms_row_to_bf16(m < TP ? x_p + (size_t)m * DM : x_s + (size_t)(m - TP) * DM, n_pre1, XN + (size_t)m * DM, C.lane); );
    }
    SEAM(0);
    if (IN(1)) { MKCTX(); pg8::Gemm g{XN, W1GU, M, 2 * FF, DM, DM, DM}; pg8::StaticOrder S; S.init(M, 2 * FF, C.G, C.bid); pg8::EpiSwiglu E{HB, FF};
        pg8::gemm_phase<pg8::EpiSwiglu, pg8::StaticOrder, true>(C.lds + RING_OFF, g, S, E);
        { constexpr int rem = ((M / 256) * (2 * FF / 256)) % 256;
          if (C.G == 256 && C.bid >= rem) tr_run(args.in, ws, (LAS unsigned*)(C.lds + C.wave * 16384), 7, 8, (C.bid - rem) * NWAVES + C.wave, (256 - rem) * NWAVES, C.lane);
          else if (C.G != 256) tr_run(args.in, ws, (LAS unsigned*)(C.lds + C.wave * 16384), 7, 8, C.gw, C.NGW, C.lane); } }
    SEAM(1);
    if (IN(2)) { MKCTX(); pg8::SplitSched S; S.S.init(TP, DM, C.G, C.bid); S.A = (const char*)HB; S.B = (const char*)W1D; S.lda = FF; S.ldb = FF; S.K = FF; S.NS = 16; S.bid = C.bid;
        pg8::EpiDual<pg8::EpiY16> E{pg8::EpiY16{Y, DM}, SLAB}; pg8::gemm_phase_g<pg8::EpiDual<pg8::EpiY16>, pg8::SplitSched, true>(C.lds + RING_OFF, FF, FF, S, E); }
    SEAM(2);
    if (IN(3)) { MKCTX(); for (int m = C.gw; m < M; m += C.NGW) norm_mid_row(m < TP ? (const void*)(Y + (size_t)m * DM) : (const void*)(SLAB + (size_t)(m - TP) * DM), m < TP ? x_p + (size_t)m * DM : x_s + (size_t)(m - TP) * DM, nullptr, nullptr, 0.f,
            n_post1, 0.5f, nullptr, n_pre2, XN + (size_t)m * DM, RS + m, C.lane, m < TP ? 0 : 16); }
    SEAM(3);
    if (IN(4)) { MKCTX(); pg8::Gemm g{XN, WINt, M, DINP, DM, DM, DM}; pg8::StaticOrder S; S.init(M, DINP, C.G, C.bid);
        pg8::EpiInProj E{ws, out, hg_lb};
        pg8::gemm_phase<pg8::EpiInProj, pg8::StaticOrder, true>(C.lds + RING_OFF, g, S, E);
        { constexpr int rem = ((M / 256) * (DINP / 256)) % 256;
          if (C.G == 256 && C.bid >= rem) tr_run(args.in, ws, (LAS unsigned*)(C.lds + C.wave * 16384), 8, 10, (C.bid - rem) * NWAVES + C.wave, (256 - rem) * NWAVES, C.lane);
          else if (C.G != 256) tr_run(args.in, ws, (LAS unsigned*)(C.lds + C.wave * 16384), 8, 10, C.gw, C.NGW, C.lane); } }
    SEAM(4);
    if (IN(5)) { MKCTX();
        { pg8::Gemm g{CA, W1C, CMP_ROWS, 512, 2048, 1024, 2048}; pg8::CmpOrder S{C.G, C.bid}; pg8::EpiCmp E{CB, HID};
          pg8::gemm_phase<pg8::EpiCmp, pg8::CmpOrder, true>(C.lds + RING_OFF, g, S, E); }
        if (C.bid >= 8) for (int u = C.bid - 8; u < 8 * HG_NCH; u += C.G - 8) hgrn_A_unit(C, u & 7, u >> 3, LOGF, KH16, VH16, UT, DD);
    }
    SEAM(5);
    if (IN(6)) { MKCTX();
        if (C.wave < 4) { const int widx = C.bid * 4 + C.wave, nw = C.G * 4;
            cmp_stage2(widx, nw, C.lane, HID, W2C, KCS, VCS, KC16, VC16);
            for (int v = widx; v < DB * 64; v += nw) { const int b = v >> 6, h = (v >> 3) & 7, vg2 = v & 7;
                hgrn_seq_pair(TP + b * 4, h, vg2, state_hgrn + (size_t)b * 131072 + (size_t)h * 16384, out + O_HGS + (size_t)b * 131072 + (size_t)h * 16384, QH16, LOGF, KH16, VH16, OHR, C.lane); }
            hgrn_scan(C.bid * 256 + C.tid, C.G * 256, UT, DD, SP, out + O_HGP);
        } else tr_run(args.in, ws, (LAS unsigned*)(C.lds + C.wave * 16384), 10, 14, C.bid * 4 + (C.wave - 4), C.G * 4, C.lane);
    }
    SEAM(6);
    if (IN(7)) { MKCTX();
        for (int m = TP + C.gw; m < M; m += C.NGW) hgrn_finish_row(OHR + (size_t)m * 1024, GH16 + (size_t)m * 1024, hg_gnorm, OHG + (size_t)m * 1024, C.lane);
        NsaP AP{QN16, KSL, VSL, KWN, VWN, KC16, VC16, NG, ONSA};
        NsaS AS{QN16, KVO, WINF, NG, cache_kv, cache_win, page_table, KCS, VCS, ONSA};
        LAS int* qslot = (LAS int*)(C.lds + MISC_OFF + 128);
#define QUEUE_LOOP(word, count, ...) for (;;) { __syncthreads(); if (C.tid == 0) qslot[0] = (int)__hip_atomic_fetch_add(ctl + (word), 1u, __ATOMIC_RELAXED, __HIP_MEMORY_SCOPE_AGENT); __syncthreads(); \
            const int it = qslot[0]; if (it >= (count)) break; __VA_ARGS__ }
        QUEUE_LOOP(CW_Q7, 512, nsa_prompt_unit(C, AP, 255 - (it >> 1), it & 1); )
        QUEUE_LOOP(CW_Q7 + 64, 2 * DB, nsa_sample_unit(C, AS, it >> 1, it & 1); )
        QUEUE_LOOP(CW_Q7 + 128, 8 * HG_NCH, hgrn_B_unit(C, it & 7, it >> 3, QH16, LOGF, KH16, VH16, GH16, hg_gnorm, SP, OHG); )
    }
    SEAM(7);
    if (IN(8)) { MKCTX(); pg8::ProjSched S; S.S.init(TP, DM, C.G, C.bid); S.Ah = (const char*)OHG; S.An = (const char*)ONSA; S.Bh = (const char*)WPH; S.Bn = (const char*)WPN; S.bid = C.bid;
        pg8::EpiProj E{pg8::EpiGate1{GA, T1, DM}, pg8::EpiGate2{GB, T1, MIX, DM}, SLAB}; pg8::gemm_phase_g<pg8::EpiProj, pg8::ProjSched, true>(C.lds + RING_OFF, 1024, 1024, S, E); }
    SEAM(8);
    if (IN(9)) { MKCTX(); for (int m = TP + C.gw; m < M; m += C.NGW) mix_sample_row(GA + (size_t)m * DM, GB + (size_t)m * DM, SLAB + (size_t)(m - TP) * DM, MIX + (size_t)m * DM, C.lane); }
    SEAM(9);
    if (IN(10)) { MKCTX(); pg8::SplitSched S; S.S.init(TP, DM, C.G, C.bid); S.A = (const char*)MIX; S.B = (const char*)WOt; S.lda = DM; S.ldb = DM; S.K = DM; S.NS = 8; S.bid = C.bid;
        pg8::EpiDual<pg8::EpiY16> E{pg8::EpiY16{Y, DM}, SLAB}; pg8::gemm_phase_g<pg8::EpiDual<pg8::EpiY16>, pg8::SplitSched, true>(C.lds + RING_OFF, DM, DM, S, E); }
    SEAM(10);
    if (IN(11)) { MKCTX(); for (int m = C.gw; m < M; m += C.NGW) norm_mid_row(m < TP ? (const void*)(Y + (size_t)m * DM) : (const void*)(SLAB + (size_t)(m - TP) * DM), nullptr, XN + (size_t)m * DM, n_pre2, RS[m],
            n_post2, 1.0f, nullptr, n_pre3, XN + (size_t)m * DM, RS + m, C.lane, m < TP ? 0 : 8); }
    SEAM(11);
    if (IN(12)) { MKCTX(); pg8::Gemm g{XN, W2GU, M, 2 * FF, DM, DM, DM}; pg8::StaticOrder S; S.init(M, 2 * FF, C.G, C.bid); pg8::EpiSwiglu E{HB, FF};
        pg8::gemm_phase<pg8::EpiSwiglu, pg8::StaticOrder, true>(C.lds + RING_OFF, g, S, E);
        { constexpr int rem = ((M / 256) * (2 * FF / 256)) % 256;
          if (C.G == 256 && C.bid >= rem) win_copy(cache_win, WINS, (size_t)(C.bid - rem) * NTHR + C.tid, (size_t)(256 - rem) * NTHR);
          else if (C.G != 256) win_copy(cache_win, WINS, (size_t)C.bid * NTHR + C.tid, (size_t)C.G * NTHR); } }
    SEAM(12);
    if (IN(13)) { MKCTX(); pg8::SplitSched S; S.S.init(TP, DM, C.G, C.bid); S.A = (const char*)HB; S.B = (const char*)W2D; S.lda = FF; S.ldb = FF; S.K = FF; S.NS = 16; S.bid = C.bid;
        pg8::EpiDual<pg8::EpiY16> E{pg8::EpiY16{Y, DM}, SLAB}; pg8::gemm_phase_g<pg8::EpiDual<pg8::EpiY16>, pg8::SplitSched, true>(C.lds + RING_OFF, FF, FF, S, E); }
    SEAM(13);
    if (IN(14)) { MKCTX(); for (int m = C.gw; m < M; m += C.NGW) norm_mid_row(m < TP ? (const void*)(Y + (size_t)m * DM) : (const void*)(SLAB + (size_t)(m - TP) * DM), nullptr, XN + (size_t)m * DM, n_pre3, RS[m],
            n_post3, 0.5f, out + O_Y + (size_t)m * DM, nullptr, nullptr, nullptr, C.lane, m < TP ? 0 : 16); }
#if PROBE_MASK
    { const unsigned long long t_ = __builtin_amdgcn_s_memrealtime(); if ((PROBE_MASK >> 14) & 1) pr_acc += t_ - pr_t;
      if (PROBE_SUB >= 32) pr_acc += ((volatile LAS unsigned long long*)(lds0 + MISC_OFF + 256))[PROBE_SUB - 32];
      if (blockIdx.x == 0) { const unsigned long long t0_ = __builtin_amdgcn_s_memrealtime(); while (__builtin_amdgcn_s_memrealtime() - t0_ < PROBE_K * pr_acc) __builtin_amdgcn_s_sleep(8); } }
#endif
#undef IN
#undef SEAM
#undef MKCTX
#undef QUEUE_LOOP
#undef x_p
#undef x_s
#undef cache_kv
#undef cache_win
#undef state_hgrn
#undef page_table
#undef n_pre1
#undef n_post1
#undef n_pre2
#undef n_post2
#undef n_pre3
#undef n_post3
#undef hg_lb
#undef hg_gnorm
#undef W1GU
#undef W1D
#undef W2GU
#undef W2D
#undef WINt
#undef WPH
#undef WPN
#undef WOt
#undef XN
#undef HB
#undef Y
#undef LOGF
#undef WINF
#undef NG
#undef GA
#undef GB
#undef KCS
#undef VCS
#undef CB
#undef OHR
#undef OHG
#undef ONSA
#undef T1
#undef MIX
#undef UT
#undef DD
#undef SP
#undef CA
#undef HID
#undef W1C
#undef W2C
#undef SLAB
#undef RS
#undef QH16
#undef KH16
#undef VH16
#undef GH16
#undef QN16
#undef KSL
#undef VSL
#undef KWN
#undef VWN
#undef KC16
#undef VC16
#undef KVO
#undef WINP
#undef WINS
}

#ifndef MK_ONE_LAUNCH
#define MK_ONE_LAUNCH 1
#endif
extern "C" void kernel_launch(void* const* d_in, const int* in_sizes, int n_in, void* d_out, int out_size, void* d_ws, size_t ws_size, hipStream_t stream) {
    static int grid = 0;
    if (grid == 0) {
        if (n_in != 30 || out_size != (int)O_END || ws_size < WS_END) { fprintf(stderr, "kernel_launch: unexpected sizes (n_in %d out %d ws %zu)\n", n_in, out_size, ws_size); grid = -1; return; }
        int dev = 0, cus = 0, per_cu = 0;
        if (hipGetDevice(&dev) != hipSuccess || hipDeviceGetAttribute(&cus, hipDeviceAttributeMultiprocessorCount, dev) != hipSuccess) { grid = -1; return; }
        if (hipFuncSetAttribute((const void*)mk_fwd, hipFuncAttributeMaxDynamicSharedMemorySize, LDS_BYTES) != hipSuccess) { fprintf(stderr, "kernel_launch: hipFuncSetAttribute failed\n"); grid = -1; return; }
        if (hipOccupancyMaxActiveBlocksPerMultiprocessor(&per_cu, (const void*)mk_fwd, NTHR, LDS_BYTES) != hipSuccess || per_cu < 1) { fprintf(stderr, "kernel_launch: occupancy query says %d\n", per_cu); }
        (void)hipGetLastError();
        grid = cus;
    }
    if (grid < 0) return;
    (void)hipMemsetAsync((char*)d_ws + WS_CTL, 0, CTL_ZERO_BYTES, stream);
    Args a{};
    for (int i = 0; i < 30; ++i) a.in[i] = d_in[i];
    a.out = (float*)d_out; a.ws = (unsigned char*)d_ws;
#if MK_ONE_LAUNCH
    a.ph_lo = 0; a.ph_hi = NPHASE;
    hipLaunchKernelGGL(mk_fwd, dim3(grid), dim3(NTHR), LDS_BYTES, stream, a);
#else
    for (int p = 0; p < NPHASE; ++p) { a.ph_lo = p; a.ph_hi = p + 1; hipLaunchKernelGGL(mk_fwd, dim3(grid), dim3(NTHR), LDS_BYTES, stream, a); }
#endif
}
```

```cpp
#include <hip/hip_runtime.h>
#include <cstdio>
#include <cstdint>
#ifndef PROBE_MASK
#define PROBE_MASK 0
#endif
#ifndef PROBE_K
#define PROBE_K 1
#endif
#ifndef PROBE_SUB
#define PROBE_SUB 0
#endif
#if PROBE_MASK
#define STAMP(C, id) do { __syncthreads(); if ((C).tid == 0) { volatile __attribute__((address_space(3))) unsigned long long* P_ = (volatile __attribute__((address_space(3))) unsigned long long*)((C).lds + 131072 + 320 + 256); \
    const unsigned long long t_ = __builtin_amdgcn_s_memrealtime(); P_[id] += t_ - P_[0]; P_[0] = t_; } } while (0)
#else
#define STAMP(C, id) do {} while (0)
#endif
namespace pg8 {
#define PG8_LAS __attribute__((address_space(3)))
typedef unsigned short bf16_t;
typedef short bf16x8 __attribute__((ext_vector_type(8)));
typedef float f32x4 __attribute__((ext_vector_type(4)));
typedef unsigned u32x4 __attribute__((ext_vector_type(4)));
constexpr int BM = 256, BK = 64, HALF = 128, HTB = HALF * BK * 2  , STAGE_BYTES = 8 * HTB, NXCD = 8, WGM = 8;

__host__ __device__ __forceinline__ int lds_byte(int r, int c) { const int st = (r >> 4) * 2 + (c >> 5), rr = r & 15, cc = c & 31, ob = rr * 64 + cc * 2; return st * 1024 + (ob ^ (((ob >> 9) & 1) << 5)); }
__host__ __device__ __forceinline__ void stage_rc(int b, int& R, int& C) { const int st = b / 1024, sb = b % 1024, swz = sb ^ (((sb >> 9) & 1) << 5); R = (st >> 1) * 16 + swz / 64; C = (st & 1) * 32 + (swz % 64) / 2; }
__host__ __device__ __forceinline__ int perm32(int rho) { const int n = rho >> 4, i = rho & 15; return 8 * (i >> 2) + 4 * n + (i & 3); }

struct Unit { int pm, pn; };
struct Gemm { const bf16_t* A; const bf16_t* Bt; int M, N, K, lda, ldb; };

struct StaticOrder {
    int nM, nN, nwg, G, c;
    __host__ __device__ void init(int M, int N, int G_, int c_) { nM = M / BM; nN = N / BM; nwg = nM * nN; G = G_; c = c_; }
    __host__ __device__ bool next(int i, Unit& u) const {
        const long L = (long)i * G + c; if (L >= nwg) return false;
        int wgid = (int)L; { const int q = nwg / NXCD, r = nwg % NXCD, xcd = wgid % NXCD, off = wgid / NXCD; wgid = (xcd < r ? xcd * (q + 1) : r * (q + 1) + (xcd - r) * q) + off; }
        const int nig = WGM * nN, gid = wgid / nig, fm = gid * WGM, gsz = (nM - fm) < WGM ? (nM - fm) : WGM;
        u.pm = fm + ((wgid % nig) % gsz); u.pn = (wgid % nig) / gsz; return true;
    }
    __device__ __forceinline__ void a_ready(const Unit&) const {}
    __device__ __forceinline__ void done(const Unit&) const {}
};

typedef float cvt_f32x2 __attribute__((ext_vector_type(2))); typedef __bf16 cvt_bf16x2 __attribute__((ext_vector_type(2)));
__device__ __forceinline__ unsigned cvt_pk_bf16(float lo, float hi) { const cvt_f32x2 v = {lo, hi}; const cvt_bf16x2 b = __builtin_convertvector(v, cvt_bf16x2); return __builtin_bit_cast(unsigned, b); }
typedef float f32x2 __attribute__((ext_vector_type(2)));
template <class Epi, class Sched, bool ALIGN_EPI = false>
__device__ __forceinline__ void gemm_phase(PG8_LAS unsigned char* lds, const Gemm g, const Sched& S, const Epi& E) {
    int tid = threadIdx.x; asm volatile("" : "+v"(tid));
    const int wid = __builtin_amdgcn_readfirstlane(tid >> 6), lane = tid & 63, wr = wid >> 2, wc = wid & 3, fr = lane & 15, fq = lane >> 4;
    const int K = g.K, nt = K / BK;
    unsigned voffA, voffB;
    { int R, C; stage_rc(tid * 16, R, C); const int Rb = Epi::PERM ? ((R & ~31) + perm32(R & 31)) : R; voffA = (unsigned)(R * g.lda + C) * 2u; voffB = (unsigned)(Rb * g.ldb + C) * 2u; }
    const size_t r64A = (size_t)64 * g.lda * 2, r64B = (size_t)64 * g.ldb * 2;
    const size_t kstep = (size_t)(BK * 2);
    const size_t hstepA = (size_t)HALF * g.lda * 2, hstepB = (size_t)HALF * g.ldb * 2;
    const size_t tstepA = 2 * hstepA, tstepB = 2 * hstepB;
    const unsigned ldsw = (unsigned)wid * 1024u;
    const int aoff = lds_byte(wr * 64 + fr, fq * 8), boff = lds_byte(wc * 32 + fr, fq * 8);
#define PG8_SA(b, h) (((b) * 2 + (h)) * HTB)
#define PG8_SB(b, h) ((4 + (b) * 2 + (h)) * HTB)
#define PG8_STAGE(bufoff, gbase, sfx) do { _Pragma("unroll") for (int _i = 0; _i < 2; ++_i) \
        __builtin_amdgcn_global_load_lds((const unsigned*)((const char*)(gbase) + (size_t)_i * r64##sfx + voff##sfx), (PG8_LAS unsigned*)(lds + (bufoff) + ldsw + _i * 8192), 16, 0, 0); } while (0)
#define PG8_LDA(dst, b, h) do { _Pragma("unroll") for (int m = 0; m < 4; ++m) _Pragma("unroll") for (int k = 0; k < 2; ++k) dst[m][k] = *(const PG8_LAS bf16x8*)(lds + PG8_SA(b, h) + aoff + m * 2048 + k * 1024); } while (0)
#define PG8_LDB(dst, b, h) do { _Pragma("unroll") for (int n = 0; n < 2; ++n) _Pragma("unroll") for (int k = 0; k < 2; ++k) dst[n][k] = *(const PG8_LAS bf16x8*)(lds + PG8_SB(b, h) + boff + n * 2048 + k * 1024); } while (0)
#define PG8_MMA(ai, bj, At, Bt) do { __builtin_amdgcn_s_setprio(1); _Pragma("unroll") for (int m = 0; m < 4; ++m) _Pragma("unroll") for (int n = 0; n < 2; ++n) _Pragma("unroll") for (int k = 0; k < 2; ++k) \
        acc[ai][bj][m][n] = __builtin_amdgcn_mfma_f32_16x16x32_bf16(Bt[n][k], At[m][k], acc[ai][bj][m][n], 0, 0, 0); __builtin_amdgcn_s_setprio(0); } while (0)
#define PG8_WAIT_V(n) asm volatile("s_waitcnt vmcnt(" #n ")" ::: "memory")
#define PG8_WAIT_L(n) asm volatile("s_waitcnt lgkmcnt(" #n ")" ::: "memory")
#define PG8_BAR __builtin_amdgcn_s_barrier()
#define PG8_SCHED __builtin_amdgcn_sched_barrier(0)
    Unit cur, nxt; int ui = 0;
    if (!S.next(0, cur)) return;
    f32x4 acc[2][2][4][2];
#pragma unroll
    for (int a = 0; a < 2; ++a)
#pragma unroll
        for (int b = 0; b < 2; ++b)
#pragma unroll
            for (int m = 0; m < 4; ++m)
#pragma unroll
                for (int n = 0; n < 2; ++n) acc[a][b][m][n] = (f32x4){0.f, 0.f, 0.f, 0.f};
    bf16x8 At[4][2], B0[2][2], B1[2][2];
    const char* cA = (const char*)g.A + (size_t)cur.pm * tstepA; const char* cB = (const char*)g.Bt + (size_t)cur.pn * tstepB;
    S.a_ready(cur);
    PG8_STAGE(PG8_SB(0, 0), cB, B); PG8_STAGE(PG8_SB(0, 1), cB + hstepB, B); PG8_STAGE(PG8_SA(0, 0), cA, A); PG8_STAGE(PG8_SA(0, 1), cA + hstepA, A);
    if (wr == 1) PG8_BAR;
    PG8_WAIT_V(2); PG8_BAR;
    PG8_STAGE(PG8_SB(1, 0), cB + kstep, B); PG8_STAGE(PG8_SA(1, 0), cA + kstep, A); PG8_STAGE(PG8_SB(1, 1), cB + hstepB + kstep, B);
    PG8_WAIT_V(6); PG8_BAR;
    for (;;) {
        const bool has_next = S.next(ui + 1, nxt);
        const char* nA = has_next ? (const char*)g.A + (size_t)nxt.pm * tstepA : cA; const char* nB = has_next ? (const char*)g.Bt + (size_t)nxt.pn * tstepB : cB;
        for (int t = 0; t < nt; t += 2) {
            const bool last = (t == nt - 2);
            const char* a1 = cA + (size_t)(t + 1) * kstep;
            const char* a2 = last ? nA : cA + (size_t)(t + 2) * kstep; const char* b2 = last ? nB : cB + (size_t)(t + 2) * kstep;
            const char* a3 = a2 + kstep; const char* b3 = b2 + kstep;
            if (last && has_next) S.a_ready(nxt);
            PG8_LDB(B0, 0, 0); PG8_LDB(B1, 0, 1); PG8_SCHED; PG8_LDA(At, 0, 0); PG8_STAGE(PG8_SA(1, 1), a1 + hstepA, A);
            PG8_WAIT_V(8); PG8_WAIT_L(0); PG8_BAR; PG8_MMA(0, 0, At, B0); PG8_MMA(0, 1, At, B1); PG8_BAR; PG8_SCHED;
            PG8_LDA(At, 0, 1); PG8_STAGE(PG8_SB(0, 0), b2, B); PG8_STAGE(PG8_SB(0, 1), b2 + hstepB, B); PG8_STAGE(PG8_SA(0, 0), a2, A);
            PG8_WAIT_V(8); PG8_WAIT_L(0); PG8_BAR; PG8_MMA(1, 0, At, B0); PG8_MMA(1, 1, At, B1); PG8_BAR; PG8_SCHED;
            PG8_LDB(B0, 1, 0); PG8_LDB(B1, 1, 1); PG8_SCHED; PG8_LDA(At, 1, 0); PG8_STAGE(PG8_SA(0, 1), a2 + hstepA, A);
            PG8_WAIT_V(8); PG8_WAIT_L(0); PG8_BAR; PG8_MMA(0, 0, At, B0); PG8_MMA(0, 1, At, B1); PG8_BAR; PG8_SCHED;
            PG8_LDA(At, 1, 1); PG8_STAGE(PG8_SB(1, 0), b3, B); PG8_STAGE(PG8_SB(1, 1), b3 + hstepB, B); PG8_STAGE(PG8_SA(1, 0), a3, A);
            PG8_WAIT_V(8); PG8_WAIT_L(0); PG8_BAR; PG8_MMA(1, 0, At, B0); PG8_MMA(1, 1, At, B1); PG8_BAR; PG8_SCHED;
        }
        if constexpr (ALIGN_EPI) { if (wr == 0) PG8_BAR; }
        E(acc, cur, wr, wc, fr, fq); S.done(cur);
        if (!has_next) break;
#pragma unroll
        for (int a = 0; a < 2; ++a)
#pragma unroll
            for (int b = 0; b < 2; ++b)
#pragma unroll
                for (int m = 0; m < 4; ++m)
#pragma unroll
                    for (int n = 0; n < 2; ++n) acc[a][b][m][n] = (f32x4){0.f, 0.f, 0.f, 0.f};
        cur = nxt; cA = nA; cB = nB; ++ui;
        if constexpr (ALIGN_EPI) { if (wr == 1) PG8_BAR; }
    }
    PG8_WAIT_V(0);
    if constexpr (!ALIGN_EPI) { if (wr == 0) PG8_BAR; }
    PG8_BAR;
#undef PG8_SA
#undef PG8_SB
#undef PG8_STAGE
#undef PG8_LDA
#undef PG8_LDB
#undef PG8_MMA
#undef PG8_WAIT_V
#undef PG8_WAIT_L
#undef PG8_BAR
#undef PG8_SCHED
}

struct UnitG : Unit { const char* A; const char* B; int nt, kind, aux; };
template <class Epi, class Sched, bool ALIGN_EPI = false>
__device__ __forceinline__ void gemm_phase_g(PG8_LAS unsigned char* lds, int lda, int ldb, const Sched& S, const Epi& E) {
    int tid = threadIdx.x; asm volatile("" : "+v"(tid));
    const int wid = __builtin_amdgcn_readfirstlane(tid >> 6), lane = tid & 63, wr = wid >> 2, wc = wid & 3, fr = lane & 15, fq = lane >> 4;
    unsigned voffA, voffB;
    { int R, C; stage_rc(tid * 16, R, C); const int Rb = Epi::PERM ? ((R & ~31) + perm32(R & 31)) : R; voffA = (unsigned)(R * lda + C) * 2u; voffB = (unsigned)(Rb * ldb + C) * 2u; }
    const size_t r64A = (size_t)64 * lda * 2, r64B = (size_t)64 * ldb * 2;
    const size_t kstep = (size_t)(BK * 2);
    const size_t hstepA = (size_t)HALF * lda * 2, hstepB = (size_t)HALF * ldb * 2;
    const size_t tstepA = 2 * hstepA, tstepB = 2 * hstepB;
    const unsigned ldsw = (unsigned)wid * 1024u;
    const int aoff = lds_byte(wr * 64 + fr, fq * 8), boff = lds_byte(wc * 32 + fr, fq * 8);
#define PG8_SA(b, h) (((b) * 2 + (h)) * HTB)
#define PG8_SB(b, h) ((4 + (b) * 2 + (h)) * HTB)
#define PG8_STAGE(bufoff, gbase, sfx) do { _Pragma("unroll") for (int _i = 0; _i < 2; ++_i) \
        __builtin_amdgcn_global_load_lds((const unsigned*)((const char*)(gbase) + (size_t)_i * r64##sfx + voff##sfx), (PG8_LAS unsigned*)(lds + (bufoff) + ldsw + _i * 8192), 16, 0, 0); } while (0)
#define PG8_LDA(dst, b, h) do { _Pragma("unroll") for (int m = 0; m < 4; ++m) _Pragma("unroll") for (int k = 0; k < 2; ++k) dst[m][k] = *(const PG8_LAS bf16x8*)(lds + PG8_SA(b, h) + aoff + m * 2048 + k * 1024); } while (0)
#define PG8_LDB(dst, b, h) do { _Pragma("unroll") for (int n = 0; n < 2; ++n) _Pragma("unroll") for (int k = 0; k < 2; ++k) dst[n][k] = *(const PG8_LAS bf16x8*)(lds + PG8_SB(b, h) + boff + n * 2048 + k * 1024); } while (0)
#define PG8_MMA(ai, bj, At, Bt) do { __builtin_amdgcn_s_setprio(1); _Pragma("unroll") for (int m = 0; m < 4; ++m) _Pragma("unroll") for (int n = 0; n < 2; ++n) _Pragma("unroll") for (int k = 0; k < 2; ++k) \
        acc[ai][bj][m][n] = __builtin_amdgcn_mfma_f32_16x16x32_bf16(Bt[n][k], At[m][k], acc[ai][bj][m][n], 0, 0, 0); __builtin_amdgcn_s_setprio(0); } while (0)
#define PG8_WAIT_V(n) asm volatile("s_waitcnt vmcnt(" #n ")" ::: "memory")
#define PG8_WAIT_L(n) asm volatile("s_waitcnt lgkmcnt(" #n ")" ::: "memory")
#define PG8_BAR __builtin_amdgcn_s_barrier()
#define PG8_SCHED __builtin_amdgcn_sched_barrier(0)
    UnitG cur, nxt; int ui = 0;
    if (!S.next(0, cur)) return;
    f32x4 acc[2][2][4][2];
#pragma unroll
    for (int a = 0; a < 2; ++a)
#pragma unroll
        for (int b = 0; b < 2; ++b)
#pragma unroll
            for (int m = 0; m < 4; ++m)
#pragma unroll
                for (int n = 0; n < 2; ++n) acc[a][b][m][n] = (f32x4){0.f, 0.f, 0.f, 0.f};
    bf16x8 At[4][2], B0[2][2], B1[2][2];
    const char* cA = cur.A; const char* cB = cur.B;
    S.a_ready(cur);
    PG8_STAGE(PG8_SB(0, 0), cB, B); PG8_STAGE(PG8_SB(0, 1), cB + hstepB, B); PG8_STAGE(PG8_SA(0, 0), cA, A); PG8_STAGE(PG8_SA(0, 1), cA + hstepA, A);
    if (wr == 1) PG8_BAR;
    PG8_WAIT_V(2); PG8_BAR;
    PG8_STAGE(PG8_SB(1, 0), cB + kstep, B); PG8_STAGE(PG8_SA(1, 0), cA + kstep, A); PG8_STAGE(PG8_SB(1, 1), cB + hstepB + kstep, B);
    PG8_WAIT_V(6); PG8_BAR;
    for (;;) {
        const bool has_next = S.next(ui + 1, nxt);
        const char* nA = has_next ? nxt.A : cA; const char* nB = has_next ? nxt.B : cB; const int nt = cur.nt;
        for (int t = 0; t < nt; t += 2) {
            const bool last = (t == nt - 2);
            const char* a1 = cA + (size_t)(t + 1) * kstep;
            const char* a2 = last ? nA : cA + (size_t)(t + 2) * kstep; const char* b2 = last ? nB : cB + (size_t)(t + 2) * kstep;
            const char* a3 = a2 + kstep; const char* b3 = b2 + kstep;
            if (last && has_next) S.a_ready(nxt);
            PG8_LDB(B0, 0, 0); PG8_LDB(B1, 0, 1); PG8_SCHED; PG8_LDA(At, 0, 0); PG8_STAGE(PG8_SA(1, 1), a1 + hstepA, A);
            PG8_WAIT_V(8); PG8_WAIT_L(0); PG8_BAR; PG8_MMA(0, 0, At, B0); PG8_MMA(0, 1, At, B1); PG8_BAR; PG8_SCHED;
            PG8_LDA(At, 0, 1); PG8_STAGE(PG8_SB(0, 0), b2, B); PG8_STAGE(PG8_SB(0, 1), b2 + hstepB, B); PG8_STAGE(PG8_SA(0, 0), a2, A);
            PG8_WAIT_V(8); PG8_WAIT_L(0); PG8_BAR; PG8_MMA(1, 0, At, B0); PG8_MMA(1, 1, At, B1); PG8_BAR; PG8_SCHED;
            PG8_LDB(B0, 1, 0); PG8_LDB(B1, 1, 1); PG8_SCHED; PG8_LDA(At, 1, 0); PG8_STAGE(PG8_SA(0, 1), a2 + hstepA, A);
            PG8_WAIT_V(8); PG8_WAIT_L(0); PG8_BAR; PG8_MMA(0, 0, At, B0); PG8_MMA(0, 1, At, B1); PG8_BAR; PG8_SCHED;
            PG8_LDA(At, 1, 1); PG8_STAGE(PG8_SB(1, 0), b3, B); PG8_STAGE(PG8_SB(1, 1), b3 + hstepB, B); PG8_STAGE(PG8_SA(1, 0), a3, A);
            PG8_WAIT_V(8); PG8_WAIT_L(0); PG8_BAR; PG8_MMA(1, 0, At, B0); PG8_MMA(1, 1, At, B1); PG8_BAR; PG8_SCHED;
        }
        if constexpr (ALIGN_EPI) { if (wr == 0) PG8_BAR; }
        E(acc, cur, wr, wc, fr, fq); S.done(cur);
        if (!has_next) break;
#pragma unroll
        for (int a = 0; a < 2; ++a)
#pragma unroll
            for (int b = 0; b < 2; ++b)
#pragma unroll
                for (int m = 0; m < 4; ++m)
#pragma unroll
                    for (int n = 0; n < 2; ++n) acc[a][b][m][n] = (f32x4){0.f, 0.f, 0.f, 0.f};
        cur = nxt; cA = nA; cB = nB; ++ui;
        if constexpr (ALIGN_EPI) { if (wr == 1) PG8_BAR; }
    }
    PG8_WAIT_V(0);
    if constexpr (!ALIGN_EPI) { if (wr == 0) PG8_BAR; }
    PG8_BAR;
#undef PG8_SA
#undef PG8_SB
#undef PG8_STAGE
#undef PG8_LDA
#undef PG8_LDB
#undef PG8_MMA
#undef PG8_WAIT_V
#undef PG8_WAIT_L
#undef PG8_BAR
#undef PG8_SCHED
}
}
#define GAS __attribute__((address_space(1)))
#define LAS __attribute__((address_space(3)))
typedef unsigned short bf16;
typedef unsigned v4u __attribute__((ext_vector_type(4)));
typedef float f32x4 __attribute__((ext_vector_type(4)));
typedef short bf16x8 __attribute__((ext_vector_type(8)));
typedef GAS unsigned gu32;
typedef GAS unsigned long long gu64;
#define RLX_AGENT __ATOMIC_RELAXED, __HIP_MEMORY_SCOPE_AGENT
#define LDS_WAIT() asm volatile("s_waitcnt lgkmcnt(0)" ::: "memory")
#define VM_WAIT() asm volatile("s_waitcnt vmcnt(0)" ::: "memory")
__device__ __forceinline__ unsigned long long rt() { return __builtin_amdgcn_s_memrealtime(); }
__device__ __forceinline__ unsigned f2bf(float f) { unsigned u = __builtin_bit_cast(unsigned, f); return (u + 0x7fffu + ((u >> 16) & 1u)) >> 16; }
__device__ __forceinline__ unsigned pk2(float lo, float hi) { return f2bf(lo) | (f2bf(hi) << 16); }

#define XB_TMO      128
#define XB_XCNT(j)  (256  + 64 * (j))
#define XB_XSUB(j)  (1280 + 64 * (j))
#define XB_XGEN(j)  (2304 + 64 * (j))
#define XB_TOP      3328
#define XB_TOPGEN   3392
#define XCD_BAR_WORDS 3456
#define XB_SPIN_CAP (1u << 18)

__device__ __forceinline__ unsigned xb_ld(unsigned* p)              { return __hip_atomic_load(p, __ATOMIC_RELAXED, __HIP_MEMORY_SCOPE_AGENT); }
__device__ __forceinline__ unsigned xb_add(unsigned* p, unsigned v) { return __hip_atomic_fetch_add(p, v, __ATOMIC_RELAXED, __HIP_MEMORY_SCOPE_AGENT); }
__device__ __forceinline__ unsigned xb_xcc_id() { return (unsigned)__builtin_amdgcn_s_getreg((3 << 11) | 20) & 0xFu; }
#define XB_SPIN(cond, bar) do { unsigned _sp = 0; while (cond) { __builtin_amdgcn_s_sleep(1); \
    if ((++_sp & 255u) == 0u) { if (xb_ld(&(bar)[XB_TMO])) break; if (_sp > XB_SPIN_CAP) { atomicAdd(&(bar)[XB_TMO], 1u); break; } } } } while (0)

struct XcdBarrier {
    unsigned* bar; unsigned x;
    volatile LAS unsigned* st;
};

__device__ __forceinline__ XcdBarrier xcd_barrier_post(unsigned* bar, volatile LAS unsigned* st) {
    XcdBarrier b; b.bar = bar; b.x = xb_xcc_id(); b.st = st;
    if (threadIdx.x == 0) (void)xb_add(&bar[XB_XCNT(b.x)], 1u);
    return b;
}
__device__ __forceinline__ void xcd_barrier_complete(unsigned* bar, unsigned x, unsigned& nloc, unsigned& nx) {
    const unsigned G = gridDim.x * gridDim.y * gridDim.z;
    unsigned sum, cnt, mine, sp = 0u;
    for (;;) {
        sum = 0u; cnt = 0u; mine = 0u;
#pragma unroll
        for (unsigned j = 0; j < 16; ++j) { const unsigned c = xb_ld(&bar[XB_XCNT(j)]); sum += c; cnt += (c > 0u) ? 1u : 0u; mine = (j == x) ? c : mine; }
        if (sum == G) break;
        __builtin_amdgcn_s_sleep(1);
        if ((++sp & 255u) == 0u) { if (xb_ld(&bar[XB_TMO])) break; if (sp > XB_SPIN_CAP) { atomicAdd(&bar[XB_TMO], 1u); break; } }
    }
    nloc = mine > 0u ? mine : 1u; nx = cnt > 0u ? cnt : 1u;
}

__device__ __forceinline__ void xcd_barrier(const XcdBarrier& b) {
    asm volatile("s_waitcnt vmcnt(0)" ::: "memory");
    __syncthreads();
    if (threadIdx.x == 0) {
        unsigned* bar = b.bar;
        __builtin_amdgcn_s_waitcnt(0);
        unsigned nloc = b.st[0], nx = b.st[1];
        if (nloc == 0u) { xcd_barrier_complete(bar, b.x, nloc, nx); b.st[0] = nloc; b.st[1] = nx; }
        const unsigned old = xb_add(&bar[XB_XSUB(b.x)], 1u);
        const unsigned gen = old / nloc;
        if (old + 1u == (gen + 1u) * nloc) {
            __builtin_amdgcn_fence(__ATOMIC_RELEASE, "agent");
            asm volatile("s_waitcnt vmcnt(0)" ::: "memory");
            const unsigned og = xb_add(&bar[XB_TOP], 1u);
            const unsigned tg = og / nx;
            if (og + 1u == (tg + 1u) * nx) xb_add(&bar[XB_TOPGEN], 1u);
            else XB_SPIN(xb_ld(&bar[XB_TOPGEN]) == tg, bar);
            __builtin_amdgcn_fence(__ATOMIC_ACQUIRE, "agent");
            xb_add(&bar[XB_XGEN(b.x)], 1u);
            asm volatile("s_waitcnt vmcnt(0)" ::: "memory");
        } else {
            XB_SPIN(xb_ld(&bar[XB_XGEN(b.x)]) == gen, bar);
            __builtin_amdgcn_fence(__ATOMIC_ACQUIRE, "agent");
            asm volatile("s_waitcnt vmcnt(0)" ::: "memory");
        }
    }
    __syncthreads();
}
constexpr int NWAVES = 8, NTHR = 512;
constexpr int DM = 2048, TP = 8192, DB = 128, DS = 4, NSAMP = DB * DS, M = TP + NSAMP;
constexpr int FF = 5504, PASTL = 2048, PAGE = 128, NPAGES = 16;
constexpr int HGH = 8, HGD = 128, HGW = 1024;
constexpr int NH = 16, NKV = 2, GRP = 8, HD = 64, NSAW = 1024, KVW = 128;
constexpr int CMPB = 32, CMPS = 16, CMPH = 256, SLCB = 64, SLCT = 16, WIN = 512;
constexpr int NCP = (TP - CMPB) / CMPS + 1;
constexpr int NCS = (PASTL + DS - CMPB) / CMPS + 1;
constexpr int NSP = TP / SLCB;
constexpr int NSS = (PASTL + DS + SLCB - 1) / SLCB;
constexpr int DIN = 10032, DINP = 10240;
constexpr float EPS = 1e-6f;
constexpr int C_HQ = 0, C_HF = 1024, C_HI = 2048, C_HG = 3072, C_NQ = 4096, C_KV = 5120, C_WN = 5632, C_GA = 5888, C_GB = 7936, C_NG = 9984;
constexpr size_t O_Y = 0, O_KV = (size_t)M * DM, O_WINP = O_KV + (size_t)M * 512, O_WINS = O_WINP + 512 * 256, O_HGP = O_WINS + (size_t)DB * 512 * 256, O_HGS = O_HGP + 131072, O_END = O_HGS + (size_t)DB * 131072;
static_assert(O_END == 56098816, "d_out size");
constexpr size_t MiB = 1u << 20;
constexpr size_t alignup(size_t x) { return (x + MiB - 1) / MiB * MiB; }
constexpr size_t WS_CTL = 0, CTL_ZERO_BYTES = 1 * MiB;
constexpr size_t WS_W1GU = 1 * MiB;
constexpr size_t WS_W1D  = WS_W1GU + alignup((size_t)2 * FF * DM * 2);
constexpr size_t WS_W2GU = WS_W1D + alignup((size_t)DM * FF * 2);
constexpr size_t WS_W2D  = WS_W2GU + alignup((size_t)2 * FF * DM * 2);
constexpr size_t WS_WIN  = WS_W2D + alignup((size_t)DM * FF * 2);
constexpr size_t WS_WPH  = WS_WIN + alignup((size_t)DINP * DM * 2);
constexpr size_t WS_WPN  = WS_WPH + alignup((size_t)DM * 1024 * 2);
constexpr size_t WS_WO   = WS_WPN + alignup((size_t)DM * 1024 * 2);
constexpr size_t WS_XN   = WS_WO + alignup((size_t)DM * DM * 2);
constexpr size_t WS_HB   = WS_XN + alignup((size_t)M * DM * 2);
constexpr size_t WS_Y    = WS_HB + alignup((size_t)M * FF * 2);
constexpr size_t WS_X1   = WS_Y + alignup((size_t)M * DM * 4);
constexpr size_t WS_X2   = WS_X1 + alignup((size_t)M * DM * 4);
constexpr size_t WS_QH   = WS_X2 + alignup((size_t)M * DM * 4);
constexpr size_t WS_LOGF = WS_QH + alignup((size_t)M * 1024 * 4);
constexpr size_t WS_KH   = WS_LOGF + alignup((size_t)M * 1024 * 4);
constexpr size_t WS_VH   = WS_KH + alignup((size_t)M * 1024 * 4);
constexpr size_t WS_GH   = WS_VH + alignup((size_t)M * 1024 * 4);
constexpr size_t WS_QN   = WS_GH + alignup((size_t)M * 1024 * 4);
constexpr size_t WS_WINF = WS_QN + alignup((size_t)M * 1024 * 4);
constexpr size_t WS_NG   = WS_WINF + alignup((size_t)M * 256 * 4);
constexpr size_t WS_GA   = WS_NG + alignup((size_t)M * 48 * 4);
constexpr size_t WS_GB   = WS_GA + alignup((size_t)M * DM * 4);
constexpr size_t WS_KCP  = WS_GB + alignup((size_t)M * DM * 4);
constexpr size_t WS_VCP  = WS_KCP + 1 * MiB;
constexpr size_t WS_KCS  = WS_VCP + 1 * MiB;
constexpr size_t WS_VCS  = WS_KCS + alignup((size_t)DB * 2 * NCS * 64 * 4);
constexpr size_t WS_CB   = WS_VCS + alignup((size_t)DB * 2 * NCS * 64 * 4);
constexpr size_t WS_OHR  = WS_CB + 1 * MiB;
constexpr size_t WS_OHG  = WS_OHR + alignup((size_t)M * 1024 * 4);
constexpr size_t WS_ONSA = WS_OHG + alignup((size_t)M * 1024 * 2);
constexpr size_t WS_T1   = WS_ONSA + alignup((size_t)M * 1024 * 2);
constexpr size_t WS_MIX  = WS_T1 + alignup((size_t)M * DM * 4);
constexpr size_t WS_UT   = WS_MIX + alignup((size_t)M * DM * 2);
constexpr size_t WS_DD   = WS_UT + alignup((size_t)128 * 8 * 16384 * 4);
constexpr size_t WS_SP   = WS_DD + 1 * MiB;
constexpr size_t WS_QN16 = WS_SP + alignup((size_t)128 * 8 * 16384 * 2);
constexpr size_t WS_KSL  = WS_QN16 + alignup((size_t)M * 1024 * 2);
constexpr size_t WS_VSL  = WS_KSL + 2 * MiB;
constexpr size_t WS_KWN  = WS_VSL + 2 * MiB;
constexpr size_t WS_VWN  = WS_KWN + 2 * MiB;
constexpr size_t WS_KC16 = WS_VWN + 2 * MiB;
constexpr size_t WS_VC16 = WS_KC16 + 1 * MiB;
constexpr int CMP_ROWS_S = DB * 2 * 2 * 128, CMP_ROWS_P = 2 * 2 * 512, CMP_ROWS = CMP_ROWS_S + CMP_ROWS_P;
constexpr size_t WS_CA   = WS_VC16 + 1 * MiB;
constexpr size_t WS_HID  = WS_CA + alignup((size_t)CMP_ROWS * 1024 * 2) + 1 * MiB;
constexpr size_t WS_W1C  = WS_HID + alignup((size_t)CMP_ROWS * 256 * 2);
constexpr size_t WS_W2C  = WS_W1C + 2 * MiB;
constexpr size_t WS_SLAB = WS_W2C + 1 * MiB;
constexpr size_t SLABSZ = (size_t)NSAMP * DM;
constexpr size_t WS_QH16 = WS_SLAB + alignup(16 * SLABSZ * 4);
constexpr size_t WS_KH16 = WS_QH16 + 18 * MiB;
constexpr size_t WS_VH16 = WS_KH16 + 18 * MiB;
constexpr size_t WS_GH16 = WS_VH16 + 18 * MiB;
constexpr size_t WS_RS   = WS_GH16 + 18 * MiB;
constexpr size_t WS_END  = WS_RS + 1 * MiB;
static_assert(WS_END < (size_t)2600 * MiB, "workspace");
constexpr int CW_TMO = 0, CW_CODE = 1, CW_BAR = 4096, CW_Q7 = 8192, CW_Q5 = 8192 + 256;
constexpr int RING_OFF = 0, RING_BYTES = 131072;
constexpr int LDSCTL_OFF = RING_BYTES, MISC_OFF = LDSCTL_OFF + 320;
constexpr int LDS_BYTES = 147456;
namespace pg8 {
__device__ __forceinline__ float sigm(float x) { return __builtin_amdgcn_rcpf(1.f + __expf(-x)); }
#define EPI_FOR(...) _Pragma("unroll") for (int ai = 0; ai < 2; ++ai) _Pragma("unroll") for (int m = 0; m < 4; ++m) { const int row = row0 + ai * 128 + m * 16; \
    _Pragma("unroll") for (int bj = 0; bj < 2; ++bj) _Pragma("unroll") for (int n = 0; n < 2; ++n) { const int cl = cl0 + bj * 128 + 4 * n; f32x4 v = acc[ai][bj][m][n]; __VA_ARGS__ } }
#define EPI_BFSILU(dst, ld, col) _Pragma("unroll") for (int ai = 0; ai < 2; ++ai) _Pragma("unroll") for (int m = 0; m < 4; ++m) { const int row = row0 + ai * 128 + m * 16; \
    _Pragma("unroll") for (int bj = 0; bj < 2; ++bj) { const f32x4 a = acc[ai][bj][m][0], b = acc[ai][bj][m][1]; u32x4 w; \
        w.x = cvt_pk_bf16(a[0] * sigm(a[0]), a[1] * sigm(a[1])); w.y = cvt_pk_bf16(a[2] * sigm(a[2]), a[3] * sigm(a[3])); w.z = cvt_pk_bf16(b[0] * sigm(b[0]), b[1] * sigm(b[1])); w.w = cvt_pk_bf16(b[2] * sigm(b[2]), b[3] * sigm(b[3])); \
        *(u32x4*)((dst) + (size_t)row * (ld) + (col)) = w; } }
#define EPI_BFS(dst, ld, col) _Pragma("unroll") for (int ai = 0; ai < 2; ++ai) _Pragma("unroll") for (int m = 0; m < 4; ++m) { const int row = row0 + ai * 128 + m * 16; \
    _Pragma("unroll") for (int bj = 0; bj < 2; ++bj) { f32x4 a = acc[ai][bj][m][0], b = acc[ai][bj][m][1]; for (int j = 0; j < 4; ++j) { a[j] = sigm(a[j]); b[j] = sigm(b[j]); } u32x4 w; \
        w.x = cvt_pk_bf16(a[0], a[1]); w.y = cvt_pk_bf16(a[2], a[3]); w.z = cvt_pk_bf16(b[0], b[1]); w.w = cvt_pk_bf16(b[2], b[3]); *(u32x4*)((dst) + (size_t)row * (ld) + (col)) = w; } }
#define EPI_BF(dst, ld, col, scale) _Pragma("unroll") for (int ai = 0; ai < 2; ++ai) _Pragma("unroll") for (int m = 0; m < 4; ++m) { const int row = row0 + ai * 128 + m * 16; \
    _Pragma("unroll") for (int bj = 0; bj < 2; ++bj) { const f32x4 a = acc[ai][bj][m][0] * (scale), b = acc[ai][bj][m][1] * (scale); u32x4 w; \
        w.x = cvt_pk_bf16(a[0], a[1]); w.y = cvt_pk_bf16(a[2], a[3]); w.z = cvt_pk_bf16(b[0], b[1]); w.w = cvt_pk_bf16(b[2], b[3]); *(u32x4*)((dst) + (size_t)row * (ld) + (col)) = w; } }
__device__ __forceinline__ void unpack8(const u32x4 w, f32x4& a, f32x4& b) {
    a[0] = __uint_as_float(w.x << 16); a[1] = __uint_as_float(w.x & 0xffff0000u); a[2] = __uint_as_float(w.y << 16); a[3] = __uint_as_float(w.y & 0xffff0000u);
    b[0] = __uint_as_float(w.z << 16); b[1] = __uint_as_float(w.z & 0xffff0000u); b[2] = __uint_as_float(w.w << 16); b[3] = __uint_as_float(w.w & 0xffff0000u); }
struct EpiSwiglu {
    static constexpr bool PERM = true;
    bf16_t* H; int ldh;
    __device__ __forceinline__ void operator()(const f32x4 (&acc)[2][2][4][2], const Unit& u, int wr, int wc, int fr, int fq) const {
        const int row0 = u.pm * BM + wr * 64 + fr, col = u.pn * 128 + wc * 32 + 8 * fq;
#pragma unroll
        for (int ai = 0; ai < 2; ++ai)
#pragma unroll
            for (int m = 0; m < 4; ++m) { const int row = row0 + ai * 128 + m * 16; float h[8];
#pragma unroll
                for (int n = 0; n < 2; ++n)
#pragma unroll
                    for (int j = 0; j < 4; ++j) { const float g = acc[ai][0][m][n][j], up = acc[ai][1][m][n][j]; h[4 * n + j] = g * sigm(g) * up; }
                u32x4 w; w.x = cvt_pk_bf16(h[0], h[1]); w.y = cvt_pk_bf16(h[2], h[3]); w.z = cvt_pk_bf16(h[4], h[5]); w.w = cvt_pk_bf16(h[6], h[7]);
                *(u32x4*)(H + (size_t)row * ldh + col) = w; }
    }
};
struct EpiY16 {
    static constexpr bool PERM = true;
    bf16_t* Y; int ldc;
    __device__ __forceinline__ void operator()(const f32x4 (&acc)[2][2][4][2], const Unit& u, int wr, int wc, int fr, int fq) const {
        const int row0 = u.pm * BM + wr * 64 + fr, cl0 = u.pn * BM + wc * 32 + 8 * fq;
        EPI_BF(Y, ldc, cl0 + bj * 128, 1.f)
    }
};
struct EpiSlab {
    static constexpr bool PERM = true;
    float* S;
    __device__ __forceinline__ void operator()(const f32x4 (&acc)[2][2][4][2], const Unit& u, int wr, int wc, int fr, int fq) const {
        const int row0 = (u.pm - 32) * BM + wr * 64 + fr, cl0 = u.pn * BM + wc * 32 + 8 * fq;
        EPI_FOR( *(f32x4*)(S + (size_t)row * 2048 + cl) = v; )
    }
};
struct OneUnit {
    int su;
    __device__ bool next(int i, Unit& u) const { if (i > 0 || su >= 16) return false; u.pm = 32 + (su >> 3); u.pn = su & 7; return true; }
    __device__ __forceinline__ void a_ready(const Unit&) const {}
    __device__ __forceinline__ void done(const Unit&) const {}
};
struct SplitSched {
    StaticOrder S; const char* A; const char* B; int lda, ldb, K, NS, bid;
    __device__ __forceinline__ void piece(int ks, int& koff, int& klen) const { if (K == FF) { koff = 128 * (ks < 11 ? 3 * ks : 33 + 2 * (ks - 11)); klen = ks < 11 ? 384 : 256; } else { klen = K / NS; koff = ks * klen; } }
    __device__ bool next(int i, UnitG& u) const {
        const int nmain = S.c < S.nwg ? (S.nwg - S.c + S.G - 1) / S.G : 0;
        if (i < nmain) { Unit m; S.next(i, m); u.pm = m.pm; u.pn = m.pn; u.A = A + (size_t)m.pm * 256 * lda * 2; u.B = B + (size_t)m.pn * 256 * ldb * 2; u.nt = K / 64; u.kind = 0; u.aux = 0; return true; }
        const int p = bid + (i - nmain) * S.G; if (p >= 16 * NS) return false;
        const int ks = p % NS, su = p / NS;
        int koff, klen; piece(ks, koff, klen);
        u.pm = 32 + (su >> 3); u.pn = su & 7; u.A = A + ((size_t)u.pm * 256 * lda + koff) * 2; u.B = B + ((size_t)u.pn * 256 * ldb + koff) * 2; u.nt = klen / 64; u.kind = 1; u.aux = ks; return true;
    }
    __device__ __forceinline__ void a_ready(const UnitG&) const {}
    __device__ __forceinline__ void done(const UnitG&) const {}
};
struct ProjSched {
    StaticOrder S; const char* Ah; const char* An; const char* Bh; const char* Bn; int bid;
    __device__ bool next(int i, UnitG& u) const {
        const int nmain = S.c < S.nwg ? (S.nwg - S.c + S.G - 1) / S.G : 0;
        if (i < 2 * nmain) { Unit m; S.next(i >> 1, m); const bool n = i & 1; u.pm = m.pm; u.pn = m.pn; u.A = (n ? An : Ah) + (size_t)m.pm * 256 * 1024 * 2; u.B = (n ? Bn : Bh) + (size_t)m.pn * 256 * 1024 * 2; u.nt = 16; u.kind = n ? 2 : 0; u.aux = 0; return true; }
        const int p = bid + (i - 2 * nmain) * S.G; if (p >= 128) return false;
        const int j = p >> 6, ks = p & 3, su = (p >> 2) & 15;
        u.pm = 32 + (su >> 3); u.pn = su & 7; u.A = (j ? An : Ah) + ((size_t)u.pm * 256 * 1024 + ks * 256) * 2; u.B = (j ? Bn : Bh) + ((size_t)u.pn * 256 * 1024 + ks * 256) * 2; u.nt = 4; u.kind = 1; u.aux = 4 * j + ks; return true;
    }
    __device__ __forceinline__ void a_ready(const UnitG&) const {}
    __device__ __forceinline__ void done(const UnitG&) const {}
};
__device__ __forceinline__ f32x4 sig4(f32x4 x) { return (f32x4){sigm(x[0]), sigm(x[1]), sigm(x[2]), sigm(x[3])}; }
struct EpiGate1 {
    static constexpr bool PERM = true;
    const bf16_t* GA; bf16_t* T1; int ldc;
    __device__ __forceinline__ void operator()(const f32x4 (&acc)[2][2][4][2], const Unit& u, int wr, int wc, int fr, int fq) const {
        const int row0 = u.pm * BM + wr * 64 + fr, cl0 = u.pn * BM + wc * 32 + 8 * fq;
#pragma unroll
        for (int ai = 0; ai < 2; ++ai)
#pragma unroll
            for (int m = 0; m < 4; ++m) { const int row = row0 + ai * 128 + m * 16;
#pragma unroll
                for (int bj = 0; bj < 2; ++bj) { const size_t off = (size_t)row * ldc + cl0 + bj * 128; f32x4 g0, g1; unpack8(*(const u32x4*)(GA + off), g0, g1);
                    const f32x4 a = sig4(g0) * acc[ai][bj][m][0], b = sig4(g1) * acc[ai][bj][m][1];
                    u32x4 w; w.x = cvt_pk_bf16(a[0], a[1]); w.y = cvt_pk_bf16(a[2], a[3]); w.z = cvt_pk_bf16(b[0], b[1]); w.w = cvt_pk_bf16(b[2], b[3]);
                    *(u32x4*)(T1 + off) = w; } }
    }
};
struct EpiGate2 {
    static constexpr bool PERM = true;
    const bf16_t* GB; const bf16_t* T1; bf16_t* MIX; int ldc;
    __device__ __forceinline__ void operator()(const f32x4 (&acc)[2][2][4][2], const Unit& u, int wr, int wc, int fr, int fq) const {
        const int row0 = u.pm * BM + wr * 64 + fr, cl0 = u.pn * BM + wc * 32 + 8 * fq;
#pragma unroll
        for (int ai = 0; ai < 2; ++ai)
#pragma unroll
            for (int m = 0; m < 4; ++m) { const int row = row0 + ai * 128 + m * 16;
#pragma unroll
                for (int bj = 0; bj < 2; ++bj) { const size_t off = (size_t)row * ldc + cl0 + bj * 128; f32x4 t0, t1, g0, g1; unpack8(*(const u32x4*)(T1 + off), t0, t1); unpack8(*(const u32x4*)(GB + off), g0, g1);
                    const f32x4 a = t0 + sig4(g0) * acc[ai][bj][m][0], b = t1 + sig4(g1) * acc[ai][bj][m][1];
                    u32x4 w; w.x = cvt_pk_bf16(a[0], a[1]); w.y = cvt_pk_bf16(a[2], a[3]); w.z = cvt_pk_bf16(b[0], b[1]); w.w = cvt_pk_bf16(b[2], b[3]);
                    *(u32x4*)(MIX + off) = w; } }
    }
};
template <class Main> struct EpiDual {
    static constexpr bool PERM = true;
    Main main; float* slab;
    __device__ __forceinline__ void operator()(const f32x4 (&acc)[2][2][4][2], const UnitG& u, int wr, int wc, int fr, int fq) const {
        if (u.kind == 0) main(acc, u, wr, wc, fr, fq); else { EpiSlab e{slab + (size_t)u.aux * SLABSZ}; e(acc, u, wr, wc, fr, fq); }
    }
};
struct EpiProj {
    static constexpr bool PERM = true;
    EpiGate1 g1; EpiGate2 g2; float* slab;
    __device__ __forceinline__ void operator()(const f32x4 (&acc)[2][2][4][2], const UnitG& u, int wr, int wc, int fr, int fq) const {
        if (u.kind == 0) g1(acc, u, wr, wc, fr, fq); else if (u.kind == 2) g2(acc, u, wr, wc, fr, fq); else { EpiSlab e{slab + (size_t)u.aux * SLABSZ}; e(acc, u, wr, wc, fr, fq); }
    }
};
struct EpiCmp {
    static constexpr bool PERM = true;
    const float* CB; bf16_t* HID;
    __device__ __forceinline__ void operator()(const f32x4 (&acc)[2][2][4][2], const Unit& u, int wr, int wc, int fr, int fq) const {
        const int row0 = u.pm * BM + wr * 64 + fr, cl0 = wc * 32 + 8 * fq;
#pragma unroll
        for (int bj = 0; bj < 2; ++bj) { const f32x4 b0 = *(const f32x4*)(CB + u.pn * 256 + cl0 + bj * 128), b1 = *(const f32x4*)(CB + u.pn * 256 + cl0 + bj * 128 + 4);
#pragma unroll
            for (int ai = 0; ai < 2; ++ai)
#pragma unroll
                for (int m = 0; m < 4; ++m) { const int row = row0 + ai * 128 + m * 16; f32x4 a = acc[ai][bj][m][0] + b0, b = acc[ai][bj][m][1] + b1;
                    for (int j = 0; j < 4; ++j) { a[j] = a[j] * sigm(1.5957691216057308f * (a[j] + 0.044715f * a[j] * a[j] * a[j])); b[j] = b[j] * sigm(1.5957691216057308f * (b[j] + 0.044715f * b[j] * b[j] * b[j])); }
                    u32x4 w; w.x = cvt_pk_bf16(a[0], a[1]); w.y = cvt_pk_bf16(a[2], a[3]); w.z = cvt_pk_bf16(b[0], b[1]); w.w = cvt_pk_bf16(b[2], b[3]);
                    *(u32x4*)(HID + (size_t)row * 256 + cl0 + bj * 128) = w; } }
    }
};
struct CmpOrder {
    int lo, hi, c, n;
    __device__ bool next(int i, Unit& u) const { const int L = lo + c + i * n; if (c < 0 || L >= hi) return false; u.pm = L; u.pn = L < CMP_ROWS_S / 256 ? (L >= CMP_ROWS_S / 512 ? 1 : 0) : (L - CMP_ROWS_S / 256 >= 4 ? 1 : 0); return true; }
    __device__ __forceinline__ void a_ready(const Unit&) const {}
    __device__ __forceinline__ void done(const Unit&) const {}
};
struct EpiInProj {
    static constexpr bool PERM = true;
    unsigned char* ws; float* out; const float* hg_lb;
    __device__ __forceinline__ void operator()(const f32x4 (&acc)[2][2][4][2], const Unit& u, int wr, int wc, int fr, int fq) const {
        const int row0 = u.pm * BM + wr * 64 + fr, cl0 = wc * 32 + 8 * fq, pn = u.pn;
        float* const LOGF = (float*)(ws + WS_LOGF);
        float* const WINF = (float*)(ws + WS_WINF); float* const NG = (float*)(ws + WS_NG); bf16_t* const GA = (bf16_t*)(ws + WS_GA); bf16_t* const GB = (bf16_t*)(ws + WS_GB);
        float* const KVO = out + O_KV; float* const WINP = out + O_WINP; float* const WINS = out + O_WINS;
        bf16_t* const QN16 = (bf16_t*)(ws + WS_QN16); bf16_t* const KSL = (bf16_t*)(ws + WS_KSL); bf16_t* const VSL = (bf16_t*)(ws + WS_VSL); bf16_t* const KWN = (bf16_t*)(ws + WS_KWN); bf16_t* const VWN = (bf16_t*)(ws + WS_VWN);
        bf16_t* const CP16 = (bf16_t*)(ws + WS_CA) + (size_t)CMP_ROWS_S * 1024;
        bf16_t* const QH16 = (bf16_t*)(ws + WS_QH16); bf16_t* const KH16 = (bf16_t*)(ws + WS_KH16); bf16_t* const VH16 = (bf16_t*)(ws + WS_VH16); bf16_t* const GH16 = (bf16_t*)(ws + WS_GH16);
        if (pn < 4) { const int cb = pn * 256;
            EPI_BFSILU(QH16, 1024, cb + cl0 + bj * 128)
        } else if (pn < 8) { const int cb = (pn - 4) * 256;
#pragma unroll
            for (int bj = 0; bj < 2; ++bj) { const int c = cb + cl0 + bj * 128; f32x4 lb[2];
#pragma unroll
                for (int n = 0; n < 2; ++n) { const f32x4 a0 = *(const f32x4*)(hg_lb + c + 4 * n), a1 = *(const f32x4*)(hg_lb + 1024 + c + 4 * n); for (int j = 0; j < 4; ++j) lb[n][j] = 1.f / (1.f + expf(a1[j] - a0[j])); }
#pragma unroll
                for (int ai = 0; ai < 2; ++ai)
#pragma unroll
                    for (int m = 0; m < 4; ++m) { const int row = row0 + ai * 128 + m * 16; f32x4 kk[2];
#pragma unroll
                        for (int n = 0; n < 2; ++n) { const f32x4 v = acc[ai][bj][m][n]; f32x4 lf;
                            for (int j = 0; j < 4; ++j) { const float sg = 1.f / (1.f + expf(-v[j])), sn = 1.f / (1.f + expf(v[j])); const float f = lb[n][j] + (1.f - lb[n][j]) * sg; lf[j] = logf(f); kk[n][j] = (1.f - lb[n][j]) * sn; }
                            *(f32x4*)(LOGF + (size_t)row * 1024 + c + 4 * n) = lf; }
                        { u32x4 w; w.x = cvt_pk_bf16(kk[0][0], kk[0][1]); w.y = cvt_pk_bf16(kk[0][2], kk[0][3]); w.z = cvt_pk_bf16(kk[1][0], kk[1][1]); w.w = cvt_pk_bf16(kk[1][2], kk[1][3]); *(u32x4*)(KH16 + (size_t)row * 1024 + c) = w; } } }
        } else if (pn < 12) { const int cb = (pn - 8) * 256;
            EPI_BF(VH16, 1024, cb + cl0 + bj * 128, 1.f)
        } else if (pn < 16) { const int cb = (pn - 12) * 256;
            EPI_BFSILU(GH16, 1024, cb + cl0 + bj * 128)
        } else if (pn < 20) { const int cb = (pn - 16) * 256;
            EPI_BF(QN16, 1024, cb + cl0 + bj * 128, 0.125f * 1.4426950408889634f)
        } else if (pn < 22) { const int cb = (pn - 20) * 256;
            EPI_FOR( *(f32x4*)(KVO + (size_t)row * 512 + cb + cl) = v; )
            if (pn == 21 && u.pm < 32) { EPI_BF((bj ? VSL : KSL), 128, cl0, 1.f) }
            if (pn == 20 && u.pm < 32) { EPI_BF(CP16 + (size_t)(bj * 2 + (cl0 >> 6)) * 8192 * 64, 64, cl0 & 63, 1.f) }
        } else if (pn == 22) {
            EPI_FOR( *(f32x4*)(WINF + (size_t)row * 256 + cl) = v;
                     if (row >= 7680 && row < 8192) *(f32x4*)(WINP + (size_t)(row - 7680) * 256 + cl) = v;
                     if (row >= 8192) { const int b = (row - 8192) >> 2, tt = (row - 8192) & 3; *(f32x4*)(WINS + ((size_t)b * 512 + 508 + tt) * 256 + cl) = v; } )
            if (u.pm < 32) { EPI_BF((bj ? VWN : KWN), 128, cl0, 1.f) }
        } else if (pn < 31) { const int cb = (pn - 23) * 256;
            EPI_BF(GA, 2048, cb + cl0 + bj * 128, 1.f)
        } else if (pn < 39) { const int cb = (pn - 31) * 256;
            EPI_BF(GB, 2048, cb + cl0 + bj * 128, 1.f)
        } else {
            EPI_FOR( if (cl < 48) { f32x4 o; for (int j = 0; j < 4; ++j) o[j] = sigm(v[j]); *(f32x4*)(NG + (size_t)row * 48 + cl) = o; } )
        }
    }
};
#undef EPI_FOR
#undef EPI_BF
#undef EPI_BFS
#undef EPI_BFSILU
}
typedef float f4 __attribute__((ext_vector_type(4)));
typedef float f2 __attribute__((ext_vector_type(2)));
typedef unsigned u2 __attribute__((ext_vector_type(2)));
__device__ __forceinline__ float wsum(float v) {
#pragma unroll
    for (int o = 32; o > 0; o >>= 1) v += __shfl_xor(v, o);
    return v;
}
__device__ __forceinline__ float wmax(float v) {
#pragma unroll
    for (int o = 32; o > 0; o >>= 1) v = fmaxf(v, __shfl_xor(v, o));
    return v;
}
__device__ __forceinline__ f4 ld4bf(const bf16* p) { const u2 w = *(const u2*)p; return (f4){__uint_as_float(w.x << 16), __uint_as_float(w.x & 0xffff0000u), __uint_as_float(w.y << 16), __uint_as_float(w.y & 0xffff0000u)}; }
struct Ctx { int tid, lane, wave, gw, NGW, G, bid; LAS unsigned char* lds; };

struct TrMat { int in_idx, K, N, map; size_t dst; };
__device__ __forceinline__ TrMat tr_mat(int m) {
    switch (m) {
        case 0: return TrMat{8, DM, FF, 1, WS_W1GU};              case 1: return TrMat{9, DM, FF, 2, WS_W1GU};
        case 2: return TrMat{13, DM, DIN, 3, WS_WIN};
        case 3: return TrMat{17, 2048, 256, 0, WS_W1C};           case 4: return TrMat{20, 2048, 256, 0, WS_W1C + (size_t)256 * 2048 * 2};
        case 5: return TrMat{18, 256, 64, 0, WS_W2C};             case 6: return TrMat{21, 256, 64, 0, WS_W2C + (size_t)64 * 256 * 2};
        case 7: return TrMat{10, FF, DM, 0, WS_W1D};
        case 8: return TrMat{27, DM, FF, 1, WS_W2GU};             case 9: return TrMat{28, DM, FF, 2, WS_W2GU};
        case 10: return TrMat{22, 1024, DM, 0, WS_WPH};           case 11: return TrMat{23, 1024, DM, 0, WS_WPN};
        case 12: return TrMat{24, DM, DM, 0, WS_WO};
        default: return TrMat{29, FF, DM, 0, WS_W2D};
    }
}
__device__ __forceinline__ int tr_items(const TrMat& t) { return (t.K / 64) * ((t.N + 63) / 64); }
__device__ __forceinline__ int dest_row_rt(int map, int n) {
    if (map == 1) return (n >> 7) * 256 + (n & 127);
    if (map == 2) return (n >> 7) * 256 + 128 + (n & 127);
    if (map == 3) return n < 5888 ? n : (n < 5936 ? C_NG + (n - 5888) : C_GA + (n - 5936));
    return n;
}
__device__ __forceinline__ void tr_item64(const float* W, int K, int N, bf16* WT, int map, LAS unsigned* scr, int item, int lane) {
    const int nblk = (N + 63) / 64, kb = item / nblk, nb = item % nblk, k0 = 64 * kb, n0 = 64 * nb, nn = n0 + lane; const bool ok = nn < N;
    const float* src = W + (size_t)k0 * N + (ok ? nn : 0);
    float v[64];
#pragma unroll
    for (int i = 0; i < 64; ++i) v[i] = src[(size_t)i * N];
#pragma unroll
    for (int i = 0; i < 32; ++i) scr[lane * 33 + i] = pk2(v[2 * i], v[2 * i + 1]);
    LDS_WAIT(); asm volatile("" ::: "memory");
    const int c = lane & 7;
#pragma unroll
    for (int j = 0; j < 8; ++j) { const int n = (lane >> 3) + 8 * j; v4u o; o.x = scr[n * 33 + 4 * c]; o.y = scr[n * 33 + 4 * c + 1]; o.z = scr[n * 33 + 4 * c + 2]; o.w = scr[n * 33 + 4 * c + 3];
        if (n0 + n < N) *(GAS v4u*)(WT + (size_t)dest_row_rt(map, n0 + n) * K + k0 + 8 * c) = o; }
    LDS_WAIT(); asm volatile("" ::: "memory");
}
__device__ __forceinline__ void tr_run(const void* const* in, unsigned char* ws, LAS unsigned* scr, int mlo, int mhi, int widx, int nw, int lane) {
    int total = 0;
    for (int m = mlo; m < mhi; ++m) total += tr_items(tr_mat(m));
    for (int it = widx; it < total; it += nw) { int r = it, m = mlo; TrMat t = tr_mat(m);
        while (r >= tr_items(t)) { r -= tr_items(t); ++m; t = tr_mat(m); }
        tr_item64((const float*)in[t.in_idx], t.K, t.N, (bf16*)(ws + t.dst), t.map, scr, r, lane); }
}
__device__ __forceinline__ void rms_row_to_bf16(const float* xrow, const float* g, bf16* orow, int lane) {
    const f4* xr = (const f4*)xrow + lane; const f4* gr = (const f4*)g + lane;
    f4 v[8]; float s = 0.f;
#pragma unroll
    for (int j = 0; j < 8; ++j) { v[j] = xr[64 * j]; s += (v[j].x * v[j].x + v[j].y * v[j].y) + (v[j].z * v[j].z + v[j].w * v[j].w); }
    const float r = rsqrtf(wsum(s) * (1.f / DM) + EPS);
    unsigned long long* o8 = (unsigned long long*)orow + lane;
#pragma unroll
    for (int j = 0; j < 8; ++j) { const f4 gg = gr[64 * j]; o8[64 * j] = (unsigned long long)pk2(v[j].x * r * gg.x, v[j].y * r * gg.y) | ((unsigned long long)pk2(v[j].z * r * gg.z, v[j].w * r * gg.w) << 32); }
}
__device__ __forceinline__ void norm_mid_row(const void* yrow_, const float* xin, const bf16* xin16, const float* gin, float rs_in, const float* gpost, float scale, float* xout, const float* gpre, bf16* xn, float* rs_out, int lane, int nslab = 0) {
    const f4* yr = (const f4*)yrow_ + lane; const f4* xr = (const f4*)xin + lane; const f4* gp = (const f4*)gpost + lane;
    f4 v[8]; float s = 0.f;
    if (nslab == 0) {
        const unsigned long long* y8 = (const unsigned long long*)yrow_ + lane;
#pragma unroll
        for (int j = 0; j < 8; ++j) { const unsigned long long w = y8[64 * j]; const unsigned lo = (unsigned)w, hi = (unsigned)(w >> 32);
            v[j] = (f4){__uint_as_float(lo << 16), __uint_as_float(lo & 0xffff0000u), __uint_as_float(hi << 16), __uint_as_float(hi & 0xffff0000u)}; }
    } else {
#pragma unroll
        for (int j = 0; j < 8; ++j) v[j] = yr[64 * j];
    }
    for (int k = 1; k + 3 < nslab; k += 4) {
        f4 t[4][8];
#pragma unroll
        for (int kk = 0; kk < 4; ++kk)
#pragma unroll
            for (int j = 0; j < 8; ++j) t[kk][j] = yr[64 * j + (size_t)(k + kk) * (SLABSZ / 4)];
#pragma unroll
        for (int kk = 0; kk < 4; ++kk)
#pragma unroll
            for (int j = 0; j < 8; ++j) v[j] += t[kk][j];
    }
    if (nslab > 0) { const int k0 = 1 + ((nslab - 1) / 4) * 4;
#pragma unroll
        for (int kk = 0; kk < 3; ++kk)
#pragma unroll
            for (int j = 0; j < 8; ++j) v[j] += yr[64 * j + (size_t)(k0 + kk) * (SLABSZ / 4)]; }
#pragma unroll
    for (int j = 0; j < 8; ++j) s += (v[j].x * v[j].x + v[j].y * v[j].y) + (v[j].z * v[j].z + v[j].w * v[j].w);
    const float r = rsqrtf(wsum(s) * (1.f / DM) + EPS) * scale;
    float s2 = 0.f;
#pragma unroll
    for (int j = 0; j < 8; ++j) { f4 xi;
        if (xin) xi = xr[64 * j];
        else { const f4 xb = ld4bf(xin16 + 4 * (lane + 64 * j)), gi = ((const f4*)gin + lane)[64 * j];
            xi = (f4){xb.x * rs_in * __builtin_amdgcn_rcpf(gi.x), xb.y * rs_in * __builtin_amdgcn_rcpf(gi.y), xb.z * rs_in * __builtin_amdgcn_rcpf(gi.z), xb.w * rs_in * __builtin_amdgcn_rcpf(gi.w)}; }
        const f4 gg = gp[64 * j]; v[j] = xi + v[j] * gg * r; if (xout) ((f4*)xout + lane)[64 * j] = v[j];
        s2 += (v[j].x * v[j].x + v[j].y * v[j].y) + (v[j].z * v[j].z + v[j].w * v[j].w); }
    if (xn) {
        const float ms = wsum(s2) * (1.f / DM) + EPS; const float r2 = rsqrtf(ms); const f4* gr = (const f4*)gpre + lane;
        if (rs_out && lane == 0) *rs_out = sqrtf(ms);
        unsigned long long* o8 = (unsigned long long*)xn + lane;
#pragma unroll
        for (int j = 0; j < 8; ++j) { const f4 gg = gr[64 * j]; o8[64 * j] = (unsigned long long)pk2(v[j].x * r2 * gg.x, v[j].y * r2 * gg.y) | ((unsigned long long)pk2(v[j].z * r2 * gg.z, v[j].w * r2 * gg.w) << 32); }
    }
}

__device__ __forceinline__ void hgrn_seq_pair(int rowbase, int h, int vg2, const float* S0, float* Sout, const bf16* QH, const float* LOGF, const bf16* KH, const bf16* VH, float* OHR, int lane) {
    const int kq = lane >> 1, vh = lane & 1, kc = h * 128 + 4 * kq, vc = h * 128 + 16 * vg2 + 4 * vh;
    f4 s[2][4], q4[4], lf[4], k4[4], v4[2][4];
#pragma unroll
    for (int u = 0; u < 2; ++u)
#pragma unroll
        for (int i = 0; i < 4; ++i) s[u][i] = *(const f4*)(S0 + (size_t)(4 * kq + i) * 128 + 16 * vg2 + 8 * u + 4 * vh);
#pragma unroll
    for (int t = 0; t < 4; ++t) { const size_t base = (size_t)(rowbase + t) * 1024; q4[t] = ld4bf(QH + base + kc); lf[t] = *(const f4*)(LOGF + base + kc); k4[t] = ld4bf(KH + base + kc);
        v4[0][t] = ld4bf(VH + base + vc); v4[1][t] = ld4bf(VH + base + vc + 8); }
#pragma unroll
    for (int t = 0; t < 4; ++t) {
        const size_t base = (size_t)(rowbase + t) * 1024;
        f4 o[2] = {(f4){0.f, 0.f, 0.f, 0.f}, (f4){0.f, 0.f, 0.f, 0.f}};
#pragma unroll
        for (int i = 0; i < 4; ++i) { const float f = __expf(lf[t][i]);
#pragma unroll
            for (int u = 0; u < 2; ++u) { s[u][i] = s[u][i] * f + v4[u][t] * k4[t][i]; o[u] += s[u][i] * q4[t][i]; } }
#pragma unroll
        for (int off = 2; off < 64; off <<= 1)
#pragma unroll
            for (int u = 0; u < 2; ++u) { o[u].x += __shfl_xor(o[u].x, off); o[u].y += __shfl_xor(o[u].y, off); o[u].z += __shfl_xor(o[u].z, off); o[u].w += __shfl_xor(o[u].w, off); }
        if (kq == 0) { *(f4*)(OHR + base + vc) = o[0]; *(f4*)(OHR + base + vc + 8) = o[1]; }
    }
#pragma unroll
    for (int u = 0; u < 2; ++u)
#pragma unroll
        for (int i = 0; i < 4; ++i) *(f4*)(Sout + (size_t)(4 * kq + i) * 128 + 16 * vg2 + 8 * u + 4 * vh) = s[u][i];
}
__device__ __forceinline__ void hgrn_finish_row(const float* orow, const bf16* grow, const float* gn, bf16* out, int lane) {
#pragma unroll
    for (int j = 0; j < 4; ++j) { const int idx = lane + 64 * j; const f4 o = ((const f4*)orow)[idx], g = ld4bf(grow + 4 * idx), w = ((const f4*)gn)[idx & 31];
        float s = (o.x * o.x + o.y * o.y) + (o.z * o.z + o.w * o.w);
#pragma unroll
        for (int off = 1; off < 32; off <<= 1) s += __shfl_xor(s, off);
        const float r = rsqrtf(s * (1.f / 128.f) + EPS);
        ((unsigned long long*)out)[idx] = (unsigned long long)pk2(o.x * r * w.x * g.x, o.y * r * w.y * g.y) | ((unsigned long long)pk2(o.z * r * w.z * g.z, o.w * r * w.w * g.w) << 32); }
}

typedef short bfx8 __attribute__((ext_vector_type(8)));
typedef short bfx4 __attribute__((ext_vector_type(4)));
__device__ __forceinline__ unsigned cvtpk(float lo, float hi) { return pg8::cvt_pk_bf16(lo, hi); }
__device__ __forceinline__ bfx8 lds_frag16(const LAS bf16* p) { return *(const LAS bfx8*)p; }
__device__ __forceinline__ bfx8 lds_frag8(const LAS bf16* p) { const bfx4 a = *(const LAS bfx4*)p, b = *(const LAS bfx4*)(p + 4); return (bfx8){a[0], a[1], a[2], a[3], b[0], b[1], b[2], b[3]}; }
__device__ __forceinline__ float bflo(unsigned w) { return __uint_as_float(w << 16); }
__device__ __forceinline__ float bfhi(unsigned w) { return __uint_as_float(w & 0xffff0000u); }
constexpr int HG_NCH = TP / 64;
constexpr int L_BF = 0, L_Q0 = 33792, L_QR = L_Q0 + 17408, L_KI = L_QR + 17408, L_VT = L_KI + 17408, L_AB = L_VT + 17408, L_TOT = L_AB + 9216, L_HEND = L_TOT + 2048;
static_assert(L_HEND <= RING_BYTES, "hgrn lds");
__device__ __forceinline__ void chunk_cumsum(const Ctx& C, const f4 (&lf)[4]) {
    LAS float* Bf = (LAS float*)(C.lds + L_BF); LAS float* tot = (LAS float*)(C.lds + L_TOT);
    __syncthreads();
#pragma unroll
    for (int j = 0; j < 4; ++j) ((LAS f4*)Bf)[C.tid + 512 * j] = lf[j];
    __syncthreads();
    const int k = C.tid & 127, qr = C.tid >> 7; float s = 0.f;
#pragma unroll
    for (int r = 0; r < 16; ++r) { s += Bf[(16 * qr + r) * 128 + k]; Bf[(16 * qr + r) * 128 + k] = s; }
    tot[qr * 128 + k] = s;
    __syncthreads();
    float off = 0.f;
    for (int q2 = 0; q2 < qr; ++q2) off += tot[q2 * 128 + k];
#pragma unroll
    for (int r = 0; r < 16; ++r) Bf[(16 * qr + r) * 128 + k] += off;
    __syncthreads();
}
__device__ __forceinline__ void hgrn_A_unit(const Ctx& C, int h, int c, const float* LOGF, const bf16* KH, const bf16* VH, float* UT, float* DD) {
    const int t0 = 64 * c, cb = h * 128;
    LAS float* Bf = (LAS float*)(C.lds + L_BF); LAS bf16* KT = (LAS bf16*)(C.lds + L_KI); LAS bf16* VT = (LAS bf16*)(C.lds + L_VT);
    f4 lf[4]; v4u kv[2], vv[2];
#pragma unroll
    for (int j = 0; j < 4; ++j) { const int idx = C.tid + 512 * j; lf[j] = *(const f4*)(LOGF + (size_t)(t0 + (idx >> 5)) * 1024 + cb + 4 * (idx & 31)); }
#pragma unroll
    for (int j = 0; j < 2; ++j) { const int idx = C.tid + 512 * j; const size_t g = (size_t)(t0 + (idx >> 4)) * 1024 + cb + 8 * (idx & 15); kv[j] = *(const v4u*)(KH + g); vv[j] = *(const v4u*)(VH + g); }
    chunk_cumsum(C, lf);
#pragma unroll
    for (int j = 0; j < 2; ++j) { const int idx = C.tid + 512 * j, s = idx >> 4, ch = 8 * (idx & 15);
        const f4 bl0 = ((const LAS f4*)Bf)[63 * 32 + (ch >> 2)], bl1 = ((const LAS f4*)Bf)[63 * 32 + (ch >> 2) + 1], bs0 = ((const LAS f4*)Bf)[s * 32 + (ch >> 2)], bs1 = ((const LAS f4*)Bf)[s * 32 + (ch >> 2) + 1];
        const unsigned kw[4] = {kv[j].x, kv[j].y, kv[j].z, kv[j].w}, vw[4] = {vv[j].x, vv[j].y, vv[j].z, vv[j].w};
        const float dl[8] = {bl0.x - bs0.x, bl0.y - bs0.y, bl0.z - bs0.z, bl0.w - bs0.w, bl1.x - bs1.x, bl1.y - bs1.y, bl1.z - bs1.z, bl1.w - bs1.w};
#pragma unroll
        for (int e = 0; e < 8; ++e) { const float kf = (e & 1) ? bfhi(kw[e >> 1]) : bflo(kw[e >> 1]);
            KT[(ch + e) * 68 + s] = (bf16)f2bf(kf * __expf(dl[e])); VT[(ch + e) * 68 + s] = (bf16)((e & 1) ? (vw[e >> 1] >> 16) : (vw[e >> 1] & 0xffffu)); } }
    if (C.tid < 128) DD[(size_t)(c * 8 + h) * 128 + C.tid] = __expf(Bf[63 * 128 + C.tid]);
    __syncthreads();
    const int w = C.wave, lane = C.lane, fr = lane & 15, kg = lane >> 4;
    pg8::f32x4 acc[8];
#pragma unroll
    for (int nt = 0; nt < 8; ++nt) acc[nt] = (pg8::f32x4){0.f, 0.f, 0.f, 0.f};
#pragma unroll
    for (int ks = 0; ks < 2; ++ks) { const bfx8 a = lds_frag8(VT + (16 * w + fr) * 68 + 32 * ks + 8 * kg);
#pragma unroll
        for (int nt = 0; nt < 8; ++nt) { const bfx8 b = lds_frag8(KT + (16 * nt + fr) * 68 + 32 * ks + 8 * kg); acc[nt] = __builtin_amdgcn_mfma_f32_16x16x32_bf16(a, b, acc[nt], 0, 0, 0); } }
    float* ut = UT + (size_t)(c * 8 + h) * 16384;
#pragma unroll
    for (int nt = 0; nt < 8; ++nt)
#pragma unroll
        for (int r = 0; r < 4; ++r) ut[(size_t)(16 * w + 4 * kg + r) * 128 + 16 * nt + fr] = acc[nt][r];
    __syncthreads();
}
__device__ __forceinline__ void hgrn_scan(int tix, int nthr, const float* UT, const float* DD, bf16* SP, float* hgp) {
    for (int e = tix; e < 8 * 16384; e += nthr) { const int h = e >> 14, vk = e & 16383, k = e & 127, v = vk >> 7;
        float S = 0.f;
        for (int c = 0; c < HG_NCH; c += 16) { float u[16], d[16];
#pragma unroll
            for (int i = 0; i < 16; ++i) { u[i] = UT[(size_t)((c + i) * 8 + h) * 16384 + vk]; d[i] = DD[(size_t)((c + i) * 8 + h) * 128 + k]; }
#pragma unroll
            for (int i = 0; i < 16; ++i) { SP[(size_t)((c + i) * 8 + h) * 16384 + vk] = (bf16)f2bf(S); S = S * d[i] + u[i]; } }
        hgp[(size_t)h * 16384 + k * 128 + v] = S; }
}
__device__ __forceinline__ void hgrn_B_unit(const Ctx& C, int h, int c, const bf16* QH, const float* LOGF, const bf16* KH, const bf16* VH, const bf16* GH, const float* gn, const bf16* SP, bf16* OHG) {
    const int t0 = 64 * c, cb = h * 128, tid = C.tid;
    LAS float* Bf = (LAS float*)(C.lds + L_BF); LAS bf16* Q0 = (LAS bf16*)(C.lds + L_Q0); LAS bf16* QR = (LAS bf16*)(C.lds + L_QR); LAS bf16* KI = (LAS bf16*)(C.lds + L_KI);
    LAS bf16* VT = (LAS bf16*)(C.lds + L_VT); LAS bf16* AB = (LAS bf16*)(C.lds + L_AB); LAS float* Of = (LAS float*)(C.lds + L_BF);
    STAMP(C, 9);
    f4 lf[4], q4[4], k4[4], b4[4]; v4u vv[2]; float gh[16];
    const int w = C.wave, lane = C.lane, fr = lane & 15, kg = lane >> 4;
#pragma unroll
    for (int j = 0; j < 4; ++j) { const int idx = tid + 512 * j; const size_t g = (size_t)(t0 + (idx >> 5)) * 1024 + cb + 4 * (idx & 31); lf[j] = *(const f4*)(LOGF + g);
        const u2 qw = *(const u2*)(QH + g), kw = *(const u2*)(KH + g); q4[j] = (f4){bflo(qw.x), bfhi(qw.x), bflo(qw.y), bfhi(qw.y)}; k4[j] = (f4){bflo(kw.x), bfhi(kw.x), bflo(kw.y), bfhi(kw.y)}; }
#pragma unroll
    for (int j = 0; j < 2; ++j) { const int idx = tid + 512 * j; vv[j] = *(const v4u*)(VH + (size_t)(t0 + (idx >> 4)) * 1024 + cb + 8 * (idx & 15)); }
#pragma unroll
    for (int rr = 0; rr < 8; ++rr) { const size_t g = (size_t)(t0 + 8 * w + rr) * 1024 + cb; gh[2 * rr] = bflo((unsigned)GH[g + lane]); gh[2 * rr + 1] = bflo((unsigned)GH[g + lane + 64]); }
    const bf16* sp = SP + (size_t)(c * 8 + h) * 16384; bfx8 spf[4][4];
#pragma unroll
    for (int ks = 0; ks < 4; ++ks)
#pragma unroll
        for (int nt = 0; nt < 4; ++nt) spf[ks][nt] = *(const bfx8*)(sp + (size_t)(16 * (4 * (w >> 2) + nt) + fr) * 128 + 32 * ks + 8 * kg);
    chunk_cumsum(C, lf);
    STAMP(C, 1);
#pragma unroll
    for (int j = 0; j < 4; ++j) { const int idx = tid + 512 * j, t = idx >> 5, c4 = idx & 31, i = t >> 4;
        const f4 q = q4[j]; b4[j] = ((const LAS f4*)Bf)[idx];
        const f4 r = i > 0 ? ((const LAS f4*)Bf)[(16 * i - 1) * 32 + c4] : (f4){0.f, 0.f, 0.f, 0.f};
        u2 w0, w1;
        w0.x = cvtpk(q.x * __expf(b4[j].x), q.y * __expf(b4[j].y)); w0.y = cvtpk(q.z * __expf(b4[j].z), q.w * __expf(b4[j].w));
        w1.x = cvtpk(q.x * __expf(b4[j].x - r.x), q.y * __expf(b4[j].y - r.y)); w1.y = cvtpk(q.z * __expf(b4[j].z - r.z), q.w * __expf(b4[j].w - r.w));
        *(LAS u2*)(Q0 + t * 136 + 4 * c4) = w0; *(LAS u2*)(QR + t * 136 + 4 * c4) = w1; }
#pragma unroll
    for (int j = 0; j < 2; ++j) { const int idx = tid + 512 * j, s = idx >> 4, ch = 8 * (idx & 15); const unsigned vw[4] = {vv[j].x, vv[j].y, vv[j].z, vv[j].w};
#pragma unroll
        for (int e = 0; e < 8; ++e) VT[(ch + e) * 68 + s] = (bf16)((e & 1) ? (vw[e >> 1] >> 16) : (vw[e >> 1] & 0xffffu)); }
    for (int e = tid; e < 64 * 72 / 2; e += 512) ((LAS unsigned*)AB)[e] = 0u;
    STAMP(C, 2);
    for (int i = 0; i < 4; ++i) {
        const f4 r = i > 0 ? ((const LAS f4*)Bf)[(16 * i - 1) * 32 + (tid & 31)] : (f4){0.f, 0.f, 0.f, 0.f};
#pragma unroll
        for (int j = 0; j < 4; ++j) if (j <= i) { const int t = (tid >> 5) + 16 * j; u2 wv;
            wv.x = cvtpk(k4[j].x * __expf(r.x - b4[j].x), k4[j].y * __expf(r.y - b4[j].y)); wv.y = cvtpk(k4[j].z * __expf(r.z - b4[j].z), k4[j].w * __expf(r.w - b4[j].w));
            *(LAS u2*)(KI + t * 136 + 4 * (tid & 31)) = wv; }
        __syncthreads();
        if (w <= i) { pg8::f32x4 a4 = (pg8::f32x4){0.f, 0.f, 0.f, 0.f};
#pragma unroll
            for (int ks = 0; ks < 4; ++ks) { const bfx8 a = lds_frag16(QR + (16 * i + fr) * 136 + 32 * ks + 8 * kg), b = lds_frag16(KI + (16 * w + fr) * 136 + 32 * ks + 8 * kg);
                a4 = __builtin_amdgcn_mfma_f32_16x16x32_bf16(a, b, a4, 0, 0, 0); }
#pragma unroll
            for (int rr = 0; rr < 4; ++rr) { const int tl = 4 * kg + rr; const float val = (w < i || fr <= tl) ? a4[rr] : 0.f; AB[(16 * i + tl) * 72 + 16 * w + fr] = (bf16)f2bf(val); } }
        __syncthreads();
    }
    STAMP(C, 3);
    const int rt = w & 3, chf = w >> 2;
    pg8::f32x4 acc[4];
#pragma unroll
    for (int nt = 0; nt < 4; ++nt) acc[nt] = (pg8::f32x4){0.f, 0.f, 0.f, 0.f};
#pragma unroll
    for (int ks = 0; ks < 4; ++ks) { const bfx8 a = lds_frag16(Q0 + (16 * rt + fr) * 136 + 32 * ks + 8 * kg);
#pragma unroll
        for (int nt = 0; nt < 4; ++nt) acc[nt] = __builtin_amdgcn_mfma_f32_16x16x32_bf16(a, spf[ks][nt], acc[nt], 0, 0, 0); }
#pragma unroll
    for (int ks = 0; ks < 2; ++ks) if (2 * ks <= rt) { const bfx8 a = lds_frag16(AB + (16 * rt + fr) * 72 + 32 * ks + 8 * kg);
#pragma unroll
        for (int nt = 0; nt < 4; ++nt) { const bfx8 b = lds_frag8(VT + (16 * (4 * chf + nt) + fr) * 68 + 32 * ks + 8 * kg); acc[nt] = __builtin_amdgcn_mfma_f32_16x16x32_bf16(a, b, acc[nt], 0, 0, 0); } }
#pragma unroll
    for (int nt = 0; nt < 4; ++nt)
#pragma unroll
        for (int rr = 0; rr < 4; ++rr) Of[(16 * rt + 4 * kg + rr) * 132 + 16 * (4 * chf + nt) + fr] = acc[nt][rr];
    __syncthreads();
#pragma unroll
    for (int rr = 0; rr < 8; ++rr) { const int row = 8 * w + rr; const float o0 = Of[row * 132 + lane], o1 = Of[row * 132 + lane + 64];
        const float rs = rsqrtf(wsum(o0 * o0 + o1 * o1) * (1.f / 128.f) + EPS); const size_t g = (size_t)(t0 + row) * 1024 + cb;
        OHG[g + lane] = (bf16)f2bf(o0 * rs * gn[lane] * gh[2 * rr]); OHG[g + lane + 64] = (bf16)f2bf(o1 * rs * gn[lane + 64] * gh[2 * rr + 1]); }
    __syncthreads();
    STAMP(C, 4);
}
typedef float f16v __attribute__((ext_vector_type(16)));
constexpr float LOG2E = 1.4426950408889634f;
constexpr int NL_KT = 0, NL_VT = 9216, NL_GS = 18432, NL_LS = NL_GS + 16384, NL_SEL = NL_LS + 16384, NL_UNI = NL_SEL + 512, NL_OACC = NL_UNI + 64, NL_END = NL_OACC + 8 * 8192;
static_assert(NL_END <= RING_BYTES, "nsa lds");
struct NsaP { const bf16* QN16; const bf16* KSL; const bf16* VSL; const bf16* KWN; const bf16* VWN; const bf16* KC16; const bf16* VC16; const float* NG; bf16* ONSA; };
__device__ __forceinline__ float ex2(float x) { return __builtin_amdgcn_exp2f(x); }
__device__ __forceinline__ void nsa_fetch(const Ctx& C, const bf16* ksrc, const bf16* vsrc, int pitch, int nvalid, v4u& kr, v4u& vr) {
    { const int key = C.tid >> 3, d8 = C.tid & 7; kr = (v4u){0u, 0u, 0u, 0u}; if (key < nvalid) kr = *(const v4u*)(ksrc + (size_t)key * pitch + 8 * d8); }
    { const int key = C.tid & 63, d8 = C.tid >> 6; vr = (v4u){0u, 0u, 0u, 0u}; if (key < nvalid) vr = *(const v4u*)(vsrc + (size_t)key * pitch + 8 * d8); }
}
__device__ __forceinline__ void nsa_put(const Ctx& C, const v4u& kr, const v4u& vr) {
    LAS bf16* KT = (LAS bf16*)(C.lds + NL_KT); LAS bf16* VT = (LAS bf16*)(C.lds + NL_VT);
    { const int key = C.tid >> 3, d8 = C.tid & 7; *(LAS v4u*)(KT + key * 72 + 8 * d8) = kr; }
    { const int key = C.tid & 63, d8 = C.tid >> 6; const v4u v = vr; LAS bf16* p = VT + (8 * d8) * 72 + key;
        p[0] = (bf16)(v.x & 0xffffu); p[72] = (bf16)(v.x >> 16); p[144] = (bf16)(v.y & 0xffffu); p[216] = (bf16)(v.y >> 16);
        p[288] = (bf16)(v.z & 0xffffu); p[360] = (bf16)(v.z >> 16); p[432] = (bf16)(v.w & 0xffffu); p[504] = (bf16)(v.w >> 16); }
}
__device__ __forceinline__ int prev_bit(const unsigned (&u)[4], int below) {
#pragma unroll
    for (int wi = 3; wi >= 0; --wi) { const int lim = below - 32 * wi; if (lim <= 0) continue; const unsigned m = lim >= 32 ? u[wi] : (u[wi] & ((1u << lim) - 1u)); if (m) return 32 * wi + 31 - __clz(m); }
    return -1;
}
template <int NT> __device__ __forceinline__ void nsa_scores_t(const LAS bf16* KT, int lane, const bfx8 (&qf)[4], int klo, int khi, float base, float inc, f16v (&s)[NT]) {
    const int q = lane & 31, hi = lane >> 5;
    int kl = klo - 4 * hi, kh = khi - 4 * hi; float bh = fmaf(inc, (float)(4 * hi), base);
    asm volatile("" : "+v"(inc), "+v"(bh), "+v"(kl), "+v"(kh));
#pragma unroll
    for (int t = 0; t < NT; ++t) { s[t] = (f16v){0.f, 0.f, 0.f, 0.f, 0.f, 0.f, 0.f, 0.f, 0.f, 0.f, 0.f, 0.f, 0.f, 0.f, 0.f, 0.f};
#pragma unroll
        for (int ks = 0; ks < 4; ++ks) { const bfx8 a = *(const LAS bfx8*)(KT + (32 * t + q) * 72 + 16 * ks + 8 * hi); s[t] = __builtin_amdgcn_mfma_f32_32x32x16_bf16(a, qf[ks], s[t], 0, 0, 0); } }
    if (__builtin_amdgcn_readfirstlane(__all(klo <= 0 && khi >= 32 * NT - 1))) {
#pragma unroll
        for (int t = 0; t < NT; ++t)
#pragma unroll
            for (int r = 0; r < 16; ++r) { const int cr = 32 * t + (r & 3) + 8 * (r >> 2); s[t][r] = s[t][r] + fmaf(inc, (float)cr, bh); }
    } else {
#pragma unroll
        for (int t = 0; t < NT; ++t)
#pragma unroll
            for (int r = 0; r < 16; ++r) { const int cr = 32 * t + (r & 3) + 8 * (r >> 2); const float v = s[t][r] + fmaf(inc, (float)cr, bh); s[t][r] = (cr >= kl && cr <= kh) ? v : -INFINITY; }
    }
}
__device__ __forceinline__ void nsa_scores(const Ctx& C, const bfx8 (&qf)[4], int klo, int khi, float base, float inc, f16v (&s)[2]) { nsa_scores_t<2>((const LAS bf16*)(C.lds + NL_KT), C.lane, qf, klo, khi, base, inc, s); }
template <int NT, int VP> __device__ __forceinline__ void nsa_block_t(const LAS bf16* KT, const LAS bf16* VT, int lane, const bfx8 (&qf)[4], int klo, int khi, float base, float inc, float& m, float& l, f16v (&O)[2]) {
    const int q = lane & 31, hi = lane >> 5;
    if (!__builtin_amdgcn_readfirstlane(__any(khi >= klo))) return;
    f16v s[NT];
    nsa_scores_t<NT>(KT, lane, qf, klo, khi, base, inc, s);
    float mx = -INFINITY;
#pragma unroll
    for (int t = 0; t < NT; ++t)
#pragma unroll
        for (int r = 0; r < 16; ++r) mx = fmaxf(mx, s[t][r]);
    mx = fmaxf(mx, __shfl_xor(mx, 32));
    const float mn = fmaxf(m, mx), alpha = ex2(m - mn); m = mn;
    float rs = 0.f;
#pragma unroll
    for (int t = 0; t < NT; ++t)
#pragma unroll
        for (int r = 0; r < 16; ++r) { const float p = ex2(s[t][r] - mn); s[t][r] = p; rs += p; }
    l = l * alpha + rs;
    if (__builtin_amdgcn_readfirstlane(__any(alpha != 1.0f))) {
#pragma unroll
        for (int dt = 0; dt < 2; ++dt) O[dt] = O[dt] * alpha; }
#pragma unroll
    for (int t = 0; t < NT; ++t)
#pragma unroll
        for (int s2 = 0; s2 < 2; ++s2) {
            union { unsigned u[4]; bfx8 v; } pb;
#pragma unroll
            for (int j = 0; j < 4; ++j) pb.u[j] = cvtpk(s[t][8 * s2 + 2 * j], s[t][8 * s2 + 2 * j + 1]);
#pragma unroll
            for (int dt = 0; dt < 2; ++dt) { const LAS bf16* vp = VT + (32 * dt + q) * VP + 32 * t + 16 * s2 + 4 * hi; const bfx4 va = *(const LAS bfx4*)vp, vb = *(const LAS bfx4*)(vp + 8); const bfx8 a = (bfx8){va[0], va[1], va[2], va[3], vb[0], vb[1], vb[2], vb[3]}; O[dt] = __builtin_amdgcn_mfma_f32_32x32x16_bf16(a, pb.v, O[dt], 0, 0, 0); }
        }
}
__device__ __forceinline__ void nsa_block(const Ctx& C, const bfx8 (&qf)[4], int klo, int khi, float base, float inc, float& m, float& l, f16v (&O)[2]) {
    nsa_block_t<2, 72>((const LAS bf16*)(C.lds + NL_KT), (const LAS bf16*)(C.lds + NL_VT), C.lane, qf, klo, khi, base, inc, m, l, O); }
__device__ __forceinline__ void nsa_prompt_unit(const Ctx& C, const NsaP& A, int qt, int n) {
    int lane = C.lane; asm volatile("" : "+v"(lane));
    const int w = C.wave, q = lane & 31, hi = lane >> 5, tl = q >> 3, g = q & 7, tok = 4 * w + tl, q0 = 32 * qt, qpos = q0 + tok, head = n * 8 + g;
    LAS float* GS = (LAS float*)(C.lds + NL_GS); LAS float* LS = (LAS float*)(C.lds + NL_LS); LAS unsigned* SEL = (LAS unsigned*)(C.lds + NL_SEL); LAS unsigned* UNI = (LAS unsigned*)(C.lds + NL_UNI);
    const float slope2 = exp2f(-0.5f * (float)(head + 1)) * LOG2E;
    bfx8 qf[4];
#pragma unroll
    for (int ks = 0; ks < 4; ++ks) qf[ks] = *(const bfx8*)(A.QN16 + (size_t)qpos * 1024 + head * 64 + 16 * ks + 8 * hi);
    const float* gates = A.NG + (size_t)qpos * 48 + head * 3;
    f16v O[2]; float m, l;
    LAS float* OA = (LAS float*)(C.lds + NL_OACC + w * 8192) + lane;
#define NP_INIT() do { m = -1e30f; l = 0.f; O[0] = (f16v){0.f, 0.f, 0.f, 0.f, 0.f, 0.f, 0.f, 0.f, 0.f, 0.f, 0.f, 0.f, 0.f, 0.f, 0.f, 0.f}; O[1] = O[0]; } while (0)
#define NP_FIN(br) do { const float lt = l + __shfl_xor(l, 32); const float sc = gates[br] / fmaxf(lt, 1e-30f); _Pragma("unroll") for (int dt = 0; dt < 2; ++dt) _Pragma("unroll") for (int r = 0; r < 16; ++r) { \
        const float pv = (br) == 0 ? 0.f : OA[(dt * 16 + r) * 64]; OA[(dt * 16 + r) * 64] = pv + O[dt][r] * sc; } l = lt; } while (0)
    __syncthreads();
    for (int i = C.tid; i < 8192; i += NTHR) GS[i] = 0.f;
    const int cmax = qpos >= 31 ? (qpos - 31) >> 4 : -1;
    const int ncb = ((q0 + 31 - 31) >> 4) / 64 + 1;
    const bf16* kc = A.KC16 + (size_t)n * 512 * 64; const bf16* vc = A.VC16 + (size_t)n * 512 * 64;
    NP_INIT();
    v4u kr, vr;
#define FETCH_C(cb_) nsa_fetch(C, kc + (size_t)(cb_) * 4096, vc + (size_t)(cb_) * 4096, 64, (NCP - 64 * (cb_)) < 64 ? (NCP - 64 * (cb_)) : 64, kr, vr)
    FETCH_C(ncb - 1);
    for (int cb = ncb - 1; cb >= 0; --cb) { const int nk = (NCP - 64 * cb) < 64 ? (NCP - 64 * cb) : 64;
        __syncthreads(); nsa_put(C, kr, vr); __syncthreads();
        if (cb > 0) FETCH_C(cb - 1);
        int khi = cmax - 64 * cb; if (khi > nk - 1) khi = nk - 1;
        nsa_block(C, qf, 0, khi, -slope2 * (float)(qpos - 31 - 1024 * cb), 16.f * slope2, m, l, O); }
    NP_FIN(0);
    { const float invl = 1.f / fmaxf(l, 1e-30f);
      FETCH_C(ncb - 1);
      for (int cb = ncb - 1; cb >= 0; --cb) { const int nk = (NCP - 64 * cb) < 64 ? (NCP - 64 * cb) : 64;
        __syncthreads(); nsa_put(C, kr, vr); __syncthreads();
        if (cb > 0) FETCH_C(cb - 1);
        int khi = cmax - 64 * cb; if (khi > nk - 1) khi = nk - 1;
        f16v s[2]; nsa_scores(C, qf, 0, khi, -slope2 * (float)(qpos - 31 - 1024 * cb), 16.f * slope2, s);
#pragma unroll
        for (int t = 0; t < 2; ++t)
#pragma unroll
            for (int a = 0; a < 4; ++a) { float p[4];
#pragma unroll
                for (int j = 0; j < 4; ++j) { float x = ex2(s[t][4 * a + j] - m) * invl; x += __shfl_xor(x, 1); x += __shfl_xor(x, 2); x += __shfl_xor(x, 4); p[j] = x; }
                if (g == 0) { const int grp = 16 * cb + 8 * t + 2 * a + hi; GS[tok * 128 + grp] = ((p[0] + p[1]) + p[2]) + p[3]; LS[tok * 128 + grp] = p[3]; } } } }
    __syncthreads();
    for (int t4 = 0; t4 < 4; ++t4) { const int tk = 4 * w + t4, qp = q0 + tk, qblk = qp >> 6;
        bool cand[2], forced[2]; unsigned u[2];
#pragma unroll
        for (int r = 0; r < 2; ++r) { const int blk = lane + 64 * r; const bool valid = blk <= qblk; const bool fz = blk == 0 || blk == qblk || blk == qblk - 1;
            const float scv = GS[tk * 128 + blk] + (blk > 0 ? LS[tk * 128 + blk - 1] : 0.f);
            forced[r] = valid && fz; cand[r] = valid && !fz; u[r] = cand[r] ? __float_as_uint(scv) : 0u; }
        const int nforced = qblk == 0 ? 1 : (qblk == 1 ? 2 : 3), need = SLCT - nforced;
        const int ncand = __popcll(__ballot(cand[0])) + __popcll(__ballot(cand[1]));
        bool sel[2];
        if (ncand <= need) { sel[0] = forced[0] || cand[0]; sel[1] = forced[1] || cand[1]; }
        else { unsigned T = 0u;
            for (int bit = 30; bit >= 0; --bit) { const unsigned c = T | (1u << bit); const int cnt = __popcll(__ballot(cand[0] && u[0] >= c)) + __popcll(__ballot(cand[1] && u[1] >= c)); if (cnt >= need) T = c; }
            const bool gt0 = cand[0] && u[0] > T, gt1 = cand[1] && u[1] > T, eq0 = cand[0] && u[0] == T, eq1 = cand[1] && u[1] == T;
            const int rem = need - (__popcll(__ballot(gt0)) + __popcll(__ballot(gt1)));
            const unsigned long long be0 = __ballot(eq0), be1 = __ballot(eq1), lt = (1ull << lane) - 1ull;
            const int i0 = __popcll(be0 & lt), i1 = __popcll(be0) + __popcll(be1 & lt);
            sel[0] = forced[0] || gt0 || (eq0 && i0 < rem); sel[1] = forced[1] || gt1 || (eq1 && i1 < rem); }
        const unsigned long long b0 = __ballot(sel[0]), b1 = __ballot(sel[1]);
        if (lane == 0) { SEL[tk * 4 + 0] = (unsigned)b0; SEL[tk * 4 + 1] = (unsigned)(b0 >> 32); SEL[tk * 4 + 2] = (unsigned)b1; SEL[tk * 4 + 3] = (unsigned)(b1 >> 32); } }
    __syncthreads();
    if (C.tid < 4) { unsigned o = 0u; for (int t = 0; t < 32; ++t) o |= SEL[t * 4 + C.tid]; UNI[C.tid] = o; }
    __syncthreads();
    const unsigned sw0 = SEL[tok * 4 + 0], sw1 = SEL[tok * 4 + 1], sw2 = SEL[tok * 4 + 2], sw3 = SEL[tok * 4 + 3];
    const unsigned un0 = UNI[0], un1 = UNI[1], un2 = UNI[2], un3 = UNI[3];
    NP_INIT();
    { const unsigned un[4] = {un0, un1, un2, un3};
#define FETCH_S(b_) nsa_fetch(C, A.KSL + (size_t)(64 * (b_)) * 128 + n * 64, A.VSL + (size_t)(64 * (b_)) * 128 + n * 64, 128, 64, kr, vr)
      int blk = prev_bit(un, 128);
      if (blk >= 0) FETCH_S(blk);
      while (blk >= 0) {
        __syncthreads(); nsa_put(C, kr, vr); __syncthreads();
        const int nb = prev_bit(un, blk); if (nb >= 0) FETCH_S(nb);
        const unsigned mw = blk < 32 ? sw0 : (blk < 64 ? sw1 : (blk < 96 ? sw2 : sw3));
        int khi = ((mw >> (blk & 31)) & 1u) ? qpos - 64 * blk : -1; if (khi > 63) khi = 63;
        nsa_block(C, qf, 0, khi, -slope2 * (float)(qpos - 64 * blk), slope2, m, l, O);
        blk = nb; } }
    NP_FIN(1);
    NP_INIT();
    { int kb0 = q0 - (WIN - 1); if (kb0 < 0) kb0 = 0; kb0 >>= 6;
#define FETCH_W(b_) nsa_fetch(C, A.KWN + (size_t)(64 * (b_)) * 128 + n * 64, A.VWN + (size_t)(64 * (b_)) * 128 + n * 64, 128, 64, kr, vr)
      FETCH_W((q0 + 31) >> 6);
      for (int kb = (q0 + 31) >> 6; kb >= kb0; --kb) {
        __syncthreads(); nsa_put(C, kr, vr); __syncthreads();
        if (kb > kb0) FETCH_W(kb - 1);
        int klo = qpos - (WIN - 1) - 64 * kb; if (klo < 0) klo = 0; int khi = qpos - 64 * kb; if (khi > 63) khi = 63;
        nsa_block(C, qf, klo, khi, -slope2 * (float)(qpos - 64 * kb), slope2, m, l, O); } }
    NP_FIN(2);
    bf16* orow = A.ONSA + (size_t)qpos * 1024 + head * 64;
#pragma unroll
    for (int dt = 0; dt < 2; ++dt)
#pragma unroll
        for (int a = 0; a < 4; ++a) { const int rb = (dt * 16 + 4 * a) * 64; u2 wv; wv.x = cvtpk(OA[rb], OA[rb + 64]); wv.y = cvtpk(OA[rb + 128], OA[rb + 192]); *(u2*)(orow + 32 * dt + 8 * a + 4 * hi) = wv; }
    __syncthreads();
#undef NP_INIT
#undef NP_FIN
#undef FETCH_C
#undef FETCH_S
#undef FETCH_W
}

struct NsaS { const bf16* QN; const float* KVO; const float* WINF; const float* NG; const float* cache; const float* cwin; const int* pt; const float* kcs; const float* vcs; bf16* ONSA; };
constexpr int SL_MW = 0, SL_LW = 2048, SL_GS = 4096, SL_LS = 6144, SL_SEL = 8192, SL_LIST = 8256, SL_CNT = 8416, SL_ROW = 8448, SL_KT = 12544, SL_VT = SL_KT + 8 * 4608, SL_END = SL_VT + 8 * 5120, SL_OW = SL_KT;
static_assert(SL_END <= RING_BYTES && SL_OW + 8 * 8192 <= SL_END, "nsa sample lds");
__device__ __forceinline__ bool ns_rows(const Ctx& C, const NsaS& A, int mode, int j, int b, int n, int slot, const float*& kp, const float*& vp) {
    if (mode == 0) { if (slot >= NCS) return false; kp = A.kcs + ((size_t)(b * 2 + n) * NCS + slot) * 64; vp = A.vcs + ((size_t)(b * 2 + n) * NCS + slot) * 64; return true; }
    if (mode == 1) { const LAS int* LIST = (const LAS int*)(C.lds + SL_LIST); const int cnt = *(const LAS int*)(C.lds + SL_CNT); const int e = 4 * j + (slot >> 6), kk = slot & 63;
        if (e >= cnt) return false; const int blk = LIST[e];
        if (blk < 32) { const float* base = A.cache + ((size_t)(A.pt[b * 16 + (blk >> 1)] * 128 + (blk & 1) * 64 + kk) * 4) * 128 + n * 64; kp = base + 256; vp = base + 384; return true; }
        if (kk >= DS) return false; const float* base = A.KVO + (size_t)(TP + b * 4 + kk) * 512 + n * 64; kp = base + 256; vp = base + 384; return true; }
    const int wi = 256 * j + slot;
    if (wi < 512) { const float* base = A.cwin + ((size_t)b * 512 + wi) * 256 + n * 64; kp = base; vp = base + 128; return true; }
    if (wi < 512 + DS) { const float* base = A.WINF + (size_t)(TP + b * 4 + wi - 512) * 256 + n * 64; kp = base; vp = base + 128; return true; }
    return false;
}
__device__ __forceinline__ void ns_stage(const Ctx& C, const NsaS& A, int mode, int j, int b, int n) {
    LAS unsigned long long* RK = (LAS unsigned long long*)(C.lds + SL_ROW); LAS unsigned long long* RV = RK + 256;
    if (C.tid < 256) { const float* kp = nullptr; const float* vp = nullptr; const bool ok = ns_rows(C, A, mode, j, b, n, C.tid, kp, vp); RK[C.tid] = ok ? (unsigned long long)kp : 0ull; RV[C.tid] = ok ? (unsigned long long)vp : 0ull; }
    __syncthreads();
    { const int slot = C.tid >> 1, half = C.tid & 1; const float* kp = (const float*)RK[slot];
      LAS bf16* dst = (LAS bf16*)(C.lds + SL_KT + (slot >> 5) * 4608) + (slot & 31) * 72 + 32 * half;
      f4 x[8];
#pragma unroll
      for (int i = 0; i < 8; ++i) x[i] = kp ? *(const f4*)(kp + 32 * half + 4 * i) : (f4){0.f, 0.f, 0.f, 0.f};
#pragma unroll
      for (int i = 0; i < 4; ++i) { v4u o; o.x = cvtpk(x[2 * i].x, x[2 * i].y); o.y = cvtpk(x[2 * i].z, x[2 * i].w); o.z = cvtpk(x[2 * i + 1].x, x[2 * i + 1].y); o.w = cvtpk(x[2 * i + 1].z, x[2 * i + 1].w); *(LAS v4u*)(dst + 8 * i) = o; } }
    { const int slot = C.tid & 255, dq = C.tid >> 8; const float* vp = (const float*)RV[slot];
      LAS bf16* dst = (LAS bf16*)(C.lds + SL_VT + (slot >> 5) * 5120) + (32 * dq) * 40 + (slot & 31);
      f4 x[8];
#pragma unroll
      for (int i = 0; i < 8; ++i) x[i] = vp ? *(const f4*)(vp + 32 * dq + 4 * i) : (f4){0.f, 0.f, 0.f, 0.f};
#pragma unroll
      for (int i = 0; i < 8; ++i) { dst[(4 * i) * 40] = (bf16)f2bf(x[i].x); dst[(4 * i + 1) * 40] = (bf16)f2bf(x[i].y); dst[(4 * i + 2) * 40] = (bf16)f2bf(x[i].z); dst[(4 * i + 3) * 40] = (bf16)f2bf(x[i].w); } }
}
__device__ __forceinline__ void nsa_sample_unit(const Ctx& C, const NsaS& A, int b, int n) {
    int lane = C.lane; asm volatile("" : "+v"(lane));
    const int w = C.wave, q = lane & 31, hi = lane >> 5, tl = q >> 3, g = q & 7, head = n * 8 + g, qpos = PASTL + tl, mrow = TP + 4 * b + tl;
    const LAS bf16* KTw = (const LAS bf16*)(C.lds + SL_KT + w * 4608); const LAS bf16* VTw = (const LAS bf16*)(C.lds + SL_VT + w * 5120);
    LAS float* MW = (LAS float*)(C.lds + SL_MW); LAS float* LW = (LAS float*)(C.lds + SL_LW); LAS float* GS = (LAS float*)(C.lds + SL_GS); LAS float* LS = (LAS float*)(C.lds + SL_LS);
    LAS unsigned* SEL = (LAS unsigned*)(C.lds + SL_SEL); LAS int* LIST = (LAS int*)(C.lds + SL_LIST); LAS int* CNT = (LAS int*)(C.lds + SL_CNT); LAS float* OW = (LAS float*)(C.lds + SL_OW);
    const float slope2 = exp2f(-0.5f * (float)(head + 1)) * LOG2E;
    bfx8 qf[4];
#pragma unroll
    for (int ks = 0; ks < 4; ++ks) qf[ks] = *(const bfx8*)(A.QN + (size_t)mrow * 1024 + head * 64 + 16 * ks + 8 * hi);
    const float* gates = A.NG + (size_t)mrow * 48 + head * 3;
    float acc4[4] = {0.f, 0.f, 0.f, 0.f}; f16v O[2]; float m, l;
#define NS_INIT() do { m = -1e30f; l = 0.f; O[0] = (f16v){0.f, 0.f, 0.f, 0.f, 0.f, 0.f, 0.f, 0.f, 0.f, 0.f, 0.f, 0.f, 0.f, 0.f, 0.f, 0.f}; O[1] = O[0]; } while (0)
#define NS_MERGE(br) do { MW[w * 64 + lane] = m; LW[w * 64 + lane] = l; _Pragma("unroll") for (int dt = 0; dt < 2; ++dt) _Pragma("unroll") for (int r = 0; r < 16; ++r) OW[(w * 32 + dt * 16 + r) * 64 + lane] = O[dt][r]; \
        __syncthreads(); float M_ = -1e30f; _Pragma("unroll") for (int w2 = 0; w2 < 8; ++w2) M_ = fmaxf(M_, MW[w2 * 64 + lane]); float L_ = 0.f, o_[4] = {0.f, 0.f, 0.f, 0.f}; \
        _Pragma("unroll") for (int w2 = 0; w2 < 8; ++w2) { const float sc_ = ex2(MW[w2 * 64 + lane] - M_); L_ += (LW[w2 * 64 + lane] + LW[w2 * 64 + (lane ^ 32)]) * sc_; \
            _Pragma("unroll") for (int r = 0; r < 4; ++r) o_[r] += OW[(w2 * 32 + 4 * w + r) * 64 + lane] * sc_; } \
        const float gs_ = gates[br] / fmaxf(L_, 1e-30f); _Pragma("unroll") for (int r = 0; r < 4; ++r) acc4[r] += o_[r] * gs_; __syncthreads(); } while (0)
    __syncthreads();
    for (int i = C.tid; i < 1024; i += NTHR) GS[i] = 0.f;
    ns_stage(C, A, 0, 0, b, n);
    __syncthreads();
    { int khi = (NCS - 1) - 32 * w; if (khi > 31) khi = 31; const float base = -slope2 * (float)(qpos - 31 - 512 * w), inc = 16.f * slope2;
      NS_INIT(); nsa_block_t<1, 40>(KTw, VTw, lane, qf, 0, khi, base, inc, m, l, O);
      MW[w * 64 + lane] = m; LW[w * 64 + lane] = l;
      __syncthreads();
      float M_ = -1e30f;
#pragma unroll
      for (int w2 = 0; w2 < 8; ++w2) M_ = fmaxf(M_, MW[w2 * 64 + lane]);
      float L_ = 0.f;
#pragma unroll
      for (int w2 = 0; w2 < 8; ++w2) L_ += (LW[w2 * 64 + lane] + LW[w2 * 64 + (lane ^ 32)]) * ex2(MW[w2 * 64 + lane] - M_);
      const float invl = 1.f / fmaxf(L_, 1e-30f);
      f16v s[1]; nsa_scores_t<1>(KTw, lane, qf, 0, khi, base, inc, s);
#pragma unroll
      for (int a = 0; a < 4; ++a) { float p[4];
#pragma unroll
          for (int jj = 0; jj < 4; ++jj) { float x = ex2(s[0][4 * a + jj] - M_) * invl; x += __shfl_xor(x, 1); x += __shfl_xor(x, 2); x += __shfl_xor(x, 4); p[jj] = x; }
          if (g == 0) { const int grp = 8 * w + 2 * a + hi; GS[tl * 128 + grp] = ((p[0] + p[1]) + p[2]) + p[3]; LS[tl * 128 + grp] = p[3]; } }
      __syncthreads();
      NS_MERGE(0); }
    if (w == 0) {
        unsigned long long uni = 0ull;
#pragma unroll 1
        for (int t4 = 0; t4 < 4; ++t4) { const int blk = lane; const bool valid = blk < NSS, fz = blk == 0 || blk == NSS - 1 || blk == NSS - 2; const bool cand = valid && !fz, forced = valid && fz;
            const float scv = valid ? GS[t4 * 128 + blk] + (blk > 0 ? LS[t4 * 128 + blk - 1] : 0.f) : 0.f; const unsigned u = cand ? __float_as_uint(scv) : 0u;
            const int need = SLCT - 3; unsigned T = 0u;
            for (int bit = 30; bit >= 0; --bit) { const unsigned c = T | (1u << bit); if (__popcll(__ballot(cand && u >= c)) >= need) T = c; }
            const bool gt = cand && u > T, eq = cand && u == T; const int rem = need - __popcll(__ballot(gt)); const unsigned long long be = __ballot(eq), lt = (1ull << lane) - 1ull;
            const bool sel = forced || gt || (eq && __popcll(be & lt) < rem); const unsigned long long bs = __ballot(sel);
            if (lane == 0) { SEL[t4 * 2] = (unsigned)bs; SEL[t4 * 2 + 1] = (unsigned)(bs >> 32); } uni |= bs; }
        const bool on = (uni >> lane) & 1ull; const int pos = __popcll(uni & ((1ull << lane) - 1ull)); if (on) LIST[pos] = lane; if (lane == 0) CNT[0] = __popcll(uni);
    }
    __syncthreads();
    { const int cnt = CNT[0]; const unsigned long long mysel = (unsigned long long)SEL[tl * 2] | ((unsigned long long)SEL[tl * 2 + 1] << 32);
      NS_INIT();
#pragma unroll 1
      for (int j = 0; 4 * j < cnt; ++j) { ns_stage(C, A, 1, j, b, n); __syncthreads();
          const int e = 4 * j + (w >> 1), sub = w & 1; int khi = -1, blk = 0;
          if (e < cnt) { blk = LIST[e]; if ((mysel >> blk) & 1ull) khi = blk < 32 ? 31 : (sub == 0 ? (tl < DS - 1 ? tl : DS - 1) : -1); }
          nsa_block_t<1, 40>(KTw, VTw, lane, qf, 0, khi, -slope2 * (float)(qpos - 64 * blk - 32 * sub), slope2, m, l, O);
          __syncthreads(); }
      NS_MERGE(1); }
    { NS_INIT();
#pragma unroll 1
      for (int j = 0; j < 3; ++j) { ns_stage(C, A, 2, j, b, n); __syncthreads();
          const int w0 = 256 * j + 32 * w; int klo = tl + 1 - w0; if (klo < 0) klo = 0; int khi = 512 + tl - w0; if (khi > 31) khi = 31;
          nsa_block_t<1, 40>(KTw, VTw, lane, qf, klo, khi, -slope2 * (float)(qpos - (PASTL - 512) - w0), slope2, m, l, O);
          __syncthreads(); }
      NS_MERGE(2); }
    { u2 wv; wv.x = cvtpk(acc4[0], acc4[1]); wv.y = cvtpk(acc4[2], acc4[3]); *(u2*)(A.ONSA + (size_t)mrow * 1024 + head * 64 + 32 * (w >> 2) + 8 * (w & 3) + 4 * hi) = wv; }
#undef NS_INIT
#undef NS_MERGE
}

__device__ __forceinline__ void cmp_convert_cache(const Ctx& C, const float* cache, const int* pt, bf16* CA) {
    const size_t NIT = (size_t)DB * 2048 * 32, stride = (size_t)C.G * NTHR;
    for (size_t i0 = (size_t)C.bid * NTHR + C.tid; i0 < NIT; i0 += 4 * stride) {
        f4 a[4], c[4]; size_t dsto[4]; bool ok[4];
#pragma unroll
        for (int k = 0; k < 4; ++k) { const size_t i = i0 + k * stride; ok[k] = i < NIT; const size_t ii = ok[k] ? i : 0;
            const int d8 = (int)(ii & 7), n = (int)(ii >> 3) & 1, type = (int)(ii >> 4) & 1; const size_t bp = ii >> 5; const int pos = (int)(bp & 2047), b = (int)(bp >> 11);
            const float* src = cache + ((size_t)(pt[b * 16 + (pos >> 7)] * 128 + (pos & 127)) * 4 + type) * 128 + n * 64 + 8 * d8;
            a[k] = *(const f4*)src; c[k] = *(const f4*)(src + 4); dsto[k] = ((size_t)((type * 128 + b) * 2 + n) * 2048 + pos) * 64 + 8 * d8; }
#pragma unroll
        for (int k = 0; k < 4; ++k) if (ok[k]) { v4u o; o.x = pk2(a[k].x, a[k].y); o.y = pk2(a[k].z, a[k].w); o.z = pk2(c[k].x, c[k].y); o.w = pk2(c[k].z, c[k].w); *(v4u*)(CA + dsto[k]) = o; }
    }
}
__device__ __forceinline__ void cmp_stage2(int widx, int nw, int lane, const bf16* HID, const bf16* W2T, float* KCS_, float* VCS_, bf16* KC16_, bf16* VC16_) {
    const int fr = lane & 15, kg = lane >> 4;
    for (int it = widx; it < CMP_ROWS / 16; it += nw) { const int r0 = 16 * it; const bool smp = r0 < CMP_ROWS_S;
        const int type = smp ? (r0 >= CMP_ROWS_S / 2) : ((r0 - CMP_ROWS_S) >= CMP_ROWS_P / 2);
        pg8::f32x4 acc[4];
#pragma unroll
        for (int nt = 0; nt < 4; ++nt) acc[nt] = (pg8::f32x4){0.f, 0.f, 0.f, 0.f};
#pragma unroll
        for (int ks = 0; ks < 8; ++ks) { const bfx8 a = *(const bfx8*)(HID + (size_t)(r0 + fr) * 256 + 32 * ks + 8 * kg);
#pragma unroll
            for (int nt = 0; nt < 4; ++nt) { const bfx8 b = *(const bfx8*)(W2T + ((size_t)type * 64 + 16 * nt + fr) * 256 + 32 * ks + 8 * kg); acc[nt] = __builtin_amdgcn_mfma_f32_16x16x32_bf16(a, b, acc[nt], 0, 0, 0); } }
#pragma unroll
        for (int rr = 0; rr < 4; ++rr) { const int r = r0 + 4 * kg + rr;
            if (smp) { const int c = r & 127, bn = (r >> 7) & 255; if (c < NCS) { float* dst = (type ? VCS_ : KCS_) + ((size_t)bn * NCS + c) * 64;
#pragma unroll
                    for (int nt = 0; nt < 4; ++nt) dst[16 * nt + fr] = acc[nt][rr]; } }
            else { const int rp = r - CMP_ROWS_S, c = rp & 511, n = (rp >> 9) & 1; if (c < NCP) { bf16* dst = (type ? VC16_ : KC16_) + ((size_t)n * 512 + c) * 64;
#pragma unroll
                    for (int nt = 0; nt < 4; ++nt) dst[16 * nt + fr] = (bf16)f2bf(acc[nt][rr]); } } }
    }
}

__device__ __forceinline__ float sgm(float x) { return __builtin_amdgcn_rcpf(1.f + __expf(-x)); }
__device__ __forceinline__ void mix_sample_row(const bf16* ga, const bf16* gb, const float* slab, bf16* mix, int lane) {
#pragma unroll 2
    for (int j = 0; j < 8; ++j) { const int idx = lane + 64 * j; f4 pacc = ((const f4*)slab)[idx], qacc = ((const f4*)slab)[idx + 4 * (SLABSZ / 4)];
#pragma unroll
        for (int k = 1; k < 4; ++k) { pacc += ((const f4*)slab)[idx + (size_t)k * (SLABSZ / 4)]; qacc += ((const f4*)slab)[idx + (size_t)(4 + k) * (SLABSZ / 4)]; }
        const f4 a = ld4bf(ga + 4 * idx), b = ld4bf(gb + 4 * idx);
        const f4 r = (f4){sgm(a.x) * pacc.x + sgm(b.x) * qacc.x, sgm(a.y) * pacc.y + sgm(b.y) * qacc.y, sgm(a.z) * pacc.z + sgm(b.z) * qacc.z, sgm(a.w) * pacc.w + sgm(b.w) * qacc.w};
        ((unsigned long long*)mix)[idx] = (unsigned long long)pk2(r.x, r.y) | ((unsigned long long)pk2(r.z, r.w) << 32); }
}

__device__ __forceinline__ void win_copy(const float* cache_win, float* wins, size_t tix, size_t nthr) {
    const size_t NF = (size_t)DB * 508 * 64;
    for (size_t i0 = tix; i0 < NF; i0 += 4 * nthr) { f4 v[4];
#pragma unroll
        for (int k = 0; k < 4; ++k) { const size_t i = i0 + k * nthr; if (i < NF) { const size_t b = i / (508 * 64), r = i % (508 * 64); v[k] = ((const f4*)cache_win)[b * 512 * 64 + 4 * 64 + r]; } }
#pragma unroll
        for (int k = 0; k < 4; ++k) { const size_t i = i0 + k * nthr; if (i < NF) { const size_t b = i / (508 * 64), r = i % (508 * 64); ((f4*)wins)[b * 512 * 64 + r] = v[k]; } } }
}
constexpr int NPHASE = 15;
#if PROBE_MASK
#define PSUB(id, ...) do { __syncthreads(); const unsigned long long ts_ = __builtin_amdgcn_s_memrealtime(); __VA_ARGS__ __syncthreads(); if (PROBE_SUB == (id)) pr_acc += __builtin_amdgcn_s_memrealtime() - ts_; } while (0)
#else
#define PSUB(id, ...) do { __VA_ARGS__ } while (0)
#endif
struct Args { const void* in[30]; float* out; unsigned char* ws; int ph_lo, ph_hi; };
__global__ void __launch_bounds__(NTHR, 2) mk_fwd(Args args) {
    extern __shared__ __attribute__((aligned(16))) unsigned char lds_raw[];
#define MKCTX() Ctx C; C.lds = (LAS unsigned char*)lds_raw; C.tid = threadIdx.x; asm volatile("" : "+v"(C.tid)); C.lane = C.tid & 63; C.wave = __builtin_amdgcn_readfirstlane(C.tid >> 6); \
    C.G = gridDim.x; C.bid = blockIdx.x; C.gw = C.bid * NWAVES + C.wave; C.NGW = C.G * NWAVES;
    LAS unsigned char* const lds0 = (LAS unsigned char*)lds_raw;
    unsigned char* ws = args.ws; float* out = args.out;
    gu32* ctl = (gu32*)(ws + WS_CTL);
    volatile LAS unsigned* MISC = (volatile LAS unsigned*)(lds0 + MISC_OFF);
    for (int u = threadIdx.x; u < (LDS_BYTES - LDSCTL_OFF) / 4; u += NTHR) ((LAS unsigned*)(lds0 + LDSCTL_OFF))[u] = 0u;
    __syncthreads();
    const int lo = args.ph_lo, hi = args.ph_hi;
    XcdBarrier bar; bar.bar = (unsigned*)(ctl + CW_BAR); bar.x = 0; bar.st = nullptr;
    if (hi - lo > 1) bar = xcd_barrier_post((unsigned*)(ctl + CW_BAR), MISC + 8);
#define IN(k) (lo <= (k) && (k) < hi)
#if PROBE_MASK
    unsigned long long pr_t = __builtin_amdgcn_s_memrealtime(), pr_acc = 0ull;
#define SEAM(k) do { if (IN(k) && IN((k) + 1)) xcd_barrier(bar); { const unsigned long long t_ = __builtin_amdgcn_s_memrealtime(); if ((PROBE_MASK >> (k)) & 1) pr_acc += t_ - pr_t; pr_t = t_; } } while (0)
#else
#define SEAM(k) do { if (IN(k) && IN((k) + 1)) xcd_barrier(bar); } while (0)
#endif
#define x_p ((const float*)args.in[0])
#define x_s ((const float*)args.in[1])
#define cache_kv ((const float*)args.in[2])
#define cache_win ((const float*)args.in[3])
#define state_hgrn ((const float*)args.in[4])
#define page_table ((const int*)args.in[5])
#define n_pre1 ((const float*)args.in[6])
#define n_post1 ((const float*)args.in[7])
#define n_pre2 ((const float*)args.in[11])
#define n_post2 ((const float*)args.in[12])
#define n_pre3 ((const float*)args.in[25])
#define n_post3 ((const float*)args.in[26])
#define hg_lb ((const float*)args.in[14])
#define hg_gnorm ((const float*)args.in[15])
#define W1GU ((bf16*)(ws + WS_W1GU))
#define W1D ((bf16*)(ws + WS_W1D))
#define W2GU ((bf16*)(ws + WS_W2GU))
#define W2D ((bf16*)(ws + WS_W2D))
#define WINt ((bf16*)(ws + WS_WIN))
#define WPH ((bf16*)(ws + WS_WPH))
#define WPN ((bf16*)(ws + WS_WPN))
#define WOt ((bf16*)(ws + WS_WO))
#define XN ((bf16*)(ws + WS_XN))
#define HB ((bf16*)(ws + WS_HB))
#define Y ((bf16*)(ws + WS_Y))
#define LOGF ((float*)(ws + WS_LOGF))
#define WINF ((float*)(ws + WS_WINF))
#define NG ((float*)(ws + WS_NG))
#define GA ((bf16*)(ws + WS_GA))
#define GB ((bf16*)(ws + WS_GB))
#define KCS ((float*)(ws + WS_KCS))
#define VCS ((float*)(ws + WS_VCS))
#define CB ((float*)(ws + WS_CB))
#define OHR ((float*)(ws + WS_OHR))
#define OHG ((bf16*)(ws + WS_OHG))
#define ONSA ((bf16*)(ws + WS_ONSA))
#define T1 ((bf16*)(ws + WS_T1))
#define MIX ((bf16*)(ws + WS_MIX))
#define UT ((float*)(ws + WS_UT))
#define DD ((float*)(ws + WS_DD))
#define SP ((bf16*)(ws + WS_SP))
#define CA ((bf16*)(ws + WS_CA))
#define HID ((bf16*)(ws + WS_HID))
#define W1C ((bf16*)(ws + WS_W1C))
#define W2C ((bf16*)(ws + WS_W2C))
#define SLAB ((float*)(ws + WS_SLAB))
#define RS ((float*)(ws + WS_RS))
#define QH16 ((bf16*)(ws + WS_QH16))
#define KH16 ((bf16*)(ws + WS_KH16))
#define VH16 ((bf16*)(ws + WS_VH16))
#define GH16 ((bf16*)(ws + WS_GH16))
#define QN16 ((bf16*)(ws + WS_QN16))
#define KSL ((bf16*)(ws + WS_KSL))
#define VSL ((bf16*)(ws + WS_VSL))
#define KWN ((bf16*)(ws + WS_KWN))
#define VWN ((bf16*)(ws + WS_VWN))
#define KC16 ((bf16*)(ws + WS_KC16))
#define VC16 ((bf16*)(ws + WS_VC16))
#define KVO ((float*)(out + O_KV))
#define WINP ((float*)(out + O_WINP))
#define WINS ((float*)(out + O_WINS))
    if (IN(0)) { MKCTX();
        if ((C.gw & 15) == 0 && (C.gw >> 4) < 128) { const int task = C.gw >> 4, type = task >> 6, j4 = task & 63;   const float* pos = (const float*)args.in[type ? 19 : 16]; const float* w1 = (const float*)args.in[type ? 20 : 17];
            f4 s = (f4){0.f, 0.f, 0.f, 0.f};
#pragma unroll 8
            for (int k = 0; k < 32; ++k) { const int i = C.lane + 64 * k; s += *(const f4*)(w1 + (size_t)i * 256 + 4 * j4) * pos[i]; }
            s.x = wsum(s.x); s.y = wsum(s.y); s.z = wsum(s.z); s.w = wsum(s.w);
            if (C.lane == 0) *(f4*)(CB + type * 256 + 4 * j4) = s; }
        PSUB(11, tr_run(args.in, ws, (LAS unsigned*)(C.lds + C.wave * 16384), 0, 8, C.gw, C.NGW, C.lane); );
        for (int i = C.bid * NTHR + C.tid; i < (DINP - DIN) * DM / 8; i += C.G * NTHR) ((v4u*)(WINt + (size_t)DIN * DM))[i] = (v4u){0u, 0u, 0u, 0u};
        PSUB(12, cmp_convert_cache(C, cache_kv, page_table, CA); );
        PSUB(13, for (int m = C.gw; m < M; m += C.NGW) rms_row_to_bf16(m < TP ? x_p + (size_t)m * DM : x_s + (size_t)(m - TP) * DM, n_pre1, XN + (size_t)m * DM, C.lane); );
    }
    SEAM(0);
    if (IN(1)) { MKCTX(); pg8::Gemm g{XN, W1GU, M, 2 * FF, DM, DM, DM}; pg8::StaticOrder S; S.init(M, 2 * FF, C.G, C.bid); pg8::EpiSwiglu E{HB, FF};
        pg8::gemm_phase<pg8::EpiSwiglu, pg8::StaticOrder, true>(C.lds + RING_OFF, g, S, E);
        { constexpr int rem = ((M / 256) * (2 * FF / 256)) % 256;
          if (C.G == 256) { pg8::Gemm gc{CA, W1C, CMP_ROWS, 512, 2048, 1024, 2048}; pg8::CmpOrder Sc{0, 256 - rem, C.bid - rem, 256 - rem}; pg8::EpiCmp Ec{CB, HID};
              pg8::gemm_phase<pg8::EpiCmp, pg8::CmpOrder, true>(C.lds + RING_OFF, gc, Sc, Ec); } } }
    SEAM(1);
    if (IN(2)) { MKCTX(); pg8::SplitSched S; S.S.init(TP, DM, C.G, C.bid); S.A = (const char*)HB; S.B = (const char*)W1D; S.lda = FF; S.ldb = FF; S.K = FF; S.NS = 16; S.bid = C.bid;
        pg8::EpiDual<pg8::EpiY16> E{pg8::EpiY16{Y, DM}, SLAB}; pg8::gemm_phase_g<pg8::EpiDual<pg8::EpiY16>, pg8::SplitSched, true>(C.lds + RING_OFF, FF, FF, S, E); }
    SEAM(2);
    if (IN(3)) { MKCTX(); for (int m = C.gw; m < M; m += C.NGW) norm_mid_row(m < TP ? (const void*)(Y + (size_t)m * DM) : (const void*)(SLAB + (size_t)(m - TP) * DM), m < TP ? x_p + (size_t)m * DM : x_s + (size_t)(m - TP) * DM, nullptr, nullptr, 0.f,
            n_post1, 0.5f, nullptr, n_pre2, XN + (size_t)m * DM, RS + m, C.lane, m < TP ? 0 : 16); }
    SEAM(3);
    if (IN(4)) { MKCTX(); pg8::Gemm g{XN, WINt, M, DINP, DM, DM, DM}; pg8::StaticOrder S; S.init(M, DINP, C.G, C.bid);
        pg8::EpiInProj E{ws, out, hg_lb};
        pg8::gemm_phase<pg8::EpiInProj, pg8::StaticOrder, true>(C.lds + RING_OFF, g, S, E);
        { constexpr int rem = ((M / 256) * (DINP / 256)) % 256, r1 = 256 - ((M / 256) * (2 * FF / 256)) % 256;
          if (C.G == 256) { pg8::Gemm gc{CA, W1C, CMP_ROWS, 512, 2048, 1024, 2048}; pg8::CmpOrder Sc{r1, r1 + 256 - rem, C.bid - rem, 256 - rem}; pg8::EpiCmp Ec{CB, HID};
              pg8::gemm_phase<pg8::EpiCmp, pg8::CmpOrder, true>(C.lds + RING_OFF, gc, Sc, Ec); } } }
    SEAM(4);
    if (IN(5)) { MKCTX();
        constexpr int c_done = (256 - ((M / 256) * (2 * FF / 256)) % 256) + (256 - ((M / 256) * (DINP / 256)) % 256);
        const int c_lo = C.G == 256 ? c_done : 0, n_c = CMP_ROWS / 256 - c_lo;
        { pg8::Gemm g{CA, W1C, CMP_ROWS, 512, 2048, 1024, 2048}; pg8::CmpOrder S{c_lo, CMP_ROWS / 256, C.bid, C.G}; pg8::EpiCmp E{CB, HID};
          pg8::gemm_phase<pg8::EpiCmp, pg8::CmpOrder, true>(C.lds + RING_OFF, g, S, E); }
        { const int skip = n_c < C.G ? n_c : 0;
          if (C.bid >= skip) for (int u = C.bid - skip; u < 8 * HG_NCH; u += C.G - skip) hgrn_A_unit(C, u & 7, u >> 3, LOGF, KH16, VH16, UT, DD); }
    }
    SEAM(5);
    if (IN(6)) { MKCTX();
        if (C.wave < 4) { const int widx = C.bid * 4 + C.wave, nw = C.G * 4;
            cmp_stage2(widx, nw, C.lane, HID, W2C, KCS, VCS, KC16, VC16);
            for (int v = widx; v < DB * 64; v += nw) { const int b = v >> 6, h = (v >> 3) & 7, vg2 = v & 7;
                hgrn_seq_pair(TP + b * 4, h, vg2, state_hgrn + (size_t)b * 131072 + (size_t)h * 16384, out + O_HGS + (size_t)b * 131072 + (size_t)h * 16384, QH16, LOGF, KH16, VH16, OHR, C.lane); }
            hgrn_scan(C.bid * 256 + C.tid, C.G * 256, UT, DD, SP, out + O_HGP);
        } else tr_run(args.in, ws, (LAS unsigned*)(C.lds + C.wave * 16384), 8, 14, C.bid * 4 + (C.wave - 4), C.G * 4, C.lane);
    }
    SEAM(6);
    if (IN(7)) { MKCTX();
        for (int m = TP + C.gw; m < M; m += C.NGW) hgrn_finish_row(OHR + (size_t)m * 1024, GH16 + (size_t)m * 1024, hg_gnorm, OHG + (size_t)m * 1024, C.lane);
        NsaP AP{QN16, KSL, VSL, KWN, VWN, KC16, VC16, NG, ONSA};
        NsaS AS{QN16, KVO, WINF, NG, cache_kv, cache_win, page_table, KCS, VCS, ONSA};
        LAS int* qslot = (LAS int*)(C.lds + MISC_OFF + 128);
#define QUEUE_LOOP(word, count, ...) for (;;) { __syncthreads(); if (C.tid == 0) qslot[0] = (int)__hip_atomic_fetch_add(ctl + (word), 1u, __ATOMIC_RELAXED, __HIP_MEMORY_SCOPE_AGENT); __syncthreads(); \
            const int it = qslot[0]; if (it >= (count)) break; __VA_ARGS__ }
        QUEUE_LOOP(CW_Q7, 512, nsa_prompt_unit(C, AP, 255 - (it >> 1), it & 1); )
        QUEUE_LOOP(CW_Q7 + 64, 2 * DB, nsa_sample_unit(C, AS, it >> 1, it & 1); )
        QUEUE_LOOP(CW_Q7 + 128, 8 * HG_NCH, hgrn_B_unit(C, it & 7, it >> 3, QH16, LOGF, KH16, VH16, GH16, hg_gnorm, SP, OHG); )
    }
    SEAM(7);
    if (IN(8)) { MKCTX(); pg8::ProjSched S; S.S.init(TP, DM, C.G, C.bid); S.Ah = (const char*)OHG; S.An = (const char*)ONSA; S.Bh = (const char*)WPH; S.Bn = (const char*)WPN; S.bid = C.bid;
        pg8::EpiProj E{pg8::EpiGate1{GA, T1, DM}, pg8::EpiGate2{GB, T1, MIX, DM}, SLAB}; pg8::gemm_phase_g<pg8::EpiProj, pg8::ProjSched, true>(C.lds + RING_OFF, 1024, 1024, S, E); }
    SEAM(8);
    if (IN(9)) { MKCTX(); for (int m = TP + C.gw; m < M; m += C.NGW) mix_sample_row(GA + (size_t)m * DM, GB + (size_t)m * DM, SLAB + (size_t)(m - TP) * DM, MIX + (size_t)m * DM, C.lane); }
    SEAM(9);
    if (IN(10)) { MKCTX(); pg8::SplitSched S; S.S.init(TP, DM, C.G, C.bid); S.A = (const char*)MIX; S.B = (const char*)WOt; S.lda = DM; S.ldb = DM; S.K = DM; S.NS = 8; S.bid = C.bid;
        pg8::EpiDual<pg8::EpiY16> E{pg8::EpiY16{Y, DM}, SLAB}; pg8::gemm_phase_g<pg8::EpiDual<pg8::EpiY16>, pg8::SplitSched, true>(C.lds + RING_OFF, DM, DM, S, E); }
    SEAM(10);
    if (IN(11)) { MKCTX(); for (int m = C.gw; m < M; m += C.NGW) norm_mid_row(m < TP ? (const void*)(Y + (size_t)m * DM) : (const void*)(SLAB + (size_t)(m - TP) * DM), nullptr, XN + (size_t)m * DM, n_pre2, RS[m],
            n_post2, 1.0f, nullptr, n_pre3, XN + (size_t)m * DM, RS + m, C.lane, m < TP ? 0 : 8); }
    SEAM(11);
    if (IN(12)) { MKCTX(); pg8::Gemm g{XN, W2GU, M, 2 * FF, DM, DM, DM}; pg8::StaticOrder S; S.init(M, 2 * FF, C.G, C.bid); pg8::EpiSwiglu E{HB, FF};
        pg8::gemm_phase<pg8::EpiSwiglu, pg8::StaticOrder, true>(C.lds + RING_OFF, g, S, E);
        { constexpr int rem = ((M / 256) * (2 * FF / 256)) % 256;
          if (C.G == 256 && C.bid >= rem) win_copy(cache_win, WINS, (size_t)(C.bid - rem) * NTHR + C.tid, (size_t)(256 - rem) * NTHR);
          else if (C.G != 256) win_copy(cache_win, WINS, (size_t)C.bid * NTHR + C.tid, (size_t)C.G * NTHR); } }
    SEAM(12);
    if (IN(13)) { MKCTX(); pg8::SplitSched S; S.S.init(TP, DM, C.G, C.bid); S.A = (const char*)HB; S.B = (const char*)W2D; S.lda = FF; S.ldb = FF; S.K = FF; S.NS = 16; S.bid = C.bid;
        pg8::EpiDual<pg8::EpiY16> E{pg8::EpiY16{Y, DM}, SLAB}; pg8::gemm_phase_g<pg8::EpiDual<pg8::EpiY16>, pg8::SplitSched, true>(C.lds + RING_OFF, FF, FF, S, E); }
    SEAM(13);
    if (IN(14)) { MKCTX(); for (int m = C.gw; m < M; m += C.NGW) norm_mid_row(m < TP ? (const void*)(Y + (size_t)m * DM) : (const void*)(SLAB + (size_t)(m - TP) * DM), nullptr, XN + (size_t)m * DM, n_pre3, RS[m],
            n_post3, 0.5f, out + O_Y + (size_t)m * DM, nullptr, nullptr, nullptr, C.lane, m < TP ? 0 : 16); }
#if PROBE_MASK
    { const unsigned long long t_ = __builtin_amdgcn_s_memrealtime(); if ((PROBE_MASK >> 14) & 1) pr_acc += t_ - pr_t;
      if (PROBE_SUB >= 32) pr_acc += ((volatile LAS unsigned long long*)(lds0 + MISC_OFF + 256))[PROBE_SUB - 32];
      if (blockIdx.x == 0) { const unsigned long long t0_ = __builtin_amdgcn_s_memrealtime(); while (__builtin_amdgcn_s_memrealtime() - t0_ < PROBE_K * pr_acc) __builtin_amdgcn_s_sleep(8); } }
#endif
#undef IN
#undef SEAM
#undef MKCTX
#undef QUEUE_LOOP
#undef x_p
#undef x_s
#undef cache_kv
#undef cache_win
#undef state_hgrn
#undef page_table
#undef n_pre1
#undef n_post1
#undef n_pre2
#undef n_post2
#undef n_pre3
#undef n_post3
#undef hg_lb
#undef hg_gnorm
#undef W1GU
#undef W1D
#undef W2GU
#undef W2D
#undef WINt
#undef WPH
#undef WPN
#undef WOt
#undef XN
#undef HB
#undef Y
#undef LOGF
#undef WINF
#undef NG
#undef GA
#undef GB
#undef KCS
#undef VCS
#undef CB
#undef OHR
#undef OHG
#undef ONSA
#undef T1
#undef MIX
#undef UT
#undef DD
#undef SP
#undef CA
#undef HID
#undef W1C
#undef W2C
#undef SLAB
#undef RS
#undef QH16
#undef KH16
#undef VH16
#undef GH16
#undef QN16
#undef KSL
#undef VSL
#undef KWN
#undef VWN
#undef KC16
#undef VC16
#undef KVO
#undef WINP
#undef WINS
}

#ifndef MK_ONE_LAUNCH
#define MK_ONE_LAUNCH 1
#endif
extern "C" void kernel_launch(void* const* d_in, const int* in_sizes, int n_in, void* d_out, int out_size, void* d_ws, size_t ws_size, hipStream_t stream) {
    static int grid = 0;
    if (grid == 0) {
        if (n_in != 30 || out_size != (int)O_END || ws_size < WS_END) { fprintf(stderr, "kernel_launch: unexpected sizes (n_in %d out %d ws %zu)\n", n_in, out_size, ws_size); grid = -1; return; }
        int dev = 0, cus = 0, per_cu = 0;
        if (hipGetDevice(&dev) != hipSuccess || hipDeviceGetAttribute(&cus, hipDeviceAttributeMultiprocessorCount, dev) != hipSuccess) { grid = -1; return; }
        if (hipFuncSetAttribute((const void*)mk_fwd, hipFuncAttributeMaxDynamicSharedMemorySize, LDS_BYTES) != hipSuccess) { fprintf(stderr, "kernel_launch: hipFuncSetAttribute failed\n"); grid = -1; return; }
        if (hipOccupancyMaxActiveBlocksPerMultiprocessor(&per_cu, (const void*)mk_fwd, NTHR, LDS_BYTES) != hipSuccess || per_cu < 1) { fprintf(stderr, "kernel_launch: occupancy query says %d\n", per_cu); }
        (void)hipGetLastError();
        grid = cus;
    }
    if (grid < 0) return;
    (void)hipMemsetAsync((char*)d_ws + WS_CTL, 0, CTL_ZERO_BYTES, stream);
    Args a{};
    for (int i = 0; i < 30; ++i) a.in[i] = d_in[i];
    a.out = (float*)d_out; a.ws = (unsigned char*)d_ws;
#if MK_ONE_LAUNCH
    a.ph_lo = 0; a.ph_hi = NPHASE;
    hipLaunchKernelGGL(mk_fwd, dim3(grid), dim3(NTHR), LDS_BYTES, stream, a);
#else
    for (int p = 0; p < NPHASE; ++p) { a.ph_lo = p; a.ph_hi = p + 1; hipLaunchKernelGGL(mk_fwd, dim3(grid), dim3(NTHR), LDS_BYTES, stream, a); }
#endif
}
```
